# Optimizing an MI355X kernel written in HIP

```python
import jax, jax.numpy as jnp
from jax import lax
import numpy as np

D_MODEL = 2048
BATCH = 8
SEQ = 2048
DEPTH = 1

CHUNK = 64
RWKV_WIDTH = 1024
RWKV_HEAD = 64
RWKV_HEADS = RWKV_WIDTH // RWKV_HEAD
DECAY_LORA = 64
AAA_LORA = 64
GATE_LORA = 160
RWKV_GN_EPS = 64e-5
HGRN_WIDTH = 1024
HGRN_EXPAND = 128
HGRN_HEADS = HGRN_WIDTH // HGRN_EXPAND
HGRN_DK = HGRN_EXPAND
HGRN_DV = HGRN_WIDTH // HGRN_HEADS
GLA_BLOCK = CHUNK // 4
N_EXPERTS = 32
TOP_K = 4
D_EXPERT = 2048
SWIGLU_ALPHA = 1.702
SWIGLU_LIMIT = 7.0
MOE_BLOCK = 128
NORM_EPS = 1e-5
RWKV_COLS = 3 * RWKV_WIDTH + DECAY_LORA + AAA_LORA + GATE_LORA
HGRN_COLS = 4 * HGRN_WIDTH
GATE_COLS = 2 * D_MODEL
IN_COLS = RWKV_COLS + HGRN_COLS + GATE_COLS

kernel_name = 'hybrid_rwkv7_hgrn2_moe_block'


def _rmsnorm(x, g, eps=NORM_EPS):
    xf = x.astype(jnp.float32)
    y = xf * lax.rsqrt(jnp.mean(xf * xf, axis=-1, keepdims=True) + eps)
    return (y * g.astype(jnp.float32)).astype(x.dtype)


def _token_shift(p, mu):
    prev = jnp.pad(p, ((0, 0), (1, 0), (0, 0)))[:, :-1, :]
    return p + (prev - p) * mu


def _rwkv7_mix(p, w0, w2, a0, a2, g2, k_k, k_a, r_k, gn_g, gn_b):
    B, S, _ = p.shape
    C, H, N = RWKV_WIDTH, RWKV_HEADS, RWKV_HEAD
    f32 = jnp.float32
    p = p.astype(f32)
    r, k, v, wd, ad, gd = jnp.split(p, [C, 2 * C, 3 * C, 3 * C + DECAY_LORA, 3 * C + DECAY_LORA + AAA_LORA], axis=-1)
    w_log = -jax.nn.softplus(-(w0 + jnp.tanh(wd) @ w2)) - 0.5
    decay = jnp.exp(-jnp.exp(w_log))
    a = jax.nn.sigmoid(a0 + ad @ a2)
    g = jax.nn.sigmoid(gd) @ g2
    heads = lambda t: t.reshape(B, S, H, N)
    kk = heads(k * k_k)
    kk = kk / jnp.maximum(jnp.sqrt(jnp.sum(kk * kk, axis=-1, keepdims=True)), 1e-12)
    k = k * (1.0 + (a - 1.0) * k_a)
    r, k, v, a, decay = heads(r), heads(k), heads(v), heads(a), heads(decay)
    tm = lambda t: jnp.moveaxis(t, 1, 0)

    def step(state, inp):
        r_t, w_t, k_t, v_t, kk_t, a_t = inp
        sa = jnp.einsum('bhvk,bhk->bhv', state, -kk_t)
        state = (state * w_t[:, :, None, :]
                 + sa[..., None] * (kk_t * a_t)[:, :, None, :]
                 + v_t[..., None] * k_t[:, :, None, :])
        return state, jnp.einsum('bhvk,bhk->bhv', state, r_t)

    _, y = lax.scan(step, jnp.zeros((B, H, N, N), f32),
                    (tm(r), tm(decay), tm(k), tm(v), tm(kk), tm(a)))
    y = jnp.moveaxis(y, 0, 1)
    mu = jnp.mean(y, axis=-1, keepdims=True)
    var = jnp.mean(jnp.square(y - mu), axis=-1, keepdims=True)
    y = ((y - mu) * lax.rsqrt(var + RWKV_GN_EPS)).reshape(B, S, C) * gn_g + gn_b
    bonus = jnp.sum(r * k * r_k, axis=-1, keepdims=True) * v
    return (y + bonus.reshape(B, S, C)) * g


def _hgrn2_mix(p, lb, gn_g):
    B, S, _ = p.shape
    H, DK, DV, L = HGRN_HEADS, HGRN_DK, HGRN_DV, GLA_BLOCK
    nC = S // L
    f32 = jnp.float32
    q, f, i, og = jnp.split(p.astype(f32), 4, axis=-1)
    q = jax.nn.silu(q)
    forget = lb + (1.0 - lb) * jax.nn.sigmoid(f)
    log_f = jnp.log(forget)
    k = 1.0 - forget
    blocks = lambda t, d: t.reshape(B, nC, L, H, d).transpose(0, 3, 1, 2, 4)
    q, k, log_f, v = blocks(q, DK), blocks(k, DK), blocks(log_f, DK), blocks(i, DV)
    b = jnp.cumsum(log_f, axis=3)
    q_dec = q * jnp.exp(b)
    k_dec = k * jnp.exp(-b)
    causal = jnp.tril(jnp.ones((L, L), dtype=bool))
    attn = jnp.where(causal, jnp.einsum('bhcld,bhcmd->bhclm', q_dec, k_dec), 0.0)
    o_intra = jnp.einsum('bhclm,bhcme->bhcle', attn, v)
    b_last = b[:, :, :, -1:, :]
    k_end = k * jnp.exp(b_last - b)
    decay_end = jnp.exp(b_last[:, :, :, 0, :])

    def step(state, inp):
        q_c, k_c, v_c, d_c = inp
        o = jnp.einsum('bhld,bhde->bhle', q_c, state)
        state = state * d_c[..., None] + jnp.einsum('bhld,bhle->bhde', k_c, v_c)
        return state, o

    cm = lambda t: jnp.moveaxis(t, 2, 0)
    _, o_inter = lax.scan(step, jnp.zeros((B, H, DK, DV), f32),
                          (cm(q_dec), cm(k_end), cm(v), cm(decay_end)))
    o = o_intra + jnp.moveaxis(o_inter, 0, 2)
    o = o.transpose(0, 2, 3, 1, 4).reshape(B, S, H, DV)
    o = o * lax.rsqrt(jnp.mean(o * o, axis=-1, keepdims=True) + NORM_EPS) * gn_g
    o = o * jax.nn.silu(og.reshape(B, S, H, DV))
    return o.reshape(B, S, HGRN_WIDTH)


def _token_mixer(h, w_in, mu, w0, w2, a0, a2, g2, k_k, k_a, r_k, rgn_g, rgn_b, lb, hgn_g, proj_a, proj_b, w_out):
    proj = h @ w_in
    p_rwkv, p_hgrn, p_gate = jnp.split(proj, [RWKV_COLS, RWKV_COLS + HGRN_COLS], axis=-1)
    y_a = _rwkv7_mix(_token_shift(p_rwkv, mu), w0, w2, a0, a2, g2, k_k, k_a, r_k, rgn_g, rgn_b)
    y_b = _hgrn2_mix(p_hgrn, lb, hgn_g)
    gate_a, gate_b = jnp.split(p_gate.astype(jnp.float32), 2, axis=-1)
    merged = (jax.nn.sigmoid(gate_a) * (y_a @ proj_a.astype(jnp.float32))
              + jax.nn.sigmoid(gate_b) * (y_b @ proj_b.astype(jnp.float32)))
    return (merged.astype(h.dtype) @ w_out)


def _moe(h, router_w, router_b, w_gate_up, b_gate_up, w_down, b_down):
    B, S, D = h.shape
    T = B * S
    A = T * TOP_K
    hf = h.reshape(T, D)
    logits = hf.astype(jnp.float32) @ router_w.astype(jnp.float32) + router_b.astype(jnp.float32)
    top_vals, top_idx = lax.top_k(logits, TOP_K)
    gates = jax.nn.softmax(top_vals, axis=-1)
    flat_e = top_idx.reshape(A)
    flat_tok = jnp.repeat(jnp.arange(T, dtype=jnp.int32), TOP_K)
    flat_w = gates.reshape(A)
    order = jnp.argsort(flat_e)
    se, stok, sw = flat_e[order], flat_tok[order], flat_w[order]
    counts = jnp.bincount(flat_e, length=N_EXPERTS)
    padded = ((counts + MOE_BLOCK - 1) // MOE_BLOCK) * MOE_BLOCK
    pad_end = jnp.cumsum(padded)
    pad_start = pad_end - padded
    start = jnp.cumsum(counts) - counts
    dest = pad_start[se] + jnp.arange(A) - start[se]
    NB = -(-A // MOE_BLOCK) + N_EXPERTS
    tok_buf = jnp.zeros((NB * MOE_BLOCK,), jnp.int32).at[dest].set(stok)
    w_buf = jnp.zeros((NB * MOE_BLOCK,), h.dtype).at[dest].set(sw.astype(h.dtype))
    block_expert = jnp.clip(jnp.searchsorted(pad_end, jnp.arange(NB) * MOE_BLOCK, side='right'), 0, N_EXPERTS - 1)

    def expert_block(args):
        tok, wt, e = args
        xb = hf[tok]
        gu = xb @ w_gate_up[e] + b_gate_up[e]
        x_glu, x_lin = jnp.split(gu, 2, axis=-1)
        x_glu = jnp.minimum(x_glu, SWIGLU_LIMIT)
        x_lin = jnp.clip(x_lin, -SWIGLU_LIMIT, SWIGLU_LIMIT)
        act = x_glu * jax.nn.sigmoid(SWIGLU_ALPHA * x_glu) * (x_lin + 1.0)
        return (act @ w_down[e] + b_down[e]) * wt[:, None]

    ys = lax.map(expert_block, (tok_buf.reshape(NB, MOE_BLOCK), w_buf.reshape(NB, MOE_BLOCK), block_expert))
    out = jnp.zeros((T, D), ys.dtype).at[tok_buf].add(ys.reshape(NB * MOE_BLOCK, D))
    return out.reshape(B, S, D).astype(h.dtype)


def setup_inputs(seed: int = 0) -> dict:
    key = jax.random.key(seed)
    ks = jax.random.split(key, 32)
    f32 = jnp.float32
    nrm = lambda k, shape, s: jax.random.normal(k, shape, f32) * s
    Dp = DEPTH
    return {
        'x': nrm(ks[0], (BATCH, SEQ, D_MODEL), 1.0),
        'c': nrm(ks[1], (BATCH, D_MODEL), 1.0),
        'ada_w': nrm(ks[2], (Dp, D_MODEL, 6 * D_MODEL), D_MODEL ** -0.5),
        'ada_b': nrm(ks[3], (Dp, 6 * D_MODEL), 0.01),
        'norm1_g': 1.0 + nrm(ks[4], (Dp, D_MODEL), 0.01),
        'norm2_g': 1.0 + nrm(ks[5], (Dp, D_MODEL), 0.01),
        'w_in': nrm(ks[6], (Dp, D_MODEL, IN_COLS), D_MODEL ** -0.5),
        'rwkv_mu': jax.random.uniform(ks[7], (Dp, RWKV_COLS), f32),
        'rwkv_w0': nrm(ks[8], (Dp, RWKV_WIDTH), 0.5),
        'rwkv_w2': nrm(ks[9], (Dp, DECAY_LORA, RWKV_WIDTH), DECAY_LORA ** -0.5),
        'rwkv_a0': nrm(ks[10], (Dp, RWKV_WIDTH), 0.1),
        'rwkv_a2': nrm(ks[11], (Dp, AAA_LORA, RWKV_WIDTH), AAA_LORA ** -0.5),
        'rwkv_g2': nrm(ks[12], (Dp, GATE_LORA, RWKV_WIDTH), GATE_LORA ** -0.5),
        'rwkv_k_k': 1.0 + nrm(ks[13], (Dp, RWKV_WIDTH), 0.1),
        'rwkv_k_a': 1.0 + nrm(ks[14], (Dp, RWKV_WIDTH), 0.1),
        'rwkv_r_k': nrm(ks[15], (Dp, RWKV_HEADS, RWKV_HEAD), 0.1),
        'rwkv_gn_g': 1.0 + nrm(ks[16], (Dp, RWKV_WIDTH), 0.01),
        'rwkv_gn_b': nrm(ks[17], (Dp, RWKV_WIDTH), 0.01),
        'hgrn_lb_logits': nrm(ks[18], (DEPTH + 1, HGRN_WIDTH), 0.1),
        'hgrn_gn_g': 1.0 + nrm(ks[19], (Dp, HGRN_DV), 0.01),
        'proj_a': nrm(ks[20], (Dp, RWKV_WIDTH, D_MODEL), RWKV_WIDTH ** -0.5),
        'proj_b': nrm(ks[21], (Dp, HGRN_WIDTH, D_MODEL), HGRN_WIDTH ** -0.5),
        'w_out': nrm(ks[22], (Dp, D_MODEL, D_MODEL), D_MODEL ** -0.5),
        'router_w': nrm(ks[23], (Dp, D_MODEL, N_EXPERTS), D_MODEL ** -0.5),
        'router_b': nrm(ks[24], (Dp, N_EXPERTS), 0.01),
        'exp_w_gate_up': nrm(ks[25], (Dp, N_EXPERTS, D_MODEL, 2 * D_EXPERT), D_MODEL ** -0.5),
        'exp_b_gate_up': nrm(ks[26], (Dp, N_EXPERTS, 2 * D_EXPERT), 0.01),
        'exp_w_down': nrm(ks[27], (Dp, N_EXPERTS, D_EXPERT, D_MODEL), D_EXPERT ** -0.5),
        'exp_b_down': nrm(ks[28], (Dp, N_EXPERTS, D_MODEL), 0.01),
        'final_norm_g': 1.0 + nrm(ks[29], (D_MODEL,), 0.01),
    }


def reference(x, c, ada_w, ada_b, norm1_g, norm2_g, w_in, rwkv_mu, rwkv_w0, rwkv_w2, rwkv_a0, rwkv_a2,
              rwkv_g2, rwkv_k_k, rwkv_k_a, rwkv_r_k, rwkv_gn_g, rwkv_gn_b, hgrn_lb_logits, hgrn_gn_g,
              proj_a, proj_b, w_out, router_w, router_b, exp_w_gate_up, exp_b_gate_up, exp_w_down,
              exp_b_down, final_norm_g):
    lower_bounds = jnp.cumsum(jax.nn.softmax(hgrn_lb_logits.astype(jnp.float32), axis=0), axis=0)
    c_act = jax.nn.silu(c)
    for l in range(DEPTH):
        mod = c_act @ ada_w[l] + ada_b[l]
        sh1, sc1, g1, sh2, sc2, g2 = [m[:, None, :] for m in jnp.split(mod, 6, axis=-1)]
        h = _rmsnorm(x, norm1_g[l]) * (1.0 + sc1) + sh1
        mix = _token_mixer(h, w_in[l], rwkv_mu[l], rwkv_w0[l], rwkv_w2[l], rwkv_a0[l], rwkv_a2[l], rwkv_g2[l],
                           rwkv_k_k[l], rwkv_k_a[l], rwkv_r_k[l], rwkv_gn_g[l], rwkv_gn_b[l],
                           lower_bounds[l], hgrn_gn_g[l], proj_a[l], proj_b[l], w_out[l])
        x = x + g1 * mix
        h = _rmsnorm(x, norm2_g[l]) * (1.0 + sc2) + sh2
        ffn = _moe(h, router_w[l], router_b[l], exp_w_gate_up[l], exp_b_gate_up[l], exp_w_down[l], exp_b_down[l])
        x = x + g2 * ffn
    return _rmsnorm(x, final_norm_g)
```

```cpp
#include <hip/hip_runtime.h>
#include <cstdio>
#include <cstdint>
namespace pg8 {
#define PG8_LAS __attribute__((address_space(3)))
typedef unsigned short bf16_t;
typedef short bf16x8 __attribute__((ext_vector_type(8)));
typedef float f32x4 __attribute__((ext_vector_type(4)));
typedef unsigned u32x4 __attribute__((ext_vector_type(4)));
typedef int i32x4_t __attribute__((ext_vector_type(4)));
constexpr int BM = 256, BK = 64, HALF = 128, HTB = HALF * BK * 2  , STAGE_BYTES = 8 * HTB, NXCD = 8, WGM = 8;

__host__ __device__ __forceinline__ int lds_byte(int r, int c) { const int st = (r >> 4) * 2 + (c >> 5), rr = r & 15, cc = c & 31, ob = rr * 64 + cc * 2; return st * 1024 + (ob ^ (((ob >> 9) & 1) << 5)); }
__host__ __device__ __forceinline__ void stage_rc(int b, int& R, int& C) { const int st = b / 1024, sb = b % 1024, swz = sb ^ (((sb >> 9) & 1) << 5); R = (st >> 1) * 16 + swz / 64; C = (st & 1) * 32 + (swz % 64) / 2; }
__host__ __device__ __forceinline__ int perm32(int rho) { const int n = rho >> 4, i = rho & 15; return 8 * (i >> 2) + 4 * n + (i & 3); }

struct Unit { int pm, pn, e, kh; };
struct Gemm { const bf16_t* A; const bf16_t* Bt; int M, N, K; size_t bgs; const int* gather; const bf16_t* A2; const bf16_t* Bt2; };

struct StaticOrder {
    static constexpr bool PAIRS = false;
    int nM, nN, nwg, G, c;
    __host__ __device__ void init(int M, int N, int G_, int c_) { nM = M / BM; nN = N / BM; nwg = nM * nN; G = G_; c = c_; }
    __host__ __device__ bool next(int i, Unit& u) const {
        const long L = (long)i * G + c; if (L >= nwg) return false;
        int wgid = (int)L; { const int q = nwg / NXCD, r = nwg % NXCD, xcd = wgid % NXCD, off = wgid / NXCD; wgid = (xcd < r ? xcd * (q + 1) : r * (q + 1) + (xcd - r) * q) + off; }
        const int nig = WGM * nN, gid = wgid / nig, fm = gid * WGM, gsz = (nM - fm) < WGM ? (nM - fm) : WGM;
        u.pm = fm + ((wgid % nig) % gsz); u.pn = (wgid % nig) / gsz; u.e = 0; u.kh = 0; return true;
    }
    __device__ __forceinline__ void a_ready(const Unit&) const {}
    __device__ __forceinline__ void done(const Unit&) const {}
};

__device__ __forceinline__ unsigned cvt_pk_bf16(float lo, float hi) { unsigned r; asm volatile("v_cvt_pk_bf16_f32 %0, %1, %2" : "=v"(r) : "v"(lo), "v"(hi)); return r; }
typedef float f32x2 __attribute__((ext_vector_type(2)));
__device__ __forceinline__ f32x2 gelu_pk(f32x2 v) {
    const f32x2 av = __builtin_elementwise_abs(v), d = av * 0.2316418882f + 1.0f;
    f32x2 t; t.x = __builtin_amdgcn_rcpf(d.x); t.y = __builtin_amdgcn_rcpf(d.y);
    f32x2 q = t * 0.5307027145f + (-0.7265760135f); q = q * t + 0.7107068705f; q = q * t + (-0.142248368f); q = q * t + 0.127414796f; q = q * t;
    const f32x2 s = (v * v) * (-0.72134752044f);
    f32x2 e; e.x = __builtin_amdgcn_exp2f(s.x); e.y = __builtin_amdgcn_exp2f(s.y);
    const f32x2 m = v * (q * e), r = v - m;
    f32x2 o; o.x = v.x < 0.f ? m.x : r.x; o.y = v.y < 0.f ? m.y : r.y; return o;
}

template <int ACT  > struct EpiBf16 {
    static constexpr bool PERM = true, AFTER_DRAIN = false, MID = false; static_assert(ACT == 0 || ACT == 1, "EpiBf16: ACT is 0 (none) or 1 (gelu_pk)");
    bf16_t* O; int ldc; const float* bias; int split_cols; size_t split_stride; float scale0;
    __device__ __forceinline__ void operator()(const f32x4 (&acc)[2][2][4][2], const Unit& u, int wr, int wc, int fr, int fq) const {
        const int row0 = u.pm * BM + wr * 64 + fr; int colt = u.pn * BM; bf16_t* base = O;
        float sc = 1.f; if (split_cols) { const int t = colt / split_cols; base += (size_t)t * split_stride; colt -= t * split_cols; if (t == 0) sc = scale0; }
        const int col0 = colt + wc * 32 + 8 * fq, bcol0 = u.pn * BM + wc * 32 + 8 * fq;
        f32x4 bv[2][2];
#pragma unroll
        for (int bj = 0; bj < 2; ++bj)
#pragma unroll
            for (int n = 0; n < 2; ++n) bv[bj][n] = bias ? *(const f32x4*)(bias + bcol0 + bj * HALF + 4 * n) : (f32x4){0.f, 0.f, 0.f, 0.f};
#pragma unroll
        for (int ai = 0; ai < 2; ++ai)
#pragma unroll
            for (int m = 0; m < 4; ++m) { bf16_t* rowp = base + (size_t)(row0 + ai * HALF + m * 16) * ldc + col0;
#pragma unroll
                for (int bj = 0; bj < 2; ++bj) { f32x4 v0 = acc[ai][bj][m][0] + bv[bj][0], v1 = acc[ai][bj][m][1] + bv[bj][1];
                    if (ACT == 1) { f32x2 a = gelu_pk((f32x2){v0[0], v0[1]}), b = gelu_pk((f32x2){v0[2], v0[3]}), c = gelu_pk((f32x2){v1[0], v1[1]}), d = gelu_pk((f32x2){v1[2], v1[3]});
                        v0 = (f32x4){a.x, a.y, b.x, b.y}; v1 = (f32x4){c.x, c.y, d.x, d.y}; }
                    v0 = v0 * sc; v1 = v1 * sc; u32x4 w; w.x = cvt_pk_bf16(v0[0], v0[1]); w.y = cvt_pk_bf16(v0[2], v0[3]); w.z = cvt_pk_bf16(v1[0], v1[1]); w.w = cvt_pk_bf16(v1[2], v1[3]);
                    *(u32x4*)(rowp + bj * HALF) = w; } }
    }
};


__device__ __forceinline__ float bf_lo(unsigned w) { return __uint_as_float(w << 16); }
__device__ __forceinline__ float bf_hi(unsigned w) { return __uint_as_float(w & 0xffff0000u); }
__device__ __forceinline__ float sigm(float x) { return __builtin_amdgcn_rcpf(1.0f + __expf(-x)); }
typedef unsigned u32x2 __attribute__((ext_vector_type(2)));

struct EpiF32 {
    static constexpr bool PERM = false, AFTER_DRAIN = false, MID = false;
    float* C; int ldc;
    __device__ __forceinline__ void operator()(const f32x4 (&acc)[2][2][4][2], const Unit& u, int wr, int wc, int fr, int fq) const {
        const int row0 = u.pm * BM + wr * 64 + fr, col0 = u.pn * BM + wc * 32 + 4 * fq;
#pragma unroll
        for (int ai = 0; ai < 2; ++ai)
#pragma unroll
            for (int m = 0; m < 4; ++m) { float* rowp = C + (size_t)(row0 + ai * HALF + m * 16) * ldc + col0;
#pragma unroll
                for (int bj = 0; bj < 2; ++bj)
#pragma unroll
                    for (int n = 0; n < 2; ++n) *(f32x4*)(rowp + bj * HALF + n * 16) = acc[ai][bj][m][n]; }
    }
};
template <int PASS> struct EpiGate {
    static constexpr bool PERM = false, AFTER_DRAIN = false, MID = false;
    const bf16_t* gate; int ldg; bf16_t* T1; bf16_t* O; int ldc;
    __device__ __forceinline__ void operator()(const f32x4 (&acc)[2][2][4][2], const Unit& u, int wr, int wc, int fr, int fq) const {
        const int row0 = u.pm * BM + wr * 64 + fr, col0 = u.pn * BM + wc * 32 + 4 * fq;
#pragma unroll
        for (int ai = 0; ai < 2; ++ai) {
            u32x2 gv[4][2][2];
#pragma unroll
            for (int m = 0; m < 4; ++m) { const size_t r = (size_t)(row0 + ai * HALF + m * 16);
#pragma unroll
                for (int bj = 0; bj < 2; ++bj)
#pragma unroll
                    for (int n = 0; n < 2; ++n) gv[m][bj][n] = *(const u32x2*)(gate + r * ldg + col0 + bj * HALF + n * 16); }
#pragma unroll
            for (int mh = 0; mh < 2; ++mh) {
                u32x2 tv[2][2][2];
                if (PASS == 1) {
#pragma unroll
                    for (int m2 = 0; m2 < 2; ++m2) { const size_t r = (size_t)(row0 + ai * HALF + (2 * mh + m2) * 16);
#pragma unroll
                        for (int bj = 0; bj < 2; ++bj)
#pragma unroll
                            for (int n = 0; n < 2; ++n) tv[m2][bj][n] = *(const u32x2*)(T1 + r * ldc + col0 + bj * HALF + n * 16); } }
#pragma unroll
                for (int m2 = 0; m2 < 2; ++m2) { const int m = 2 * mh + m2; const size_t r = (size_t)(row0 + ai * HALF + m * 16);
#pragma unroll
                    for (int bj = 0; bj < 2; ++bj)
#pragma unroll
                        for (int n = 0; n < 2; ++n) { const int c = col0 + bj * HALF + n * 16; const u32x2 g2 = gv[m][bj][n];
                            f32x4 s; s[0] = sigm(bf_lo(g2.x)); s[1] = sigm(bf_hi(g2.x)); s[2] = sigm(bf_lo(g2.y)); s[3] = sigm(bf_hi(g2.y));
                            f32x4 v = acc[ai][bj][m][n] * s;
                            if (PASS == 0) { u32x2 w; w.x = cvt_pk_bf16(v[0], v[1]); w.y = cvt_pk_bf16(v[2], v[3]); *(u32x2*)(T1 + r * ldc + c) = w; }
                            else { const u32x2 t2 = tv[m2][bj][n]; v[0] += bf_lo(t2.x); v[1] += bf_hi(t2.x); v[2] += bf_lo(t2.y); v[3] += bf_hi(t2.y); u32x2 w; w.x = cvt_pk_bf16(v[0], v[1]); w.y = cvt_pk_bf16(v[2], v[3]); *(u32x2*)(O + r * ldc + c) = w; } } }
                asm volatile("" ::: "memory"); }
        }
    }
};
struct EpiMerge {
    static constexpr bool PERM = true, AFTER_DRAIN = false, MID = true;
    const bf16_t* gate; int ldg; int gboff; bf16_t* O; int ldc;
    __device__ __forceinline__ void mid(f32x4 (&acc)[2][2][4][2], const Unit& u, int wr, int wc, int fr, int fq) const {
        const int row0 = u.pm * BM + wr * 64 + fr, col0 = u.pn * BM + wc * 32 + 8 * fq;
#pragma unroll
        for (int ai = 0; ai < 2; ++ai) {
            u32x4 ga[4][2], gb[4][2];
#pragma unroll
            for (int m = 0; m < 4; ++m) { const bf16_t* gp = gate + (size_t)(row0 + ai * HALF + m * 16) * ldg + col0;
#pragma unroll
                for (int bj = 0; bj < 2; ++bj) { ga[m][bj] = *(const u32x4*)(gp + bj * HALF); gb[m][bj] = *(const u32x4*)(gp + gboff + bj * HALF); } }
#pragma unroll
            for (int m = 0; m < 4; ++m)
#pragma unroll
                for (int bj = 0; bj < 2; ++bj) { const u32x4 a = ga[m][bj], b = gb[m][bj]; f32x4 s0, s1;
                    s0[0] = sigm(bf_lo(a.x)) * (1.0f + __expf(-bf_lo(b.x))); s0[1] = sigm(bf_hi(a.x)) * (1.0f + __expf(-bf_hi(b.x)));
                    s0[2] = sigm(bf_lo(a.y)) * (1.0f + __expf(-bf_lo(b.y))); s0[3] = sigm(bf_hi(a.y)) * (1.0f + __expf(-bf_hi(b.y)));
                    s1[0] = sigm(bf_lo(a.z)) * (1.0f + __expf(-bf_lo(b.z))); s1[1] = sigm(bf_hi(a.z)) * (1.0f + __expf(-bf_hi(b.z)));
                    s1[2] = sigm(bf_lo(a.w)) * (1.0f + __expf(-bf_lo(b.w))); s1[3] = sigm(bf_hi(a.w)) * (1.0f + __expf(-bf_hi(b.w)));
                    acc[ai][bj][m][0] = acc[ai][bj][m][0] * s0; acc[ai][bj][m][1] = acc[ai][bj][m][1] * s1; }
            asm volatile("" ::: "memory"); }
    }
    __device__ __forceinline__ void operator()(const f32x4 (&acc)[2][2][4][2], const Unit& u, int wr, int wc, int fr, int fq) const {
        const int row0 = u.pm * BM + wr * 64 + fr, col0 = u.pn * BM + wc * 32 + 8 * fq;
#pragma unroll
        for (int ai = 0; ai < 2; ++ai) {
            u32x4 gb[4][2];
#pragma unroll
            for (int m = 0; m < 4; ++m) { const bf16_t* gp = gate + (size_t)(row0 + ai * HALF + m * 16) * ldg + col0 + gboff;
#pragma unroll
                for (int bj = 0; bj < 2; ++bj) gb[m][bj] = *(const u32x4*)(gp + bj * HALF); }
#pragma unroll
            for (int m = 0; m < 4; ++m) { bf16_t* op = O + (size_t)(row0 + ai * HALF + m * 16) * ldc + col0;
#pragma unroll
                for (int bj = 0; bj < 2; ++bj) { const u32x4 b = gb[m][bj]; const f32x4 a0 = acc[ai][bj][m][0], a1 = acc[ai][bj][m][1];
                    u32x4 w; w.x = cvt_pk_bf16(a0[0] * sigm(bf_lo(b.x)), a0[1] * sigm(bf_hi(b.x))); w.y = cvt_pk_bf16(a0[2] * sigm(bf_lo(b.y)), a0[3] * sigm(bf_hi(b.y)));
                    w.z = cvt_pk_bf16(a1[0] * sigm(bf_lo(b.z)), a1[1] * sigm(bf_hi(b.z))); w.w = cvt_pk_bf16(a1[2] * sigm(bf_lo(b.w)), a1[3] * sigm(bf_hi(b.w)));
                    *(u32x4*)(op + bj * HALF) = w; } }
            asm volatile("" ::: "memory"); }
    }
};
struct EpiRes {
    static constexpr bool PERM = true, AFTER_DRAIN = false, MID = false;
    const float* base; bf16_t* out; int ldc; const float* gvec; int bpitch; int rows_per_batch; float* ssq;
    __device__ __forceinline__ void operator()(const f32x4 (&acc)[2][2][4][2], const Unit& u, int wr, int wc, int fr, int fq) const {
        const int row0 = u.pm * BM + wr * 64 + fr, col0 = u.pn * BM + wc * 32 + 8 * fq;
        const float* gb = gvec + (size_t)((u.pm * BM) / rows_per_batch) * bpitch + col0;
        f32x4 gv[2][2];
#pragma unroll
        for (int bj = 0; bj < 2; ++bj)
#pragma unroll
            for (int n = 0; n < 2; ++n) gv[bj][n] = *(const f32x4*)(gb + bj * HALF + n * 4);
#pragma unroll
        for (int ai = 0; ai < 2; ++ai) {
            f32x4 bs[4][2][2];
#pragma unroll
            for (int m = 0; m < 4; ++m) { const size_t off = (size_t)(row0 + ai * HALF + m * 16) * ldc + col0;
#pragma unroll
                for (int bj = 0; bj < 2; ++bj)
#pragma unroll
                    for (int n = 0; n < 2; ++n) bs[m][bj][n] = *(const f32x4*)(base + off + bj * HALF + n * 4); }
#pragma unroll
            for (int m = 0; m < 4; ++m) { const size_t off = (size_t)(row0 + ai * HALF + m * 16) * ldc + col0; float sq = 0.f;
#pragma unroll
                for (int bj = 0; bj < 2; ++bj) { const f32x4 o0 = bs[m][bj][0] + gv[bj][0] * acc[ai][bj][m][0], o1 = bs[m][bj][1] + gv[bj][1] * acc[ai][bj][m][1];
                    u32x4 w; w.x = cvt_pk_bf16(o0[0], o0[1]); w.y = cvt_pk_bf16(o0[2], o0[3]); w.z = cvt_pk_bf16(o1[0], o1[1]); w.w = cvt_pk_bf16(o1[2], o1[3]);
                    *(u32x4*)(out + off + bj * HALF) = w;
                    sq += ((o0[0] * o0[0] + o0[1] * o0[1]) + (o0[2] * o0[2] + o0[3] * o0[3])) + ((o1[0] * o1[0] + o1[1] * o1[1]) + (o1[2] * o1[2] + o1[3] * o1[3])); }
                sq += __shfl_xor(sq, 16); sq += __shfl_xor(sq, 32);
                if (fq == 0) ssq[(size_t)(row0 + ai * HALF + m * 16) * 32 + 4 * u.pn + wc] = sq; }
            asm volatile("" ::: "memory"); }
    }
};
struct EpiSwiglu {
    static constexpr bool PERM = true, AFTER_DRAIN = false, MID = false;
    bf16_t* O; int ldc; const float* bias; int de;
    __device__ __forceinline__ void operator()(const f32x4 (&acc)[2][2][4][2], const Unit& u, int wr, int wc, int fr, int fq) const {
        const int row0 = u.pm * BM + wr * 64 + fr, cl = u.pn * HALF + wc * 32 + 8 * fq;
        const float* bb = bias + (size_t)u.e * 2 * de + cl;
        f32x4 bg[2], bl[2];
#pragma unroll
        for (int n = 0; n < 2; ++n) { bg[n] = *(const f32x4*)(bb + 4 * n); bl[n] = *(const f32x4*)(bb + de + 4 * n); }
#pragma unroll
        for (int ai = 0; ai < 2; ++ai)
#pragma unroll
            for (int m = 0; m < 4; ++m) { bf16_t* rowp = O + (size_t)(row0 + ai * HALF + m * 16) * ldc + cl;
                f32x4 a[2];
#pragma unroll
                for (int n = 0; n < 2; ++n) { const f32x4 g = acc[ai][0][m][n] + bg[n], l = acc[ai][1][m][n] + bl[n];
#pragma unroll
                    for (int j = 0; j < 4; ++j) { const float gg = fminf(g[j], 7.0f), ll = fminf(fmaxf(l[j], -7.0f), 7.0f); a[n][j] = gg * sigm(1.702f * gg) * (ll + 1.0f); } }
                u32x4 w; w.x = cvt_pk_bf16(a[0][0], a[0][1]); w.y = cvt_pk_bf16(a[0][2], a[0][3]); w.z = cvt_pk_bf16(a[1][0], a[1][1]); w.w = cvt_pk_bf16(a[1][2], a[1][3]);
                *(u32x4*)rowp = w; }
    }
};
__device__ __forceinline__ float clamp448(float v) { return fminf(fmaxf(v, -448.0f), 448.0f); }
struct EpiSwigluF8 {
    static constexpr bool PERM = true, AFTER_DRAIN = false, MID = false;
    unsigned char* O; int ldc; const float* bias; int de; float ascale, oscale;
    __device__ __forceinline__ void operator()(const f32x4 (&acc)[2][2][4][2], const Unit& u, int wr, int wc, int fr, int fq) const {
        const int row0 = u.pm * BM + wr * 64 + fr, cl = u.pn * HALF + wc * 32 + 8 * fq;
        const float* bb = bias + (size_t)u.e * 2 * de + cl;
        f32x4 bg[2], bl[2];
#pragma unroll
        for (int n = 0; n < 2; ++n) { bg[n] = *(const f32x4*)(bb + 4 * n); bl[n] = *(const f32x4*)(bb + de + 4 * n); }
#pragma unroll
        for (int ai = 0; ai < 2; ++ai)
#pragma unroll
            for (int m = 0; m < 4; ++m) { unsigned char* rowp = O + (size_t)(row0 + ai * HALF + m * 16) * ldc + cl;
                f32x4 a[2];
#pragma unroll
                for (int n = 0; n < 2; ++n) { const f32x4 g = acc[ai][0][m][n] * ascale + bg[n], l = acc[ai][1][m][n] * ascale + bl[n];
                    f32x4 gg, ll, ex, rc;
#pragma unroll
                    for (int j = 0; j < 4; ++j) { gg[j] = fminf(g[j], 7.0f); ll[j] = __builtin_amdgcn_fmed3f(l[j], -7.0f, 7.0f); }
                    const f32x4 t = gg * (-1.702f * 1.44269504089f);
#pragma unroll
                    for (int j = 0; j < 4; ++j) ex[j] = __builtin_amdgcn_exp2f(t[j]);
                    const f32x4 d = ex + 1.0f;
#pragma unroll
                    for (int j = 0; j < 4; ++j) rc[j] = __builtin_amdgcn_rcpf(d[j]);
                    a[n] = (gg * rc) * (ll * oscale + oscale); }
                int w0 = 0, w1 = 0;
                w0 = __builtin_amdgcn_cvt_pk_fp8_f32(a[0][0], a[0][1], w0, false); w0 = __builtin_amdgcn_cvt_pk_fp8_f32(a[0][2], a[0][3], w0, true);
                w1 = __builtin_amdgcn_cvt_pk_fp8_f32(a[1][0], a[1][1], w1, false); w1 = __builtin_amdgcn_cvt_pk_fp8_f32(a[1][2], a[1][3], w1, true);
                u32x2 w; w.x = (unsigned)w0; w.y = (unsigned)w1; *(u32x2*)rowp = w; }
    }
};
struct EpiDown {
    static constexpr bool PERM = true, AFTER_DRAIN = false, MID = false;
    unsigned char* O; int ldc; const float* bias; const float* sw; float ascale, oscale;
    __device__ __forceinline__ void operator()(const f32x4 (&acc)[2][2][4][2], const Unit& u, int wr, int wc, int fr, int fq) const {
        const int row0 = u.pm * BM + wr * 64 + fr, col0 = u.pn * BM + wc * 32 + 8 * fq;
        const float* bb = bias + (size_t)u.e * ldc + col0;
        f32x4 bv[2][2];
#pragma unroll
        for (int bj = 0; bj < 2; ++bj)
#pragma unroll
            for (int n = 0; n < 2; ++n) bv[bj][n] = *(const f32x4*)(bb + bj * HALF + 4 * n);
#pragma unroll
        for (int ai = 0; ai < 2; ++ai)
#pragma unroll
            for (int m = 0; m < 4; ++m) { const int r = row0 + ai * HALF + m * 16; const float w8 = sw[r] * oscale; unsigned char* rowp = O + (size_t)r * ldc + col0;
#pragma unroll
                for (int bj = 0; bj < 2; ++bj) { f32x4 v0 = (acc[ai][bj][m][0] * ascale + bv[bj][0]) * w8, v1 = (acc[ai][bj][m][1] * ascale + bv[bj][1]) * w8;
#pragma unroll
                    for (int j = 0; j < 4; ++j) { v0[j] = __builtin_amdgcn_fmed3f(v0[j], -448.0f, 448.0f); v1[j] = __builtin_amdgcn_fmed3f(v1[j], -448.0f, 448.0f); }
                    int w0 = 0, w1 = 0;
                    w0 = __builtin_amdgcn_cvt_pk_fp8_f32(v0[0], v0[1], w0, false); w0 = __builtin_amdgcn_cvt_pk_fp8_f32(v0[2], v0[3], w0, true);
                    w1 = __builtin_amdgcn_cvt_pk_fp8_f32(v1[0], v1[1], w1, false); w1 = __builtin_amdgcn_cvt_pk_fp8_f32(v1[2], v1[3], w1, true);
                    u32x2 w; w.x = (unsigned)w0; w.y = (unsigned)w1; *(u32x2*)(rowp + bj * HALF) = w; } }
    }
};
struct EpiNull {
    static constexpr bool PERM = false, AFTER_DRAIN = false, MID = false;
    float* dummy;
    __device__ __forceinline__ void operator()(const f32x4 (&acc)[2][2][4][2], const Unit& u, int wr, int wc, int fr, int fq) const {
        f32x4 s = (f32x4){0.f, 0.f, 0.f, 0.f};
#pragma unroll
        for (int ai = 0; ai < 2; ++ai)
#pragma unroll
            for (int bj = 0; bj < 2; ++bj)
#pragma unroll
                for (int m = 0; m < 4; ++m)
#pragma unroll
                    for (int n = 0; n < 2; ++n) s = s + acc[ai][bj][m][n];
        const float t = (s[0] + s[1]) + (s[2] + s[3]);
        if (t == 123456.789f) dummy[u.pm * 64 + u.pn] = t;
    }
};
struct PairOrder : StaticOrder {
    static constexpr bool PAIRS = true;
    __device__ bool next(int i, Unit& u) const { if (!StaticOrder::next(i >> 1, u)) return false; u.kh = i & 1; return true; }
};
struct FixedOrder : StaticOrder {
    static constexpr bool PAIRS = false;
    __device__ bool next(int i, Unit& u) const { if (i >= 2) return false; u.pm = 0; u.pn = 0; u.e = 0; u.kh = 0; return true; }
};
struct GroupedOrder : StaticOrder {
    static constexpr bool PAIRS = false;
    const int* tile_e;
    __device__ bool next(int i, Unit& u) const { if (!StaticOrder::next(i, u)) return false; u.e = tile_e[u.pm]; return true; }
};
template <class Epi, class Sched, bool ALIGN_EPI = false, bool SP2 = false, bool GATHER = false, bool F8 = false>
__device__ __forceinline__ void gemm_phase(PG8_LAS unsigned char* lds, const Gemm g, const Sched& S, const Epi& E) {
    const int tid = threadIdx.x, wid = __builtin_amdgcn_readfirstlane(tid >> 6), lane = tid & 63, wr = wid >> 2, wc = wid & 3, fr = lane & 15, fq = lane >> 4;
    const int K = g.K, nt = K / BK;
    unsigned voffA[2], voffB[2];
#pragma unroll
    for (int i = 0; i < 2; ++i) { int R, C; stage_rc(tid * 16 + i * 8192, R, C); const int Rb = Epi::PERM ? ((R & ~31) + perm32(R & 31)) : R;
        voffA[i] = (unsigned)(R * K + C) * 2u; voffB[i] = (unsigned)(Rb * K + C) * 2u; }
    static_assert(SP2 || !GATHER, "the gathered-A path is written for the SP2 loop only");
    unsigned gc0[2] = {0u, 0u}, gc1[2] = {0u, 0u}, gn0[2] = {0u, 0u}, gn1[2] = {0u, 0u};
    auto load_gather = [&](const Unit& u, unsigned (&o0)[2], unsigned (&o1)[2]) {
#pragma unroll
        for (int i = 0; i < 2; ++i) { int R, C; stage_rc(tid * 16 + i * 8192, R, C); const int t0 = g.gather[u.pm * BM + R], t1 = g.gather[u.pm * BM + HALF + R];
            o0[i] = (unsigned)(t0 * K + C) * 2u; o1[i] = (unsigned)(t1 * K + C) * 2u; } };
    const size_t kstep = (size_t)(BK * 2);
    const size_t hstep = (size_t)HALF * K * 2;
    const size_t tstep = 2 * hstep;
    const unsigned ldsw = (unsigned)wid * 1024u;
    const int aoff = lds_byte(wr * 64 + fr, F8 ? fq * 16 : fq * 8), boff = lds_byte(wc * 32 + fr, F8 ? fq * 16 : fq * 8);
    const int sc1 = 0x7f7f7f7f;
    constexpr int KFR = F8 ? 16 : 1024;
#define PG8_SA(b, h) (((b) * 2 + (h)) * HTB)
#define PG8_SB(b, h) ((4 + (b) * 2 + (h)) * HTB)
#define PG8_STAGE(bufoff, gbase, voff) do { _Pragma("unroll") for (int _i = 0; _i < 2; ++_i) \
        __builtin_amdgcn_global_load_lds((const unsigned*)((const char*)(gbase) + (voff)[_i]), (PG8_LAS unsigned*)(lds + (bufoff) + ldsw + _i * 8192), 16, 0, 0); } while (0)
#define PG8_STAGE_A(bufoff, gbase, hh, nx) do { if constexpr (GATHER) { _Pragma("unroll") for (int _i = 0; _i < 2; ++_i) { const unsigned _o = (nx) ? ((hh) ? gn1[_i] : gn0[_i]) : ((hh) ? gc1[_i] : gc0[_i]); \
        __builtin_amdgcn_global_load_lds((const unsigned*)((const char*)(gbase) + _o), (PG8_LAS unsigned*)(lds + (bufoff) + ldsw + _i * 8192), 16, 0, 0); } } \
        else { PG8_STAGE(bufoff, (gbase) + ((hh) ? hstep : 0), voffA); } } while (0)
#define PG8_LDA(dst, b, h) do { _Pragma("unroll") for (int m = 0; m < 4; ++m) _Pragma("unroll") for (int k = 0; k < 2; ++k) dst[m][k] = *(const PG8_LAS bf16x8*)(lds + PG8_SA(b, h) + aoff + m * 2048 + k * KFR); } while (0)
#define PG8_LDB(dst, b, h) do { _Pragma("unroll") for (int n = 0; n < 2; ++n) _Pragma("unroll") for (int k = 0; k < 2; ++k) dst[n][k] = *(const PG8_LAS bf16x8*)(lds + PG8_SB(b, h) + boff + n * 2048 + k * KFR); } while (0)
#define PG8_V8(x) __builtin_shufflevector(__builtin_bit_cast(i32x4_t, (x)[0]), __builtin_bit_cast(i32x4_t, (x)[1]), 0, 1, 2, 3, 4, 5, 6, 7)
#define PG8_MMA(ai, bj, At, Bt) do { __builtin_amdgcn_s_setprio(1); if constexpr (F8) { _Pragma("unroll") for (int m = 0; m < 4; ++m) _Pragma("unroll") for (int n = 0; n < 2; ++n) \
        asm volatile("v_mfma_scale_f32_16x16x128_f8f6f4 %0, %1, %2, %0, %3, %3 op_sel_hi:[0,0,0]" : "+v"(acc[ai][bj][m][n]) : "v"(PG8_V8(Bt[n])), "v"(PG8_V8(At[m])), "v"(sc1)); } else { \
        _Pragma("unroll") for (int m = 0; m < 4; ++m) _Pragma("unroll") for (int n = 0; n < 2; ++n) _Pragma("unroll") for (int k = 0; k < 2; ++k) \
        acc[ai][bj][m][n] = __builtin_amdgcn_mfma_f32_16x16x32_bf16(Bt[n][k], At[m][k], acc[ai][bj][m][n], 0, 0, 0); } __builtin_amdgcn_s_setprio(0); } while (0)
#define PG8_WAIT_V(n) asm volatile("s_waitcnt vmcnt(" #n ")" ::: "memory")
#define PG8_WAIT_L(n) asm volatile("s_waitcnt lgkmcnt(" #n ")" ::: "memory")
#define PG8_BAR __builtin_amdgcn_s_barrier()
#define PG8_SCHED __builtin_amdgcn_sched_barrier(0)
    Unit cur, nxt; int ui = 0;
    if (!S.next(0, cur)) return;
    f32x4 acc[2][2][4][2];
#pragma unroll
    for (int a = 0; a < 2; ++a)
#pragma unroll
        for (int b = 0; b < 2; ++b)
#pragma unroll
            for (int m = 0; m < 4; ++m)
#pragma unroll
                for (int n = 0; n < 2; ++n) acc[a][b][m][n] = (f32x4){0.f, 0.f, 0.f, 0.f};
    bf16x8 At[4][2], B0[2][2], B1[2][2];
    const char* cA = (const char*)((Sched::PAIRS && cur.kh) ? g.A2 : g.A) + (GATHER ? (size_t)0 : (size_t)cur.pm * tstep); const char* cB = (const char*)((Sched::PAIRS && cur.kh) ? g.Bt2 : g.Bt) + (size_t)cur.e * g.bgs + (size_t)cur.pn * tstep;
    S.a_ready(cur);
    if constexpr (GATHER) load_gather(cur, gc0, gc1);
    if constexpr (SP2) {
        PG8_STAGE(PG8_SB(0, 0), cB, voffB); PG8_STAGE(PG8_SB(0, 1), cB + hstep, voffB); PG8_STAGE_A(PG8_SA(0, 0), cA, 0, false); PG8_STAGE_A(PG8_SA(0, 1), cA, 1, false);
        if (wr == 1) PG8_BAR;
        PG8_WAIT_V(2); PG8_BAR;
        PG8_STAGE(PG8_SB(1, 0), cB + kstep, voffB); PG8_STAGE_A(PG8_SA(1, 0), cA + kstep, 0, false); PG8_STAGE(PG8_SB(1, 1), cB + hstep + kstep, voffB);
        PG8_WAIT_V(6); PG8_BAR;
    } else {
        PG8_STAGE(PG8_SB(0, 0), cB, voffB); PG8_STAGE(PG8_SA(0, 0), cA, voffA); PG8_STAGE(PG8_SB(0, 1), cB + hstep, voffB); PG8_STAGE(PG8_SA(0, 1), cA + hstep, voffA);
        if (wr == 1) PG8_BAR;
        PG8_WAIT_V(4); PG8_BAR;
        PG8_STAGE(PG8_SB(1, 0), cB + kstep, voffB); PG8_STAGE(PG8_SA(1, 0), cA + kstep, voffA); PG8_STAGE(PG8_SB(1, 1), cB + hstep + kstep, voffB);
        PG8_WAIT_V(6); PG8_BAR;
    }
    for (;;) {
        const bool has_next = S.next(ui + 1, nxt);
        const char* nA = has_next ? (const char*)((Sched::PAIRS && nxt.kh) ? g.A2 : g.A) + (GATHER ? (size_t)0 : (size_t)nxt.pm * tstep) : cA;
        if constexpr (GATHER) { if (has_next) load_gather(nxt, gn0, gn1); else { gn0[0] = gc0[0]; gn0[1] = gc0[1]; gn1[0] = gc1[0]; gn1[1] = gc1[1]; } } const char* nB = has_next ? (const char*)((Sched::PAIRS && nxt.kh) ? g.Bt2 : g.Bt) + (size_t)nxt.e * g.bgs + (size_t)nxt.pn * tstep : cB;
        for (int t = 0; t < nt; t += 2) {
            const bool last = (t == nt - 2);
            const char* a1 = cA + (size_t)(t + 1) * kstep;
            const char* a2 = last ? nA : cA + (size_t)(t + 2) * kstep; const char* b2 = last ? nB : cB + (size_t)(t + 2) * kstep;
            const char* a3 = a2 + kstep; const char* b3 = b2 + kstep;
            if (last && has_next) S.a_ready(nxt);
            if constexpr (SP2) {
            PG8_LDB(B0, 0, 0); PG8_LDB(B1, 0, 1); PG8_SCHED; PG8_LDA(At, 0, 0); PG8_STAGE_A(PG8_SA(1, 1), a1, 1, false);
            PG8_WAIT_V(8); PG8_WAIT_L(0); PG8_BAR; PG8_MMA(0, 0, At, B0); PG8_MMA(0, 1, At, B1); PG8_BAR; PG8_SCHED;
            PG8_LDA(At, 0, 1); PG8_STAGE(PG8_SB(0, 0), b2, voffB); PG8_STAGE(PG8_SB(0, 1), b2 + hstep, voffB); PG8_STAGE_A(PG8_SA(0, 0), a2, 0, last);
            PG8_WAIT_V(8); PG8_WAIT_L(0); PG8_BAR; PG8_MMA(1, 0, At, B0); PG8_MMA(1, 1, At, B1); PG8_BAR; PG8_SCHED;
            PG8_LDB(B0, 1, 0); PG8_LDB(B1, 1, 1); PG8_SCHED; PG8_LDA(At, 1, 0); PG8_STAGE_A(PG8_SA(0, 1), a2, 1, last);
            PG8_WAIT_V(8); PG8_WAIT_L(0); PG8_BAR; PG8_MMA(0, 0, At, B0); PG8_MMA(0, 1, At, B1); PG8_BAR; PG8_SCHED;
            PG8_LDA(At, 1, 1); PG8_STAGE(PG8_SB(1, 0), b3, voffB); PG8_STAGE(PG8_SB(1, 1), b3 + hstep, voffB); PG8_STAGE_A(PG8_SA(1, 0), a3, 0, last);
            PG8_WAIT_V(8); PG8_WAIT_L(0); PG8_BAR; PG8_MMA(1, 0, At, B0); PG8_MMA(1, 1, At, B1); PG8_BAR; PG8_SCHED;
            } else {
            PG8_LDB(B0, 0, 0); PG8_SCHED; PG8_LDA(At, 0, 0); PG8_STAGE(PG8_SA(1, 1), a1 + hstep, voffA);
            PG8_WAIT_L(8); PG8_BAR; PG8_WAIT_L(0); PG8_MMA(0, 0, At, B0); PG8_BAR; PG8_SCHED;
            PG8_LDB(B1, 0, 1); PG8_STAGE(PG8_SB(0, 0), b2, voffB);
            PG8_BAR; PG8_WAIT_L(0); PG8_MMA(0, 1, At, B1); PG8_BAR;
            PG8_LDA(At, 0, 1); PG8_STAGE(PG8_SA(0, 0), a2, voffA);
            PG8_BAR; PG8_WAIT_L(0); PG8_MMA(1, 0, At, B0); PG8_BAR; PG8_SCHED;
            PG8_STAGE(PG8_SB(0, 1), b2 + hstep, voffB);
            PG8_WAIT_V(6); PG8_BAR; PG8_MMA(1, 1, At, B1); PG8_BAR;
            PG8_LDB(B0, 1, 0); PG8_SCHED; PG8_LDA(At, 1, 0); PG8_STAGE(PG8_SA(0, 1), a2 + hstep, voffA);
            PG8_WAIT_L(8); PG8_BAR; PG8_WAIT_L(0); PG8_MMA(0, 0, At, B0); PG8_BAR; PG8_SCHED;
            PG8_LDB(B1, 1, 1); PG8_STAGE(PG8_SB(1, 0), b3, voffB);
            PG8_BAR; PG8_WAIT_L(0); PG8_MMA(0, 1, At, B1); PG8_BAR;
            PG8_LDA(At, 1, 1); PG8_STAGE(PG8_SA(1, 0), a3, voffA);
            PG8_BAR; PG8_WAIT_L(0); PG8_MMA(1, 0, At, B0); PG8_BAR; PG8_SCHED;
            PG8_STAGE(PG8_SB(1, 1), b3 + hstep, voffB);
            PG8_WAIT_V(6); PG8_BAR; PG8_MMA(1, 1, At, B1); PG8_BAR;
            }
        }
        if constexpr (ALIGN_EPI) { if (wr == 0) PG8_BAR; }
        if constexpr (!Epi::AFTER_DRAIN) { if constexpr (Epi::MID) { if (cur.kh == 0) E.mid(acc, cur, wr, wc, fr, fq); else E(acc, cur, wr, wc, fr, fq); } else E(acc, cur, wr, wc, fr, fq); S.done(cur); }
        if (!has_next) break;
        if (!(Epi::MID && cur.kh == 0)) {
#pragma unroll
        for (int a = 0; a < 2; ++a)
#pragma unroll
            for (int b = 0; b < 2; ++b)
#pragma unroll
                for (int m = 0; m < 4; ++m)
#pragma unroll
                    for (int n = 0; n < 2; ++n) acc[a][b][m][n] = (f32x4){0.f, 0.f, 0.f, 0.f}; }
        cur = nxt; cA = nA; cB = nB; ++ui;
        if constexpr (GATHER) { gc0[0] = gn0[0]; gc0[1] = gn0[1]; gc1[0] = gn1[0]; gc1[1] = gn1[1]; }
        if constexpr (ALIGN_EPI) { if (wr == 1) PG8_BAR; }
    }
    PG8_WAIT_V(0);
    if constexpr (!ALIGN_EPI) { if (wr == 0) PG8_BAR; }
    PG8_BAR;
    if constexpr (Epi::AFTER_DRAIN) { E.fused(acc, cur, wr, wc, fr, fq, lds, wid, lane); S.done(cur); }
#undef PG8_SA
#undef PG8_SB
#undef PG8_STAGE
#undef PG8_STAGE_A
#undef PG8_LDA
#undef PG8_LDB
#undef PG8_MMA
#undef PG8_V8
#undef PG8_WAIT_V
#undef PG8_WAIT_L
#undef PG8_BAR
#undef PG8_SCHED
}
}

#ifndef PG8_SP2
#define PG8_SP2 true
#endif
#ifndef PG8_ALIGN
#define PG8_ALIGN true
#endif
constexpr int NWAVES = 8;
#ifndef MK_N_LAUNCHES
#define MK_N_LAUNCHES 1
#endif
constexpr int N_PHASES = 14;
constexpr int N_LAUNCHES = MK_N_LAUNCHES;

constexpr int D = 2048, NB = 8, SEQ = 2048, M = NB * SEQ;
constexpr int RW = 1024, RNH = 16;
constexpr int RWKV_COLS = 3360, HG_BASE = 3584, GATE_BASE = 7680, NPROJ = 11776;
constexpr int IN_COLS = 11552;
constexpr int HNH = 8;
constexpr int NE = 32, DE = 2048, NASSIGN = M * 4;
constexpr int LORA_K = 384, LORA_N = 3072;
constexpr int MAXTILES = 288, MAXSLOTS = MAXTILES * 256;
constexpr float NORM_EPS = 1e-5f, GN_EPS = 64e-5f;

constexpr size_t MiB = 1u << 20;
constexpr size_t WS_CTL = 0, CTL_ZERO_BYTES = 32768;
constexpr size_t WS_MODP = 2 * MiB;
constexpr size_t WS_MOD = 8 * MiB;
constexpr size_t WS_RWP = 9 * MiB;
constexpr size_t WS_ROUTE = 10 * MiB;
constexpr size_t WS_WLORA = 14 * MiB;
constexpr size_t WS_WIN = 18 * MiB;
constexpr size_t WS_WPA = 64 * MiB, WS_WPB = 68 * MiB, WS_WOUT = 72 * MiB;
constexpr size_t WS_WGU = 80 * MiB;
constexpr size_t WS_WDN = 592 * MiB;
constexpr size_t WS_H = 848 * MiB;
constexpr size_t WS_PROJ = 912 * MiB;
constexpr size_t WS_LORA_A = 1280 * MiB;
constexpr size_t WS_LORA_O = 1292 * MiB;
constexpr size_t WS_YA = 1484 * MiB, WS_YB = 1516 * MiB;
constexpr size_t WS_OHG = 1548 * MiB;
constexpr size_t WS_T1 = 1612 * MiB;
constexpr size_t WS_MERGED = 1740 * MiB;
constexpr size_t WS_X1 = 1804 * MiB;
constexpr size_t WS_XG = 1932 * MiB;
constexpr size_t WS_ACT = 2220 * MiB;
constexpr size_t WS_YE = 2508 * MiB;
constexpr size_t WS_END = 2796 * MiB;
constexpr size_t RT_E = 0, RT_RANK = 262144, RT_GATE = 524288, RT_TOKSLOT = 786432, RT_SLOTW = 1048576, RT_TILEE = 1048576 + 524288, RT_SLOTTOK = 2097152;
constexpr int CW_TMO = 0, CW_CODE = 1;
constexpr int CW_CNT = 64;
constexpr int CW_BAR = 4096;
constexpr int LDS_BYTES = 147456;
constexpr int MISC_OFF = LDS_BYTES - 256;
constexpr int SCR_BYTES = MISC_OFF;

#define GAS __attribute__((address_space(1)))
#define LAS __attribute__((address_space(3)))
typedef unsigned short bf16;
typedef unsigned v4u __attribute__((ext_vector_type(4)));
typedef unsigned v2u __attribute__((ext_vector_type(2)));
typedef float f32x4 __attribute__((ext_vector_type(4)));
typedef float f32x2 __attribute__((ext_vector_type(2)));
typedef GAS unsigned gu32;
#define RLX_AGENT __ATOMIC_RELAXED, __HIP_MEMORY_SCOPE_AGENT
#define LDS_WAIT() asm volatile("s_waitcnt lgkmcnt(0)" ::: "memory")
#define VM_WAIT() asm volatile("s_waitcnt vmcnt(0)" ::: "memory")
typedef __bf16 bf16x2_hw __attribute__((ext_vector_type(2)));
__device__ __forceinline__ unsigned pk2(float lo, float hi) { const f32x2 v = {lo, hi}; const bf16x2_hw r = __builtin_convertvector(v, bf16x2_hw); return __builtin_bit_cast(unsigned, r); }
__device__ __forceinline__ unsigned f2bf(float f) { return pk2(f, f) & 0xffffu; }
__device__ __forceinline__ float bf2f(unsigned short h) { return __uint_as_float(((unsigned)h) << 16); }
__device__ __forceinline__ float bflo(unsigned w) { return __uint_as_float(w << 16); }
__device__ __forceinline__ float bfhi(unsigned w) { return __uint_as_float(w & 0xffff0000u); }
__device__ __forceinline__ float sigmoidf_(float x) { return __builtin_amdgcn_rcpf(1.0f + __expf(-x)); }

#define XB_TMO      128
#define XB_XCNT(j)  (256  + 64 * (j))
#define XB_XSUB(j)  (1280 + 64 * (j))
#define XB_XGEN(j)  (2304 + 64 * (j))
#define XB_TOP      3328
#define XB_TOPGEN   3392
#define XCD_BAR_WORDS 3456
#define XB_SPIN_CAP (1u << 18)
__device__ __forceinline__ unsigned xb_ld(unsigned* p)              { return __hip_atomic_load(p, __ATOMIC_RELAXED, __HIP_MEMORY_SCOPE_AGENT); }
__device__ __forceinline__ unsigned xb_add(unsigned* p, unsigned v) { return __hip_atomic_fetch_add(p, v, __ATOMIC_RELAXED, __HIP_MEMORY_SCOPE_AGENT); }
__device__ __forceinline__ unsigned xb_xcc_id() { return (unsigned)__builtin_amdgcn_s_getreg((3 << 11) | 20) & 0xFu; }
#define XB_SPIN(cond, bar) do { unsigned _sp = 0; while (cond) { __builtin_amdgcn_s_sleep(1); \
    if ((++_sp & 255u) == 0u) { if (xb_ld(&(bar)[XB_TMO])) break; if (_sp > XB_SPIN_CAP) { atomicAdd(&(bar)[XB_TMO], 1u); break; } } } } while (0)
struct XcdBarrier { unsigned* bar; unsigned x; volatile LAS unsigned* st; };
__device__ __forceinline__ XcdBarrier xcd_barrier_post(unsigned* bar, volatile LAS unsigned* st) {
    XcdBarrier b; b.bar = bar; b.x = xb_xcc_id(); b.st = st;
    if (threadIdx.x == 0) (void)xb_add(&bar[XB_XCNT(b.x)], 1u);
    return b;
}
__device__ __forceinline__ void xcd_barrier_complete(unsigned* bar, unsigned x, unsigned& nloc, unsigned& nx) {
    const unsigned G = gridDim.x * gridDim.y * gridDim.z;
    unsigned sum, cnt, mine, sp = 0u;
    for (;;) {
        sum = 0u; cnt = 0u; mine = 0u;
#pragma unroll
        for (unsigned j = 0; j < 16; ++j) { const unsigned c = xb_ld(&bar[XB_XCNT(j)]); sum += c; cnt += (c > 0u) ? 1u : 0u; mine = (j == x) ? c : mine; }
        if (sum == G) break;
        __builtin_amdgcn_s_sleep(1);
        if ((++sp & 255u) == 0u) { if (xb_ld(&bar[XB_TMO])) break; if (sp > XB_SPIN_CAP) { atomicAdd(&bar[XB_TMO], 1u); break; } }
    }
    nloc = mine > 0u ? mine : 1u; nx = cnt > 0u ? cnt : 1u;
}
__device__ __forceinline__ void xcd_barrier(const XcdBarrier& b) {
    asm volatile("s_waitcnt vmcnt(0)" ::: "memory");
    __syncthreads();
    if (threadIdx.x == 0) {
        unsigned* bar = b.bar;
        __builtin_amdgcn_s_waitcnt(0);
        unsigned nloc = b.st[0], nx = b.st[1];
        if (nloc == 0u) { xcd_barrier_complete(bar, b.x, nloc, nx); b.st[0] = nloc; b.st[1] = nx; }
        const unsigned old = xb_add(&bar[XB_XSUB(b.x)], 1u);
        const unsigned gen = old / nloc;
        if (old + 1u == (gen + 1u) * nloc) {
            __builtin_amdgcn_fence(__ATOMIC_RELEASE, "agent");
            asm volatile("s_waitcnt vmcnt(0)" ::: "memory");
            const unsigned og = xb_add(&bar[XB_TOP], 1u);
            const unsigned tg = og / nx;
            if (og + 1u == (tg + 1u) * nx) xb_add(&bar[XB_TOPGEN], 1u);
            else XB_SPIN(xb_ld(&bar[XB_TOPGEN]) == tg, bar);
            __builtin_amdgcn_fence(__ATOMIC_ACQUIRE, "agent");
            xb_add(&bar[XB_XGEN(b.x)], 1u);
            asm volatile("s_waitcnt vmcnt(0)" ::: "memory");
        } else {
            XB_SPIN(xb_ld(&bar[XB_XGEN(b.x)]) == gen, bar);
            __builtin_amdgcn_fence(__ATOMIC_ACQUIRE, "agent");
            asm volatile("s_waitcnt vmcnt(0)" ::: "memory");
        }
    }
    __syncthreads();
}

struct Args { const float* in[30]; float* out; unsigned char* ws; int ph_lo, ph_hi, li, pad; };
struct Frame {
    LAS unsigned char* lds;
    volatile LAS unsigned* MISC;
    gu32* ctl;
    unsigned char* ws;
    int tid, lane, wave;
    int vcu, G;
};
__device__ __forceinline__ float wave_sum(float v) {
#pragma unroll
    for (int o = 1; o < 64; o <<= 1) v += __shfl_xor(v, o);
    return v;
}
template <int CTRL> __device__ __forceinline__ float dpp_mov(float v) { return __builtin_bit_cast(float, __builtin_amdgcn_update_dpp(0, __builtin_bit_cast(int, v), CTRL, 0xf, 0xf, false)); }
__device__ __forceinline__ float red8(float v) {
    v += dpp_mov<0xB1>(v);
    v += dpp_mov<0x4E>(v);
    v += dpp_mov<0x141>(v);
    return v;
}

struct TItem { const float* src; bf16* dst; int N, Kd; };
constexpr int P0_I_IN = 32 * (IN_COLS / 32), P0_I_PA = 16 * 64, P0_I_OUT = 32 * 64;
constexpr int P0_NITEMS = P0_I_IN + 2 * P0_I_PA + P0_I_OUT;
__device__ __forceinline__ TItem p0_decode(const Args& args, unsigned char* ws, int it) {
    TItem t; int r = it;
    if (r < P0_I_IN) { const int nblk = IN_COLS / 32, kb = r / nblk, nb = r % nblk, n0 = nb * 32; const int dr = n0 + (n0 >= RWKV_COLS ? (HG_BASE - RWKV_COLS) : 0);
        t.src = args.in[6] + (size_t)(kb * 64) * IN_COLS + n0; t.N = IN_COLS; t.dst = (bf16*)(ws + WS_WIN) + (size_t)dr * D + kb * 64; t.Kd = D; return t; }
    r -= P0_I_IN;
    if (r < P0_I_PA) { const int kb = r / 64, nb = r % 64; t.src = args.in[20] + (size_t)(kb * 64) * D + nb * 32; t.N = D; t.dst = (bf16*)(ws + WS_WPA) + (size_t)(nb * 32) * RW + kb * 64; t.Kd = RW; return t; }
    r -= P0_I_PA;
    if (r < P0_I_PA) { const int kb = r / 64, nb = r % 64; t.src = args.in[21] + (size_t)(kb * 64) * D + nb * 32; t.N = D; t.dst = (bf16*)(ws + WS_WPB) + (size_t)(nb * 32) * RW + kb * 64; t.Kd = RW; return t; }
    r -= P0_I_PA;
    if (r < P0_I_OUT) { const int kb = r / 64, nb = r % 64; t.src = args.in[22] + (size_t)(kb * 64) * D + nb * 32; t.N = D; t.dst = (bf16*)(ws + WS_WOUT) + (size_t)(nb * 32) * D + kb * 64; t.Kd = D; return t; }
    t.src = nullptr; t.dst = nullptr; t.N = 0; t.Kd = 0; return t;
}
__device__ __forceinline__ void p0_issue(const TItem& t, f32x4 (&v)[8], int lane) {
    const GAS f32x4* src = (const GAS f32x4*)((const GAS float*)t.src + (size_t)(lane >> 3) * t.N + 4 * (lane & 7));
#pragma unroll
    for (int i = 0; i < 8; ++i) v[i] = __builtin_nontemporal_load(src + (size_t)(2 * i) * t.N);
}
__device__ __forceinline__ void p0_finish(const TItem& t, const f32x4 (&v)[8], LAS float* scr, int lane) {
#pragma unroll
    for (int i = 0; i < 8; ++i) *(LAS f32x4*)(scr + (8 * i + (lane >> 3)) * 32 + (((lane & 7) ^ i) << 2)) = v[i];
    LDS_WAIT(); asm volatile("" ::: "memory");
    const int c = lane & 7;
#pragma unroll
    for (int j = 0; j < 4; ++j) { const int n = (lane >> 3) + 8 * j; const LAS float* s = scr + (8 * c) * 32 + ((((n >> 2) ^ c) << 2) | (n & 3));
        v4u o; o.x = pk2(s[0 * 32], s[1 * 32]); o.y = pk2(s[2 * 32], s[3 * 32]); o.z = pk2(s[4 * 32], s[5 * 32]); o.w = pk2(s[6 * 32], s[7 * 32]);
        *(GAS v4u*)(t.dst + (size_t)n * t.Kd + 8 * c) = o; }
    LDS_WAIT(); asm volatile("" ::: "memory");
}

__device__ __forceinline__ void p0_convert(Frame& F, const Args& args, int lo, int hi, int gw, int NGW, int nlight) {
    LAS float* scr = (LAS float*)(F.lds + F.wave * 8448);
    unsigned char* ws = F.ws;
    const int nA = NGW > nlight ? NGW - nlight : 0, nit = hi - lo, itemsA = nA * 16 < nit ? nA * 16 : nit;
    auto item_of = [&](int idx) -> int {
        if (gw >= nlight && idx < 16) { const int a = (gw - nlight) + nA * idx; return a < itemsA ? lo + a : hi + 1000000; }
        const int j = (gw >= nlight) ? idx - 16 : idx; return lo + itemsA + gw + NGW * j; };
    int idx = 0;
    while (idx < 16 && item_of(idx) >= hi + 1000000) ++idx;
    if (item_of(idx) < hi) {
        f32x4 va[8], vb[8];
        TItem ca = p0_decode(args, ws, item_of(idx)), cb = ca; p0_issue(ca, va, F.lane);
        for (;;) {
            int nx = item_of(++idx); bool has = nx < hi;
            if (has) { cb = p0_decode(args, ws, nx); p0_issue(cb, vb, F.lane); }
            p0_finish(ca, va, scr, F.lane);
            if (!has) break;
            nx = item_of(++idx); has = nx < hi;
            if (has) { ca = p0_decode(args, ws, nx); p0_issue(ca, va, F.lane); }
            p0_finish(cb, vb, scr, F.lane);
            if (!has) break;
        }
    }
}
#ifndef P0_SPLIT_PCT
#define P0_SPLIT_PCT 44
#endif
#ifndef P0_TAIL_PCT
#define P0_TAIL_PCT 6
#endif
#ifndef P0_HG_PCT
#define P0_HG_PCT 15
#endif
#ifndef P8_E0
#define P8_E0 25
#endif
constexpr int P8_GU1 = 16 * 128, P8_DN1 = 16 * 64, P8_N = P8_E0 * (P8_GU1 + P8_DN1) + (NE - P8_E0) * P8_GU1, P8_Q = (NE - P8_E0) * P8_DN1;
constexpr int P8_SPLIT = (int)((long long)P8_N * (100 - P0_SPLIT_PCT) / 100);
constexpr int P8_SPLITA = P8_SPLIT - (int)((long long)P8_N * P0_TAIL_PCT / 100);
constexpr int P8_SPLITH = P8_SPLITA - (int)((long long)P8_N * P0_HG_PCT / 100);
#ifndef P0_RW_PCT
#define P0_RW_PCT 5
#endif
constexpr int P8_SPLITR = P8_SPLITH - (int)((long long)P8_N * P0_RW_PCT / 100);
#ifndef P0_DED_PCT
#define P0_DED_PCT 30
#endif
constexpr int P8_SPLITD = (P8_SPLITR - (int)((long long)P8_N * P0_DED_PCT / 100)) > 0 ? (P8_SPLITR - (int)((long long)P8_N * P0_DED_PCT / 100)) : 0;
#ifndef P2_GEMM_WGS
#define P2_GEMM_WGS 232
#endif
constexpr int P2_ROUNDS = ((M / 256) * (NPROJ / 256) + P2_GEMM_WGS - 1) / P2_GEMM_WGS, P2_NFULL = (M / 256) * (NPROJ / 256) - (P2_ROUNDS - 1) * P2_GEMM_WGS;
#ifndef P11_TAIL_ITEMS
#define P11_TAIL_ITEMS 48
#endif
constexpr float W8_SCALE = 64.0f, H8_SCALE = 8.0f, A8_SCALE = 4.0f, Y8_SCALE = 64.0f;
struct TItem8 { const float* src; unsigned char* dst; int N, Kd; };
__device__ __forceinline__ TItem8 p8_decode(const Args& args, unsigned char* ws, int it) {
    TItem8 t;
    if (it >= P8_N) { const int j = it - P8_N; it = (P8_E0 + j / P8_DN1) * (P8_GU1 + P8_DN1) + P8_GU1 + j % P8_DN1; }
    else if (it >= P8_E0 * (P8_GU1 + P8_DN1)) { const int r = it - P8_E0 * (P8_GU1 + P8_DN1); it = (P8_E0 + r / P8_GU1) * (P8_GU1 + P8_DN1) + r % P8_GU1; }
    const int e = it / (P8_GU1 + P8_DN1), q = it % (P8_GU1 + P8_DN1);
    if (q < P8_GU1) { const int kb = q / 128, nb = q % 128, n0 = nb * 32;
        const int dr = (n0 < DE) ? (256 * (n0 / 128) + (n0 % 128)) : (256 * ((n0 - DE) / 128) + 128 + ((n0 - DE) % 128));
        t.src = args.in[25] + (size_t)e * D * 2 * DE + (size_t)(kb * 128) * (2 * DE) + n0; t.N = 2 * DE; t.dst = ws + WS_WGU + (size_t)e * 2 * DE * D + (size_t)dr * D + kb * 128; t.Kd = D; }
    else { const int q2 = q - P8_GU1, kb = q2 / 64, nb = q2 % 64;
        t.src = args.in[27] + (size_t)e * DE * D + (size_t)(kb * 128) * D + nb * 32; t.N = D; t.dst = ws + WS_WDN + (size_t)e * D * DE + (size_t)(nb * 32) * DE + kb * 128; t.Kd = DE; }
    return t;
}
__device__ __forceinline__ void p8_issue(const TItem8& t, f32x4 (&v)[16], int lane) {
    const GAS f32x4* src = (const GAS f32x4*)((const GAS float*)t.src + (size_t)(lane >> 3) * t.N + 4 * (lane & 7));
#pragma unroll
    for (int i = 0; i < 16; ++i) v[i] = __builtin_nontemporal_load(src + (size_t)(2 * i) * t.N);
}
__device__ __forceinline__ void p8_finish(const TItem8& t, const f32x4 (&v)[16], LAS float* scr, int lane) {
#pragma unroll
    for (int i = 0; i < 16; ++i) *(LAS f32x4*)(scr + (8 * i + (lane >> 3)) * 32 + (((lane & 7) ^ (i & 7)) << 2)) = v[i] * W8_SCALE;
    LDS_WAIT(); asm volatile("" ::: "memory");
    const int c = lane & 7;
#pragma unroll
    for (int j = 0; j < 4; ++j) { const int n = (lane >> 3) + 8 * j; float x[16];
#pragma unroll
        for (int i = 0; i < 16; ++i) { const int k = 16 * c + i; x[i] = scr[k * 32 + ((((n >> 2) ^ ((k >> 3) & 7)) << 2) | (n & 3))]; }
        int w[4];
#pragma unroll
        for (int g = 0; g < 4; ++g) { int q = 0; q = __builtin_amdgcn_cvt_pk_fp8_f32(fminf(fmaxf(x[4 * g], -448.f), 448.f), fminf(fmaxf(x[4 * g + 1], -448.f), 448.f), q, false);
            q = __builtin_amdgcn_cvt_pk_fp8_f32(fminf(fmaxf(x[4 * g + 2], -448.f), 448.f), fminf(fmaxf(x[4 * g + 3], -448.f), 448.f), q, true); w[g] = q; }
        v4u o; o.x = (unsigned)w[0]; o.y = (unsigned)w[1]; o.z = (unsigned)w[2]; o.w = (unsigned)w[3];
        __builtin_nontemporal_store(o, (GAS v4u*)(t.dst + (size_t)n * t.Kd + 16 * c)); }
    LDS_WAIT(); asm volatile("" ::: "memory");
}
__device__ __forceinline__ void p8_convert(Frame& F, const Args& args, int lo, int hi, int gw, int NGW, int nlight) {
    LAS float* scr = (LAS float*)(F.lds + F.wave * 16384);
    unsigned char* ws = F.ws;
    const int nA = NGW > nlight ? NGW - nlight : 0, nit = hi - lo, itemsA = (nlight > 0) ? (nA * 8 < nit ? nA * 8 : nit) : 0;
    auto item_of = [&](int idx) -> int {
        if (nlight > 0) { if (gw >= nlight && idx < 8) { const int a = (gw - nlight) + nA * idx; return a < itemsA ? lo + a : hi + 1000000; }
            const int j = (gw >= nlight) ? idx - 8 : idx; return lo + itemsA + gw + NGW * j; }
        return lo + gw + NGW * idx; };
    int idx = 0;
    while (nlight > 0 && idx < 8 && item_of(idx) >= hi + 1000000) ++idx;
    if (item_of(idx) < hi) {
        f32x4 va[16], vb[16];
        TItem8 ca = p8_decode(args, ws, item_of(idx)), cb = ca; p8_issue(ca, va, F.lane);
        for (;;) {
            int nx = item_of(++idx); bool has = nx < hi;
            if (has) { cb = p8_decode(args, ws, nx); p8_issue(cb, vb, F.lane); }
            p8_finish(ca, va, scr, F.lane);
            if (!has) break;
            nx = item_of(++idx); has = nx < hi;
            if (has) { ca = p8_decode(args, ws, nx); p8_issue(ca, va, F.lane); }
            p8_finish(cb, vb, scr, F.lane);
            if (!has) break;
        }
    }
}
__device__ __forceinline__ void p0_prologue(Frame& F, const Args& args) {
    const int gw = F.vcu * NWAVES + F.wave, NGW = F.G * NWAVES, gt = F.vcu * 512 + F.tid, NGT = F.G * 512;
    unsigned char* ws = F.ws;
    LAS float* sc = (LAS float*)(F.lds + 67584);
    for (int i = F.tid; i < NB * D; i += 512) { const int b = i / D, k = i % D; const float cv = args.in[1][i]; sc[k * 8 + b] = cv * sigmoidf_(cv); }
    __syncthreads();
    {
        float* modp = (float*)(ws + WS_MODP);
        for (int it = gw; it < 16 * 48; it += NGW) {
            const int kc = it / 48, jc = it % 48, j0 = jc * 256 + 4 * F.lane;
            f32x4 acc[8];
#pragma unroll
            for (int b = 0; b < 8; ++b) acc[b] = (f32x4){0.f, 0.f, 0.f, 0.f};
            const GAS f32x4* wp = (const GAS f32x4*)(args.in[2] + (size_t)(kc * 128) * 12288 + j0);
            const LAS f32x4* sp = (const LAS f32x4*)(sc + kc * 128 * 8);
            for (int k0 = 0; k0 < 128; k0 += 32) {
                f32x4 wv[32];
#pragma unroll
                for (int kk = 0; kk < 32; ++kk) wv[kk] = wp[(size_t)(k0 + kk) * 3072];
#pragma unroll
                for (int kk = 0; kk < 32; ++kk) { const f32x4 w = wv[kk]; const f32x4 s0 = sp[2 * (k0 + kk)], s1 = sp[2 * (k0 + kk) + 1];
                    acc[0] += s0[0] * w; acc[1] += s0[1] * w; acc[2] += s0[2] * w; acc[3] += s0[3] * w;
                    acc[4] += s1[0] * w; acc[5] += s1[1] * w; acc[6] += s1[2] * w; acc[7] += s1[3] * w; }
            }
#pragma unroll
            for (int b = 0; b < 8; ++b) *(GAS f32x4*)(modp + (size_t)(kc * 8 + b) * 12288 + j0) = acc[b];
        }
    }
    {
        bf16* rwh = (bf16*)(ws + WS_RWP); bf16* rwl = rwh + NE * D;
        for (int o = gt; o < D * NE; o += NGT) { const int k = o & (D - 1), e = o >> 11; const float w = args.in[23][k * NE + e]; const unsigned hi = f2bf(w); rwh[o] = (bf16)hi; rwl[o] = (bf16)f2bf(w - bf2f((unsigned short)hi)); }
    }
    {
        bf16* wl = (bf16*)(ws + WS_WLORA);
        for (int o = gt; o < LORA_N * LORA_K; o += NGT) {
            const int n = o / LORA_K, k = o % LORA_K; float v = 0.f;
            if (n < 1024) { if (k < 64) v = args.in[9][k * 1024 + n]; }
            else if (n < 2048) { if (k >= 64 && k < 128) v = args.in[11][(k - 64) * 1024 + (n - 1024)]; }
            else { if (k >= 128 && k < 288) v = args.in[12][(k - 128) * 1024 + (n - 2048)]; }
            wl[o] = (bf16)f2bf(v);
        }
    }
    {
        GAS v4u* z = (GAS v4u*)(ws + WS_WIN + (size_t)RWKV_COLS * D * 2);
        for (int o = gt; o < (HG_BASE - RWKV_COLS) * D * 2 / 16; o += NGT) z[o] = (v4u){0u, 0u, 0u, 0u};
    }
    p0_convert(F, args, 0, P0_NITEMS, gw, NGW, 0);
    __syncthreads();
    if (P8_SPLITD > 0) p8_convert(F, args, 0, P8_SPLITD, gw, NGW, 768);
}

__device__ __forceinline__ void p1_norm1(Frame& F, const Args& args) {
    const float* modp = (const float*)(F.ws + WS_MODP); float* mod = (float*)(F.ws + WS_MOD); bf16* H = (bf16*)(F.ws + WS_H);
    LAS float* ml = (LAS float*)F.lds;
    for (int rg = F.vcu; rg < M / 64; rg += F.G) {
        const int b = rg / (SEQ / 64);
        __syncthreads();
        for (int j = F.tid; j < 2 * D; j += 512) { float s = args.in[3][j];
#pragma unroll
            for (int kc = 0; kc < 16; ++kc) s += modp[(size_t)(kc * 8 + b) * 12288 + j];
            ml[j] = s; }
        for (int idx = rg * 384 + F.tid; idx < (rg + 1) * 384 && F.tid < 384; idx += 512) { const int bb = idx / 12288, j = idx % 12288; float s = args.in[3][j];
#pragma unroll
            for (int kc = 0; kc < 16; ++kc) s += modp[(size_t)(kc * 8 + bb) * 12288 + j];
            mod[idx] = s; }
        __syncthreads();
        f32x4 g1q[8];
#pragma unroll
        for (int j = 0; j < 8; ++j) g1q[j] = *(const GAS f32x4*)(args.in[4] + 256 * j + 4 * F.lane);
        f32x4 vn[8];
        { const GAS f32x4* xr0 = (const GAS f32x4*)(args.in[0] + (size_t)(rg * 64 + F.wave * 8) * D) + F.lane;
#pragma unroll
          for (int j = 0; j < 8; ++j) vn[j] = xr0[64 * j]; }
        for (int i = 0; i < 8; ++i) {
            const int m = rg * 64 + F.wave * 8 + i;
            f32x4 v[8]; float ss = 0.f;
#pragma unroll
            for (int j = 0; j < 8; ++j) { v[j] = vn[j]; ss += (v[j].x * v[j].x + v[j].y * v[j].y) + (v[j].z * v[j].z + v[j].w * v[j].w); }
            if (i < 7) { const GAS f32x4* xr1 = (const GAS f32x4*)(args.in[0] + (size_t)(m + 1) * D) + F.lane;
#pragma unroll
                for (int j = 0; j < 8; ++j) vn[j] = xr1[64 * j]; }
            const float rstd = 1.0f / sqrtf(wave_sum(ss) * (1.0f / D) + NORM_EPS);
            GAS v2u* o8 = (GAS v2u*)(H + (size_t)m * D) + F.lane;
#pragma unroll
            for (int j = 0; j < 8; ++j) { const int c = 256 * j + 4 * F.lane;
                const f32x4 g = g1q[j], sh = *(const LAS f32x4*)(ml + c), scl = *(const LAS f32x4*)(ml + D + c);
                const f32x4 hv = v[j] * rstd * g * (scl + 1.0f) + sh;
                v2u w; w.x = pk2(hv.x, hv.y); w.y = pk2(hv.z, hv.w); o8[64 * j] = w; }
        }
    }
}

__device__ __forceinline__ void p3_lora_a(Frame& F, const Args& args) {
    const bf16* P = (const bf16*)(F.ws + WS_PROJ); bf16* A = (bf16*)(F.ws + WS_LORA_A);
    const int gw = F.vcu * NWAVES + F.wave, NGW = F.G * NWAVES;
    float muv[5];
#pragma unroll
    for (int jj = 0; jj < 5; ++jj) { const int c = F.lane + 64 * jj; muv[jj] = (c < 288) ? args.in[7][3072 + c] : 0.f; }
    for (int rg = gw; rg < M / 8; rg += NGW) {
        const int m0 = rg * 8; unsigned short raw[9][5];
#pragma unroll
        for (int r = 0; r < 9; ++r)
#pragma unroll
            for (int jj = 0; jj < 5; ++jj) { const int c = F.lane + 64 * jj; const bool first = (r == 0) && (m0 % SEQ) == 0; const int m = first ? m0 : m0 + r - 1;
                const unsigned short q = ((const GAS bf16*)P)[(size_t)m * NPROJ + 3072 + (c < 288 ? c : 287)]; raw[r][jj] = (c < 288 && !first) ? q : (unsigned short)0; }
#pragma unroll
        for (int r = 1; r < 9; ++r) { const int m = m0 + r - 1;
#pragma unroll
            for (int jj = 0; jj < 6; ++jj) { const int c = F.lane + 64 * jj; float o = 0.f;
                if (jj < 5 && c < 288) { const float p = bf2f(raw[r][jj < 5 ? jj : 0]), pp = bf2f(raw[r - 1][jj < 5 ? jj : 0]); const float s = p + (pp - p) * muv[jj < 5 ? jj : 0];
                    o = (c < 64) ? (2.0f * sigmoidf_(2.0f * s) - 1.0f) : ((c < 128) ? s : sigmoidf_(s)); }
                A[(size_t)m * LORA_K + c] = (bf16)f2bf(o); } }
    }
}

__device__ __forceinline__ float wave_sum_u(float v) {
    v += dpp_mov<0xB1>(v); v += dpp_mov<0x4E>(v); v += dpp_mov<0x141>(v); v += dpp_mov<0x140>(v);
    v += __builtin_bit_cast(float, __builtin_amdgcn_update_dpp(0, __builtin_bit_cast(int, v), 0x142, 0xa, 0xf, false));
    v += __builtin_bit_cast(float, __builtin_amdgcn_update_dpp(0, __builtin_bit_cast(int, v), 0x143, 0xc, 0xf, false));
    return __builtin_bit_cast(float, __builtin_amdgcn_readlane(__builtin_bit_cast(int, v), 63));
}
#define LO2(v) __builtin_shufflevector(v, v, 0, 1)
#define HI2(v) __builtin_shufflevector(v, v, 2, 3)
__device__ __forceinline__ float fma_s(float a, float b, float c) { float d; asm("v_fma_f32 %0, %1, %2, %3" : "=v"(d) : "v"(a), "v"(b), "v"(c)); return d; }
__device__ __forceinline__ float mul_s(float a, float b) { float d; asm("v_mul_f32 %0, %1, %2" : "=v"(d) : "v"(a), "v"(b)); return d; }
__device__ __forceinline__ float sub_s(float a, float b) { float d; asm("v_sub_f32 %0, %1, %2" : "=v"(d) : "v"(a), "v"(b)); return d; }
__device__ __forceinline__ float add_s(float a, float b) { float d; asm("v_add_f32 %0, %1, %2" : "=v"(d) : "v"(a), "v"(b)); return d; }
struct RStep { f32x4 kk0, kk1, w0, w1, nb0, nb1, k0, k1, r0, r1; float v; };
__device__ __forceinline__ void rwkv_scan(Frame& F, const Args& args, int bh) {
    constexpr int TT = 32, ARR = TT * 64, BUF = 8 * ARR + 64;
    const int b = bh >> 4, h = bh & 15, lane = F.lane, wave = F.wave;
    const bf16* P = (const bf16*)(F.ws + WS_PROJ); const bf16* LO = (const bf16*)(F.ws + WS_LORA_O); bf16* YA = (bf16*)(F.ws + WS_YA);
    LAS float* L = (LAS float*)F.lds;
    const int c = h * 64 + lane;
    const float mu_r = args.in[7][c], mu_k = args.in[7][1024 + c], mu_v = args.in[7][2048 + c], w0 = args.in[8][c], a0 = args.in[10][c], kkc = args.in[13][c], kac = args.in[14][c], rkc = args.in[15][c], gng = args.in[16][c], gnb = args.in[17][c];
    unsigned short rr[4], rk[4], rv[4], pr[4], pk[4], pv[4], rwl[4], ral[4], rg[4];
    auto load_raw = [&](int t0) {
#pragma unroll
        for (int i = 0; i < 4; ++i) { const int t = t0 + wave + 8 * i; const size_t m = (size_t)b * SEQ + t; const GAS bf16* pm = (const GAS bf16*)P + m * NPROJ + c;
            rr[i] = pm[0]; rk[i] = pm[1024]; rv[i] = pm[2048];
            if (t > 0) { pr[i] = pm[-NPROJ]; pk[i] = pm[1024 - NPROJ]; pv[i] = pm[2048 - NPROJ]; } else { pr[i] = 0; pk[i] = 0; pv[i] = 0; }
            const GAS bf16* lm = (const GAS bf16*)LO + m * LORA_N + c; rwl[i] = lm[0]; ral[i] = lm[1024]; rg[i] = lm[2048]; }
    };
    auto derive = [&](LAS float* B) {
#pragma unroll
        for (int i = 0; i < 4; ++i) { const int tl = wave + 8 * i;
            const float r0 = bf2f(rr[i]), k0 = bf2f(rk[i]), v0 = bf2f(rv[i]);
            const float r = r0 + (bf2f(pr[i]) - r0) * mu_r, k = k0 + (bf2f(pk[i]) - k0) * mu_k, v = v0 + (bf2f(pv[i]) - v0) * mu_v;
            const float decay = __expf(-0.6065306597126334f * sigmoidf_(w0 + bf2f(rwl[i])));
            const float a = sigmoidf_(a0 + bf2f(ral[i]));
            const float kkv = k * kkc; const float n2 = wave_sum_u(kkv * kkv); const float kk = kkv / fmaxf(sqrtf(n2), 1e-12f);
            const float k2 = k * (1.0f + (a - 1.0f) * kac);
            const float bon = wave_sum_u(r * k2 * rkc);
            B[0 * ARR + tl * 64 + lane] = kk; B[1 * ARR + tl * 64 + lane] = decay; B[2 * ARR + tl * 64 + lane] = -kk * a; B[3 * ARR + tl * 64 + lane] = k2;
            B[4 * ARR + tl * 64 + lane] = r; B[5 * ARR + tl * 64 + lane] = v; B[6 * ARR + tl * 64 + lane] = bf2f(rg[i]);
            if (lane == 0) B[8 * ARR + tl] = bon; }
    };
    const int rv8 = lane >> 3, kg = lane & 7, row = 8 * wave + rv8;
    float S[8];
#pragma unroll
    for (int i = 0; i < 8; ++i) S[i] = 0.f;
    auto ldstep = [&](const LAS float* B, int tl) -> RStep {
        const LAS f32x4* q = (const LAS f32x4*)(B + tl * 64 + 8 * kg); RStep s;
        s.kk0 = q[0]; s.kk1 = q[1]; s.w0 = q[ARR / 4]; s.w1 = q[ARR / 4 + 1]; s.nb0 = q[2 * ARR / 4]; s.nb1 = q[2 * ARR / 4 + 1];
        s.k0 = q[3 * ARR / 4]; s.k1 = q[3 * ARR / 4 + 1]; s.r0 = q[4 * ARR / 4]; s.r1 = q[4 * ARR / 4 + 1]; s.v = B[5 * ARR + tl * 64 + row]; return s;
    };
    float yacc = 0.f;
    auto step = [&](LAS float* B, const RStep& s, int tl) {
        float p0 = mul_s(S[0], s.kk0[0]), p1 = mul_s(S[1], s.kk0[1]);
        p0 = fma_s(S[2], s.kk0[2], p0); p1 = fma_s(S[3], s.kk0[3], p1); p0 = fma_s(S[4], s.kk1[0], p0); p1 = fma_s(S[5], s.kk1[1], p1); p0 = fma_s(S[6], s.kk1[2], p0); p1 = fma_s(S[7], s.kk1[3], p1);
        const float sa = red8(add_s(p0, p1));
#pragma unroll
        for (int i = 0; i < 4; ++i) { S[i] = fma_s(S[i], s.w0[i], fma_s(sa, s.nb0[i], mul_s(s.v, s.k0[i]))); S[4 + i] = fma_s(S[4 + i], s.w1[i], fma_s(sa, s.nb1[i], mul_s(s.v, s.k1[i]))); }
        float y0 = mul_s(S[0], s.r0[0]), y1 = mul_s(S[1], s.r0[1]);
        y0 = fma_s(S[2], s.r0[2], y0); y1 = fma_s(S[3], s.r0[3], y1); y0 = fma_s(S[4], s.r1[0], y0); y1 = fma_s(S[5], s.r1[1], y1); y0 = fma_s(S[6], s.r1[2], y0); y1 = fma_s(S[7], s.r1[3], y1);
        const float y = red8(add_s(y0, y1));
        yacc = ((tl & 7) == kg) ? y : yacc;
        if ((tl & 7) == 7) B[7 * ARR + ((tl & ~7) + kg) * 64 + row] = yacc;
    };
    __syncthreads();
    load_raw(0); derive(L);
    __syncthreads();
    for (int tile = 0; tile < SEQ / TT; ++tile) {
        LAS float* B = L + (tile & 1) * BUF; LAS float* Bn = L + ((tile + 1) & 1) * BUF;
        const bool more = (tile + 1) < SEQ / TT;
        if (more) load_raw((tile + 1) * TT);
        {
            RStep sa_ = ldstep(B, 0), sb_;
#pragma unroll
            for (int tl = 0; tl < TT; tl += 2) {
                sb_ = ldstep(B, tl + 1); __builtin_amdgcn_sched_barrier(0); step(B, sa_, tl); __builtin_amdgcn_sched_barrier(0);
                if (tl + 2 < TT) sa_ = ldstep(B, tl + 2);
                __builtin_amdgcn_sched_barrier(0); step(B, sb_, tl + 1); __builtin_amdgcn_sched_barrier(0);
            }
        }
        __syncthreads();
#pragma unroll
        for (int i = 0; i < 4; ++i) { const int tl = wave + 8 * i; const size_t m = (size_t)b * SEQ + tile * TT + tl;
            const float y = B[7 * ARR + tl * 64 + lane]; const float mean = wave_sum_u(y) * (1.0f / 64.0f); const float d = y - mean; const float var = wave_sum_u(d * d) * (1.0f / 64.0f);
            const float yn = d * (1.0f / sqrtf(var + GN_EPS)) * gng + gnb;
            const float o = (yn + B[8 * ARR + tl] * B[5 * ARR + tl * 64 + lane]) * B[6 * ARR + tl * 64 + lane];
            YA[m * RW + c] = (bf16)f2bf(o); }
        if (more) derive(Bn);
        __syncthreads();
    }
}

struct HStep { f32x4 f[4], q[4]; float v; };
__device__ __forceinline__ void hgrn_scan(Frame& F, const Args& args, int u) {
    constexpr int TT = 32, KP = 160, BUF = TT * (KP + KP + 64 + 64);
    const int half = u & 1, bh = u >> 1, b = bh >> 3, h = bh & 7, lane = F.lane, wave = F.wave, tid = F.tid;
    const bf16* P = (const bf16*)(F.ws + WS_PROJ); float* OH = (float*)(F.ws + WS_OHG);
    LAS float* L = (LAS float*)F.lds;
    const int j = tid & 127, ts = tid >> 7, jp = (j >> 4) * 20 + (j & 15);
    const float lb = 1.0f / (1.0f + __expf(args.in[18][1024 + h * 128 + j] - args.in[18][h * 128 + j]));
    unsigned short rq[8], rf[8], rvv[8];
    auto load_raw = [&](int t0) {
#pragma unroll
        for (int i = 0; i < 8; ++i) { const size_t m = (size_t)b * SEQ + t0 + ts + 4 * i; const GAS bf16* pm = (const GAS bf16*)P + m * NPROJ + HG_BASE + h * 128 + j;
            rq[i] = pm[0]; rf[i] = pm[1024]; rvv[i] = (j < 64) ? pm[2048 + half * 64] : (unsigned short)0; }
    };
    auto derive = [&](LAS float* B) {
#pragma unroll
        for (int i = 0; i < 8; ++i) { const int tl = ts + 4 * i; const float q = bf2f(rq[i]); const float f = lb + (1.0f - lb) * sigmoidf_(bf2f(rf[i]));
            B[tl * KP + jp] = f; B[TT * KP + tl * KP + jp] = q * sigmoidf_(q); if (j < 64) B[TT * 2 * KP + tl * 64 + j] = bf2f(rvv[i]); }
    };
    const int cv = lane >> 3, kg = lane & 7, col = 8 * wave + cv;
    float S[16];
#pragma unroll
    for (int i = 0; i < 16; ++i) S[i] = 0.f;
    auto ldstep = [&](const LAS float* B, int tl) -> HStep {
        const LAS f32x4* fp = (const LAS f32x4*)(B + tl * KP + 20 * kg); const LAS f32x4* qp = (const LAS f32x4*)(B + TT * KP + tl * KP + 20 * kg); HStep s; s.v = B[TT * 2 * KP + tl * 64 + col];
#pragma unroll
        for (int g4 = 0; g4 < 4; ++g4) { s.f[g4] = fp[g4]; s.q[g4] = qp[g4]; }
        return s;
    };
    float oacc = 0.f;
    auto step = [&](LAS float* B, const HStep& s, int tl) {
        float o0 = 0.f, o1 = 0.f;
#pragma unroll
        for (int g4 = 0; g4 < 4; ++g4) {
#pragma unroll
            for (int i = 0; i < 4; ++i) { S[4 * g4 + i] = fma_s(s.f[g4][i], sub_s(S[4 * g4 + i], s.v), s.v); }
            if (g4 == 0) { o0 = mul_s(s.q[0][0], S[0]); o1 = mul_s(s.q[0][1], S[1]); } else { o0 = fma_s(s.q[g4][0], S[4 * g4], o0); o1 = fma_s(s.q[g4][1], S[4 * g4 + 1], o1); }
            o0 = fma_s(s.q[g4][2], S[4 * g4 + 2], o0); o1 = fma_s(s.q[g4][3], S[4 * g4 + 3], o1); }
        const float o = red8(add_s(o0, o1));
        oacc = ((tl & 7) == kg) ? o : oacc;
        if ((tl & 7) == 7) B[TT * (2 * KP + 64) + ((tl & ~7) + kg) * 64 + col] = oacc;
    };
    __syncthreads();
    load_raw(0); derive(L);
    __syncthreads();
    for (int tile = 0; tile < SEQ / TT; ++tile) {
        LAS float* B = L + (tile & 1) * BUF; LAS float* Bn = L + ((tile + 1) & 1) * BUF;
        const bool more = (tile + 1) < SEQ / TT;
        if (more) load_raw((tile + 1) * TT);
        {
            HStep sa_ = ldstep(B, 0), sb_;
#pragma unroll
            for (int tl = 0; tl < TT; tl += 2) {
                sb_ = ldstep(B, tl + 1); __builtin_amdgcn_sched_barrier(0); step(B, sa_, tl); __builtin_amdgcn_sched_barrier(0);
                if (tl + 2 < TT) sa_ = ldstep(B, tl + 2);
                __builtin_amdgcn_sched_barrier(0); step(B, sb_, tl + 1); __builtin_amdgcn_sched_barrier(0);
            }
        }
        __syncthreads();
        {
            const int jj = tid & 63, t8 = tid >> 6;
#pragma unroll
            for (int i = 0; i < 4; ++i) { const int tl = t8 + 8 * i; const size_t m = (size_t)b * SEQ + tile * TT + tl; OH[m * 1024 + h * 128 + half * 64 + jj] = B[TT * (2 * KP + 64) + tl * 64 + jj]; }
        }
        if (more) derive(Bn);
        __syncthreads();
    }
}


typedef short bf16x8_t __attribute__((ext_vector_type(8)));
template <int KS> __device__ __forceinline__ f32x4 mm16(const LAS bf16* A, int lda, const LAS bf16* Bt, int ldb, f32x4 acc, int lane) {
    const LAS bf16* ap = A + (lane & 15) * lda + 8 * (lane >> 4); const LAS bf16* bp = Bt + (lane & 15) * ldb + 8 * (lane >> 4);
#pragma unroll
    for (int ks = 0; ks < KS; ++ks) { const bf16x8_t a = *(const LAS bf16x8_t*)(ap + 32 * ks), b = *(const LAS bf16x8_t*)(bp + 32 * ks); acc = __builtin_amdgcn_mfma_f32_16x16x32_bf16(a, b, acc, 0, 0, 0); }
    return acc;
}
__device__ __forceinline__ v2u pack4(f32x4 v) { v2u w; w.x = pk2(v[0], v[1]); w.y = pk2(v[2], v[3]); return w; }
__device__ __forceinline__ float row16_sum(float v) {
    v += dpp_mov<0xB1>(v); v += dpp_mov<0x4E>(v); v += dpp_mov<0x141>(v); v += dpp_mov<0x140>(v); return v;
}

__device__ __forceinline__ void hgrn_chunk_scan(Frame& F, const Args& args, int bh) {
    constexpr int CL = 32, PQ = 136, PS = 40, PO = 132;
    const int b = bh >> 3, h = bh & 7, lane_ = F.lane, wave = F.wave, tid_ = F.tid;
    const bf16* P = (const bf16*)(F.ws + WS_PROJ); bf16* YB = (bf16*)(F.ws + WS_YB);
    LAS bf16* QD = (LAS bf16*)F.lds;
    LAS bf16* KD = QD + 32 * PQ;
    LAS bf16* VT = KD + 32 * PQ;
    LAS bf16* KET = VT + 128 * PS;
    LAS bf16* ST = KET + 128 * PS;
    LAS bf16* AT = ST + 128 * PQ;
    LAS float* OB = (LAS float*)(AT + 32 * PS);
    LAS float* DEND = OB + 32 * PO;
    LAS float* TOT = DEND + 128;
    const float lb = 1.0f / (1.0f + __expf(args.in[18][1024 + h * 128 + (tid_ & 127)] - args.in[18][h * 128 + (tid_ & 127)]));
    unsigned short rq[8], rf[8], rvv[8];
    auto load_raw = [&](int t0) {
#pragma unroll
        for (int i = 0; i < 8; ++i) { const size_t m = (size_t)b * SEQ + t0 + 8 * (tid_ >> 7) + i; const GAS bf16* pm = (const GAS bf16*)P + m * NPROJ + HG_BASE + h * 128 + (tid_ & 127);
            rq[i] = pm[0]; rf[i] = pm[1024]; rvv[i] = pm[2048]; }
    };
    f32x4 Sacc[8];
#pragma unroll
    for (int vt = 0; vt < 8; ++vt) Sacc[vt] = (f32x4){0.f, 0.f, 0.f, 0.f};
    for (int i = tid_; i < 128 * PQ / 2; i += 512) ((LAS unsigned*)ST)[i] = 0u;
    const float gng0 = args.in[19][8 * (tid_ & 15)], gng1 = args.in[19][8 * (tid_ & 15) + 1], gng2 = args.in[19][8 * (tid_ & 15) + 2], gng3 = args.in[19][8 * (tid_ & 15) + 3],
                gng4 = args.in[19][8 * (tid_ & 15) + 4], gng5 = args.in[19][8 * (tid_ & 15) + 5], gng6 = args.in[19][8 * (tid_ & 15) + 6], gng7 = args.in[19][8 * (tid_ & 15) + 7];
    load_raw(0);
    const GAS bf16* ogp = (const GAS bf16*)P + ((size_t)b * SEQ + (tid_ >> 4)) * NPROJ + HG_BASE + 3072 + h * 128 + 8 * (tid_ & 15);
    v4u ogc = *(const GAS v4u*)ogp, ogn = ogc;
    __syncthreads();
    for (int ch = 0; ch < SEQ / CL; ++ch) {
        int lane = lane_, tid = tid_; asm volatile("" : "+v"(lane), "+v"(tid));
        const int j = tid & 127, tq = tid >> 7, q4 = lane >> 4, r16 = lane & 15;
        float fv[8], cs[8]; float run = 0.f;
#pragma unroll
        for (int i = 0; i < 8; ++i) { fv[i] = lb + (1.0f - lb) * sigmoidf_(bf2f(rf[i])); run += __logf(fv[i]); cs[i] = run; }
        TOT[tq * 128 + j] = run;
        {
            v4u w; w.x = (unsigned)rvv[0] | ((unsigned)rvv[1] << 16); w.y = (unsigned)rvv[2] | ((unsigned)rvv[3] << 16); w.z = (unsigned)rvv[4] | ((unsigned)rvv[5] << 16); w.w = (unsigned)rvv[6] | ((unsigned)rvv[7] << 16);
            *(LAS v4u*)(VT + j * PS + 8 * tq) = w; }
        __syncthreads();
        {
            const float t0 = TOT[j], t1 = TOT[128 + j], t2 = TOT[256 + j], t3 = TOT[384 + j];
            const float off = (tq > 0 ? t0 : 0.f) + (tq > 1 ? t1 : 0.f) + (tq > 2 ? t2 : 0.f); const float bl = ((t0 + t1) + t2) + t3; const float ebl = __expf(bl);
            if (tq == 0) DEND[j] = ebl;
            float ke[8];
#pragma unroll
            for (int i = 0; i < 8; ++i) { const float bb = off + cs[i]; const float eb = __expf(bb), enb = __builtin_amdgcn_rcpf(eb); const float qv = bf2f(rq[i]); const float kd = (1.0f - fv[i]) * enb;
                QD[(8 * tq + i) * PQ + j] = (bf16)f2bf(qv * sigmoidf_(qv) * eb); KD[(8 * tq + i) * PQ + j] = (bf16)f2bf(kd); ke[i] = kd * ebl; }
            v4u w; w.x = pk2(ke[0], ke[1]); w.y = pk2(ke[2], ke[3]); w.z = pk2(ke[4], ke[5]); w.w = pk2(ke[6], ke[7]);
            *(LAS v4u*)(KET + j * PS + 8 * tq) = w;
        }
        const bool more = (ch + 1) < SEQ / CL;
        if (more) { load_raw((ch + 1) * CL); ogn = *(const GAS v4u*)(ogp + (size_t)(ch + 1) * CL * NPROJ); }
        __syncthreads();
        if (wave < 4) { const int tt = wave >> 1, st = wave & 1;
            f32x4 a = mm16<4>(KD + 16 * st * PQ, PQ, QD + 16 * tt * PQ, PQ, (f32x4){0.f, 0.f, 0.f, 0.f}, lane);
            const int t = 16 * tt + r16, s0 = 16 * st + 4 * q4;
#pragma unroll
            for (int i = 0; i < 4; ++i) a[i] = (s0 + i <= t) ? a[i] : 0.f;
            *(LAS v2u*)(AT + t * PS + s0) = pack4(a); }
        const int ott = wave & 1, ovt0 = 2 * (wave >> 1);
        f32x4 o0 = mm16<4>(QD + 16 * ott * PQ, PQ, ST + 16 * ovt0 * PQ, PQ, (f32x4){0.f, 0.f, 0.f, 0.f}, lane);
        f32x4 o1 = mm16<4>(QD + 16 * ott * PQ, PQ, ST + 16 * (ovt0 + 1) * PQ, PQ, (f32x4){0.f, 0.f, 0.f, 0.f}, lane);
        __syncthreads();
        o0 = mm16<1>(AT + 16 * ott * PS, PS, VT + 16 * ovt0 * PS, PS, o0, lane);
        o1 = mm16<1>(AT + 16 * ott * PS, PS, VT + 16 * (ovt0 + 1) * PS, PS, o1, lane);
#pragma unroll
        for (int i = 0; i < 4; ++i) { OB[(16 * ott + 4 * q4 + i) * PO + 16 * ovt0 + r16] = o0[i]; OB[(16 * ott + 4 * q4 + i) * PO + 16 * (ovt0 + 1) + r16] = o1[i]; }
        {
            const f32x4 de = *(const LAS f32x4*)(DEND + 16 * wave + 4 * q4);
#pragma unroll
            for (int vt = 0; vt < 8; ++vt) { Sacc[vt] = Sacc[vt] * de; Sacc[vt] = mm16<1>(KET + 16 * wave * PS, PS, VT + 16 * vt * PS, PS, Sacc[vt], lane);
                *(LAS v2u*)(ST + (16 * vt + r16) * PQ + 16 * wave + 4 * q4) = pack4(Sacc[vt]); }
        }
        __syncthreads();
        {
            const int t = tid >> 4, vg = tid & 15; const size_t m = (size_t)b * SEQ + ch * CL + t;
            const f32x4 x0 = *(const LAS f32x4*)(OB + t * PO + 8 * vg), x1 = *(const LAS f32x4*)(OB + t * PO + 8 * vg + 4);
            float ss = (x0[0] * x0[0] + x0[1] * x0[1]) + (x0[2] * x0[2] + x0[3] * x0[3]) + ((x1[0] * x1[0] + x1[1] * x1[1]) + (x1[2] * x1[2] + x1[3] * x1[3]));
            ss = row16_sum(ss);
            const float rs = __builtin_amdgcn_rsqf(ss * (1.0f / 128.0f) + NORM_EPS);
            const v4u og = ogc; ogc = ogn;
            const float z0 = bflo(og.x), z1 = bfhi(og.x), z2 = bflo(og.y), z3 = bfhi(og.y), z4 = bflo(og.z), z5 = bfhi(og.z), z6 = bflo(og.w), z7 = bfhi(og.w);
            v4u w; w.x = pk2(x0[0] * rs * gng0 * (z0 * sigmoidf_(z0)), x0[1] * rs * gng1 * (z1 * sigmoidf_(z1))); w.y = pk2(x0[2] * rs * gng2 * (z2 * sigmoidf_(z2)), x0[3] * rs * gng3 * (z3 * sigmoidf_(z3)));
            w.z = pk2(x1[0] * rs * gng4 * (z4 * sigmoidf_(z4)), x1[1] * rs * gng5 * (z5 * sigmoidf_(z5))); w.w = pk2(x1[2] * rs * gng6 * (z6 * sigmoidf_(z6)), x1[3] * rs * gng7 * (z7 * sigmoidf_(z7)));
            *(GAS v4u*)(YB + m * 1024 + h * 128 + 8 * vg) = w;
        }
    }
}

__device__ __forceinline__ void rwkv_chunk_scan(Frame& F, const Args& args, int bh) {
    constexpr int CL = 32, P72 = 72, P40 = 40, PN = 36, PY = 68;
    const int b = bh >> 4, h = bh & 15, lane_ = F.lane, wave = F.wave, tid_ = F.tid;
    const bf16* P = (const bf16*)(F.ws + WS_PROJ); const bf16* LO = (const bf16*)(F.ws + WS_LORA_O); bf16* YA = (bf16*)(F.ws + WS_YA);
    LAS bf16* X1 = (LAS bf16*)F.lds;
    LAS bf16* X2 = X1 + 64 * P72;
    LAS bf16* BKT = X2 + 64 * P72;
    LAS bf16* VT = BKT + 64 * P72;
    LAS bf16* KKT = VT + 64 * P40;
    LAS bf16* MVT = KKT + 64 * P40;
    LAS bf16* UT = MVT + 64 * P40;
    LAS bf16* MAK = UT + 64 * P40;
    LAS bf16* TT = MAK + 32 * P40;
    LAS bf16* AR = TT + 32 * P40;
    LAS bf16* PM = AR + 32 * P72;
    LAS bf16* T11T = PM + 32 * P72;
    LAS bf16* WTm = T11T + 16 * P40;
    LAS bf16* N21B = WTm + 16 * P40;
    LAS bf16* T22B = N21B + 16 * P40;
    LAS bf16* ZT = T22B + 16 * P40;
    LAS float* NM = (LAS float*)(ZT + 2 * 64 * P72);
    LAS float* YBf = NM + 32 * PN;
    LAS float* WLv = YBf + 32 * PY;
    LAS float* CT = WLv + 64;
    LAS float* VGB = CT + 8 * 64;
    constexpr int VGB_SZ = 2 * 32 * 64 + 32;
    const int c = h * 64 + lane_;
    const float mu_r = args.in[7][c], mu_k = args.in[7][1024 + c], mu_v = args.in[7][2048 + c], w0 = args.in[8][c], a0 = args.in[10][c], kkc = args.in[13][c], kac = args.in[14][c], rkc = args.in[15][c], gng = args.in[16][c], gnb = args.in[17][c];
    unsigned short rr[5], rk[5], rv[5], rwl[4], ral[4], rg[4];
    auto load_raw = [&](int t0) {
#pragma unroll
        for (int i = 0; i < 5; ++i) { const int t = t0 + 4 * wave + i - 1;
            if (t >= 0) { const GAS bf16* pm = (const GAS bf16*)P + ((size_t)b * SEQ + t) * NPROJ + c; rr[i] = pm[0]; rk[i] = pm[1024]; rv[i] = pm[2048]; } else { rr[i] = 0; rk[i] = 0; rv[i] = 0; }
            if (i > 0) { const GAS bf16* lm = (const GAS bf16*)LO + ((size_t)b * SEQ + t) * LORA_N + c; rwl[i - 1] = lm[0]; ral[i - 1] = lm[1024]; rg[i - 1] = lm[2048]; } }
    };
    for (int i = tid_; i < (2 * 64 * P72) / 2; i += 512) ((LAS unsigned*)ZT)[i] = 0u;
    for (int i = tid_; i < (4 * 16 * P40) / 2; i += 512) ((LAS unsigned*)T11T)[i] = 0u;
    for (int i = tid_; i < (32 * P40) / 2; i += 512) ((LAS unsigned*)TT)[i] = 0u;
    f32x4 zacc[2] = {(f32x4){0.f, 0.f, 0.f, 0.f}, (f32x4){0.f, 0.f, 0.f, 0.f}};
    load_raw(0);
    __syncthreads();
    for (int ch = 0; ch < SEQ / CL; ++ch) {
        int lane = lane_; asm volatile("" : "+v"(lane));
        const int q4 = lane >> 4, r16 = lane & 15;
        LAS bf16* ZTc = ZT + (ch & 1) * 64 * P72; LAS bf16* ZTn = ZT + ((ch + 1) & 1) * 64 * P72;
        LAS float* VB = VGB + (ch & 1) * VGB_SZ; LAS float* GB = VB + 32 * 64; LAS float* BON = GB + 32 * 64;
        float er[4], ek2[4], ev[4], ekk[4], eb[4], elw[4], ecw[4]; float run = 0.f;
#pragma unroll
        for (int i = 0; i < 4; ++i) {
            const float r0 = bf2f(rr[i + 1]), k0 = bf2f(rk[i + 1]), v0 = bf2f(rv[i + 1]);
            const float r = r0 + (bf2f(rr[i]) - r0) * mu_r, k = k0 + (bf2f(rk[i]) - k0) * mu_k, v = v0 + (bf2f(rv[i]) - v0) * mu_v;
            const float lw = -0.6065306597126334f * sigmoidf_(w0 + bf2f(rwl[i]));
            const float a = sigmoidf_(a0 + bf2f(ral[i]));
            const float kkv = k * kkc; const float n2 = wave_sum_u(kkv * kkv); const float kk = kkv * __builtin_amdgcn_rsqf(fmaxf(n2, 1e-24f));
            const float k2 = k * (1.0f + (a - 1.0f) * kac);
            const float bon = wave_sum_u(r * k2 * rkc);
            run += lw; er[i] = r; ek2[i] = k2; ev[i] = v; ekk[i] = kk; eb[i] = kk * a; elw[i] = lw; ecw[i] = run;
            const int t = 4 * wave + i;
            VB[t * 64 + lane] = v; GB[t * 64 + lane] = bf2f(rg[i]); if (lane == 0) BON[t] = bon;
        }
        CT[wave * 64 + lane] = run;
        __syncthreads();
        {
            float off = 0.f, tot = 0.f;
#pragma unroll
            for (int w = 0; w < 8; ++w) { const float cv = CT[w * 64 + lane]; off += (w < wave) ? cv : 0.f; tot += cv; }
            const float etot = __expf(tot);
            if (wave == 0) WLv[lane] = etot;
            float fb[4], fk[4], fkk[4];
#pragma unroll
            for (int i = 0; i < 4; ++i) { const int t = 4 * wave + i; const float cw = off + ecw[i]; const float e1 = __expf(cw), e2 = __expf(cw - elw[i]), e3 = __builtin_amdgcn_rcpf(e1), e4 = etot * e3;
                fkk[i] = ekk[i] * e2; fb[i] = eb[i] * e4; fk[i] = ek2[i] * e4;
                X1[t * P72 + lane] = (bf16)f2bf(fkk[i]); X1[(32 + t) * P72 + lane] = (bf16)f2bf(er[i] * e1);
                X2[t * P72 + lane] = (bf16)f2bf(eb[i] * e3); X2[(32 + t) * P72 + lane] = (bf16)f2bf(ek2[i] * e3); }
            v2u w; w.x = pk2(fb[0], fb[1]); w.y = pk2(fb[2], fb[3]); *(LAS v2u*)(BKT + lane * P72 + 4 * wave) = w;
            w.x = pk2(fk[0], fk[1]); w.y = pk2(fk[2], fk[3]); *(LAS v2u*)(BKT + lane * P72 + 32 + 4 * wave) = w;
            w.x = pk2(fkk[0], fkk[1]); w.y = pk2(fkk[2], fkk[3]); *(LAS v2u*)(KKT + lane * P40 + 4 * wave) = w;
            w.x = pk2(ev[0], ev[1]); w.y = pk2(ev[2], ev[3]); *(LAS v2u*)(VT + lane * P40 + 4 * wave) = w;
        }
        const bool more = (ch + 1) < SEQ / CL;
        if (more) load_raw((ch + 1) * CL);
        __syncthreads();
#pragma unroll
        for (int u = 0; u < 2; ++u) { const int idx = 2 * wave + u, rt = idx >> 2, ct = idx & 3;
            if (rt == 0 && ct == 1) continue;
            f32x4 m = mm16<2>(X2 + 16 * ct * P72, P72, X1 + 16 * rt * P72, P72, (f32x4){0.f, 0.f, 0.f, 0.f}, lane);
            const int t = 16 * (rt & 1) + r16, s0 = 16 * (ct & 1) + 4 * q4;
            if (rt < 2) {
#pragma unroll
                for (int i = 0; i < 4; ++i) m[i] = (s0 + i < t) ? m[i] : 0.f;
                if (ct < 2) { *(LAS f32x4*)(NM + t * PN + s0) = m; if (rt == 1 && ct == 0) *(LAS v2u*)(N21B + r16 * P40 + 4 * q4) = pack4(m); }
                else *(LAS v2u*)(MAK + t * P40 + s0) = pack4(m);
            } else {
#pragma unroll
                for (int i = 0; i < 4; ++i) m[i] = (s0 + i <= t) ? m[i] : 0.f;
                *(LAS v2u*)(AR + t * P72 + (ct >= 2 ? 32 : 0) + s0) = pack4(m);
            }
        }
        __syncthreads();
        if (wave == 0) {
            const int blk = q4 & 1, jc = r16; float Tc[16];
            const LAS float* nrow = NM + (16 * blk) * PN + 16 * blk;
#pragma unroll
            for (int t = 0; t < 16; ++t) { float acc = (t == jc) ? 1.0f : 0.0f;
                if (t > 0) {
                    f32x4 nv[4];
#pragma unroll
                    for (int g = 0; g < 4; ++g) if (4 * g < t) nv[g] = *(const LAS f32x4*)(nrow + t * PN + 4 * g);
#pragma unroll
                    for (int s = 0; s < t; ++s) acc -= nv[s >> 2][s & 3] * Tc[s];
                }
                Tc[t] = acc; }
            if (lane < 32) {
#pragma unroll
                for (int s = 0; s < 16; ++s) TT[(16 * blk + s) * P40 + 16 * blk + jc] = (bf16)f2bf(Tc[s]);
                if (blk == 0) { v4u w0v, w1v; w0v.x = pk2(Tc[0], Tc[1]); w0v.y = pk2(Tc[2], Tc[3]); w0v.z = pk2(Tc[4], Tc[5]); w0v.w = pk2(Tc[6], Tc[7]); w1v.x = pk2(Tc[8], Tc[9]); w1v.y = pk2(Tc[10], Tc[11]); w1v.z = pk2(Tc[12], Tc[13]); w1v.w = pk2(Tc[14], Tc[15]);
                    *(LAS v4u*)(T11T + jc * P40) = w0v; *(LAS v4u*)(T11T + jc * P40 + 8) = w1v; }
                else {
#pragma unroll
                    for (int s = 0; s < 16; ++s) T22B[s * P40 + jc] = (bf16)f2bf(Tc[s]); }
            }
            LDS_WAIT();
            f32x4 wv = mm16<1>(N21B, P40, T11T, P40, (f32x4){0.f, 0.f, 0.f, 0.f}, lane);
            *(LAS v2u*)(WTm + r16 * P40 + 4 * q4) = pack4(wv);
            LDS_WAIT();
            f32x4 t21 = mm16<1>(WTm, P40, T22B, P40, (f32x4){0.f, 0.f, 0.f, 0.f}, lane);
            *(LAS v2u*)(TT + (16 + r16) * P40 + 4 * q4) = pack4(-t21);
        } else {
#pragma unroll
            for (int u = 0; u < 2; ++u) { const int tile = (wave - 1) + 7 * u; if (tile < 8) { const int tt = tile & 1, vt = tile >> 1;
                f32x4 mv = mm16<1>(MAK + 16 * tt * P40, P40, VT + 16 * vt * P40, P40, (f32x4){0.f, 0.f, 0.f, 0.f}, lane);
                *(LAS v2u*)(MVT + (16 * vt + r16) * P40 + 16 * tt + 4 * q4) = pack4(mv); } }
        }
        __syncthreads();
        const int ptt = wave & 1, pct = wave >> 1;
        {
            f32x4 pv = mm16<1>(KKT + 16 * pct * P40, P40, TT + 16 * ptt * P40, P40, (f32x4){0.f, 0.f, 0.f, 0.f}, lane);
            *(LAS v2u*)(PM + (16 * ptt + r16) * P72 + 16 * pct + 4 * q4) = pack4(-pv);
        }
        f32x4 uacc = -mm16<1>(TT + 16 * ptt * P40, P40, MVT + 16 * pct * P40, P40, (f32x4){0.f, 0.f, 0.f, 0.f}, lane);
        __syncthreads();
        uacc = mm16<2>(PM + 16 * ptt * P72, P72, ZTc + 16 * pct * P72, P72, uacc, lane);
        *(LAS v2u*)(UT + (16 * pct + r16) * P40 + 16 * ptt + 4 * q4) = pack4(uacc);
        __syncthreads();
        {
            f32x4 y = mm16<2>(X1 + (32 + 16 * ptt) * P72, P72, ZTc + 16 * pct * P72, P72, (f32x4){0.f, 0.f, 0.f, 0.f}, lane);
            y = mm16<1>(AR + 16 * ptt * P72, P72, UT + 16 * pct * P40, P40, y, lane);
            y = mm16<1>(AR + 16 * ptt * P72 + 32, P72, VT + 16 * pct * P40, P40, y, lane);
#pragma unroll
            for (int i = 0; i < 4; ++i) YBf[(16 * ptt + 4 * q4 + i) * PY + 16 * pct + r16] = y[i];
            const int kt = wave >> 1; const f32x4 wl = *(const LAS f32x4*)(WLv + 16 * kt + 4 * q4);
#pragma unroll
            for (int jv = 0; jv < 2; ++jv) { const int vt = 2 * (wave & 1) + jv;
                zacc[jv] = zacc[jv] * wl;
                zacc[jv] = mm16<1>(BKT + 16 * kt * P72, P72, UT + 16 * vt * P40, P40, zacc[jv], lane);
                zacc[jv] = mm16<1>(BKT + 16 * kt * P72 + 32, P72, VT + 16 * vt * P40, P40, zacc[jv], lane);
                *(LAS v2u*)(ZTn + (16 * vt + r16) * P72 + 16 * kt + 4 * q4) = pack4(zacc[jv]); }
        }
        __syncthreads();
#pragma unroll
        for (int i = 0; i < 4; ++i) { const int tl = wave + 8 * i; const size_t m = (size_t)b * SEQ + ch * CL + tl;
            const float y = YBf[tl * PY + lane]; const float mean = wave_sum_u(y) * (1.0f / 64.0f); const float d = y - mean; const float var = wave_sum_u(d * d) * (1.0f / 64.0f);
            const float yn = d * __builtin_amdgcn_rsqf(var + GN_EPS) * gng + gnb;
            const float o = (yn + BON[tl] * VB[tl * 64 + lane]) * GB[tl * 64 + lane];
            YA[m * RW + c] = (bf16)f2bf(o); }
    }
}

__device__ __forceinline__ void p6_hgrn_post(Frame& F, const Args& args) {
    const bf16* P = (const bf16*)(F.ws + WS_PROJ); const float* OH = (const float*)(F.ws + WS_OHG); bf16* YB = (bf16*)(F.ws + WS_YB);
    const int gw = F.vcu * NWAVES + F.wave, NGW = F.G * NWAVES;
    const float g0 = args.in[19][F.lane], g1 = args.in[19][64 + F.lane];
    for (int p = gw; p < M * HNH; p += NGW) { const int m = p >> 3, h = p & 7;
        const float o0 = OH[(size_t)m * 1024 + h * 128 + F.lane], o1 = OH[(size_t)m * 1024 + h * 128 + 64 + F.lane];
        const float rs = 1.0f / sqrtf(wave_sum(o0 * o0 + o1 * o1) * (1.0f / 128.0f) + NORM_EPS);
        const bf16* og = P + (size_t)m * NPROJ + HG_BASE + 3072 + h * 128 + F.lane; const float z0 = bf2f(og[0]), z1 = bf2f(og[64]);
        YB[(size_t)m * 1024 + h * 128 + F.lane] = (bf16)f2bf(o0 * rs * g0 * (z0 * sigmoidf_(z0)));
        YB[(size_t)m * 1024 + h * 128 + 64 + F.lane] = (bf16)f2bf(o1 * rs * g1 * (z1 * sigmoidf_(z1))); }
}

typedef float f32x4_ __attribute__((ext_vector_type(4)));
__device__ __forceinline__ void p9_norm2_router(Frame& F, const Args& args) {
    const bf16* X1 = (const bf16*)(F.ws + WS_X1); const float* mod = (const float*)(F.ws + WS_MOD); unsigned char* H8 = F.ws + WS_XG; const bf16* rwh = (const bf16*)(F.ws + WS_RWP); const bf16* rwl = rwh + NE * D;
    int* tk_e = (int*)(F.ws + WS_ROUTE + RT_E); int* tk_rank = (int*)(F.ws + WS_ROUTE + RT_RANK); float* tk_gate = (float*)(F.ws + WS_ROUTE + RT_GATE);
    constexpr int CP = 264;
    LAS bf16* hsh = (LAS bf16*)F.lds;
    LAS bf16* hsl = hsh + 64 * CP;
    LAS bf16* bsh = hsl + 64 * CP;
    LAS bf16* bsl = bsh + 32 * CP;
    LAS float* rstd_l = (LAS float*)(bsl + 32 * CP);
    LAS float* lg = rstd_l + 64;
    LAS int* lcnt = (LAS int*)(lg + 64 * 32);
    LAS int* lbase = lcnt + 32;
    LAS int* res_e = lbase + 32;
    LAS int* res_r = res_e + 256;
    LAS float* res_g = (LAS float*)(res_r + 256);
    const int lane = F.lane, wave = F.wave, tid = F.tid;
    for (int rg = F.vcu; rg < M / 64; rg += F.G) {
        const int b = rg / (SEQ / 64), m0 = rg * 64;
        const float* sh2 = mod + (size_t)b * 12288 + 3 * D; const float* sc2 = mod + (size_t)b * 12288 + 4 * D;
        __syncthreads();
        if (tid < 32) lcnt[tid] = 0;
        { float pq[8];
#pragma unroll
          for (int i = 0; i < 8; ++i) pq[i] = (lane < 32) ? ((const GAS float*)(F.ws + WS_MODP))[(size_t)(m0 + wave * 8 + i) * 32 + lane] : 0.f;
#pragma unroll
          for (int i = 0; i < 8; ++i) { const float rs = 1.0f / sqrtf(wave_sum(pq[i]) * (1.0f / D) + NORM_EPS); if (lane == 0) rstd_l[wave * 8 + i] = rs; } }
        __syncthreads();
        const int rt = wave >> 1, nt = wave & 1;
        f32x4 acc = (f32x4){0.f, 0.f, 0.f, 0.f};
        v2u xq[8];
#pragma unroll
        for (int p = 0; p < 8; ++p) xq[p] = *(const GAS v2u*)(X1 + (size_t)(m0 + p * 8 + (tid >> 6)) * D + 4 * (tid & 63));
        f32x4 gq = *(const GAS f32x4*)(args.in[5] + 4 * (tid & 63)), shq = *(const GAS f32x4*)(sh2 + 4 * (tid & 63)), scq = *(const GAS f32x4*)(sc2 + 4 * (tid & 63));
        v4u bq[4];
#pragma unroll
        for (int i = 0; i < 4; ++i) { const int idx = tid + 512 * i, e = (idx & 1023) >> 5, k16 = idx & 31; bq[i] = *(const GAS v4u*)(((idx >> 10) ? rwl : rwh) + (size_t)e * D + 8 * k16); }
        for (int ch = 0; ch < 8; ++ch) {
#pragma unroll
            for (int i = 0; i < 4; ++i) { const int idx = tid + 512 * i, e = (idx & 1023) >> 5, k16 = idx & 31; *(LAS v4u*)(((idx >> 10) ? bsl : bsh) + e * CP + 8 * k16) = bq[i]; }
#pragma unroll
            for (int p = 0; p < 8; ++p) { const int rl = p * 8 + (tid >> 6), c = ch * 256 + 4 * (tid & 63);
                const v2u xv = xq[p]; const f32x4 v = (f32x4){bflo(xv.x), bfhi(xv.x), bflo(xv.y), bfhi(xv.y)};
                const f32x4 hv = v * rstd_l[rl] * gq * (scq + 1.0f) + shq;
                { v2u wh, wl; wh.x = pk2(hv.x, hv.y); wh.y = pk2(hv.z, hv.w);
                  wl.x = pk2(hv.x - bflo(wh.x), hv.y - bfhi(wh.x)); wl.y = pk2(hv.z - bflo(wh.y), hv.w - bfhi(wh.y));
                  *(LAS v2u*)(hsh + rl * CP + 4 * (tid & 63)) = wh; *(LAS v2u*)(hsl + rl * CP + 4 * (tid & 63)) = wl; }
                int q8 = 0; q8 = __builtin_amdgcn_cvt_pk_fp8_f32(fminf(fmaxf(hv.x * H8_SCALE, -448.f), 448.f), fminf(fmaxf(hv.y * H8_SCALE, -448.f), 448.f), q8, false);
                q8 = __builtin_amdgcn_cvt_pk_fp8_f32(fminf(fmaxf(hv.z * H8_SCALE, -448.f), 448.f), fminf(fmaxf(hv.w * H8_SCALE, -448.f), 448.f), q8, true);
                *(GAS int*)(H8 + (size_t)(m0 + rl) * D + c) = q8; }
            if (ch < 7) { const int cn = (ch + 1) * 256 + 4 * (tid & 63);
#pragma unroll
                for (int p = 0; p < 8; ++p) xq[p] = *(const GAS v2u*)(X1 + (size_t)(m0 + p * 8 + (tid >> 6)) * D + cn);
                gq = *(const GAS f32x4*)(args.in[5] + cn); shq = *(const GAS f32x4*)(sh2 + cn); scq = *(const GAS f32x4*)(sc2 + cn);
#pragma unroll
                for (int i = 0; i < 4; ++i) { const int idx = tid + 512 * i, e = (idx & 1023) >> 5, k16 = idx & 31; bq[i] = *(const GAS v4u*)(((idx >> 10) ? rwl : rwh) + (size_t)e * D + (ch + 1) * 256 + 8 * k16); } }
            __syncthreads();
#pragma unroll
            for (int ks = 0; ks < 8; ++ks) {
                const int ao = (16 * rt + (lane & 15)) * CP + 32 * ks + 8 * (lane >> 4);
                const int bo = (16 * nt + (lane & 15)) * CP + 32 * ks + 8 * (lane >> 4);
                const bf16x8_t ah = *(const LAS bf16x8_t*)(hsh + ao), al = *(const LAS bf16x8_t*)(hsl + ao), bh = *(const LAS bf16x8_t*)(bsh + bo), bl = *(const LAS bf16x8_t*)(bsl + bo);
                acc = __builtin_amdgcn_mfma_f32_16x16x32_bf16(ah, bh, acc, 0, 0, 0); acc = __builtin_amdgcn_mfma_f32_16x16x32_bf16(ah, bl, acc, 0, 0, 0); acc = __builtin_amdgcn_mfma_f32_16x16x32_bf16(al, bh, acc, 0, 0, 0);
            }
            __syncthreads();
        }
#pragma unroll
        for (int i = 0; i < 4; ++i) lg[(16 * rt + 4 * (lane >> 4) + i) * 32 + 16 * nt + (lane & 15)] = acc[i] + args.in[24][16 * nt + (lane & 15)];
        __syncthreads();
        if (tid < 64) {
            float v[32];
#pragma unroll
            for (int e = 0; e < 32; ++e) v[e] = lg[tid * 32 + e];
            float tv[4]; int ti[4];
#pragma unroll
            for (int k = 0; k < 4; ++k) { float best = -3.0e38f; int bi = 0;
#pragma unroll
                for (int e = 0; e < 32; ++e) { const bool gt = v[e] > best; best = gt ? v[e] : best; bi = gt ? e : bi; }
                tv[k] = best; ti[k] = bi;
#pragma unroll
                for (int e = 0; e < 32; ++e) v[e] = (e == bi) ? -3.0e38f : v[e]; }
            const float e1 = __expf(tv[1] - tv[0]), e2 = __expf(tv[2] - tv[0]), e3 = __expf(tv[3] - tv[0]); const float inv = 1.0f / (1.0f + e1 + e2 + e3);
            const float gt4[4] = {inv, e1 * inv, e2 * inv, e3 * inv};
#pragma unroll
            for (int k = 0; k < 4; ++k) { res_e[tid * 4 + k] = ti[k]; res_g[tid * 4 + k] = gt4[k]; res_r[tid * 4 + k] = atomicAdd((int*)&lcnt[ti[k]], 1); }
        }
        __syncthreads();
        if (tid < 32) lbase[tid] = (int)__hip_atomic_fetch_add((unsigned*)(F.ctl + CW_CNT) + tid, (unsigned)lcnt[tid], RLX_AGENT);
        __syncthreads();
        if (tid < 256) { const int e = res_e[tid]; const size_t p = (size_t)m0 * 4 + tid; tk_e[p] = e; tk_rank[p] = lbase[e] + res_r[tid]; tk_gate[p] = res_g[tid]; }
    }
}

__device__ __forceinline__ void p10_dispatch(Frame& F, const Args& args) {
    const int* tk_e = (const int*)(F.ws + WS_ROUTE + RT_E); const int* tk_rank = (const int*)(F.ws + WS_ROUTE + RT_RANK); const float* tk_gate = (const float*)(F.ws + WS_ROUTE + RT_GATE);
    int* tok_slot = (int*)(F.ws + WS_ROUTE + RT_TOKSLOT); float* slot_w = (float*)(F.ws + WS_ROUTE + RT_SLOTW); int* tile_e = (int*)(F.ws + WS_ROUTE + RT_TILEE); int* slot_tok = (int*)(F.ws + WS_ROUTE + RT_SLOTTOK);
    LAS int* tstart = (LAS int*)F.lds;
    __syncthreads();
    if (F.tid < NE) tstart[40 + F.tid] = (int)__hip_atomic_load((unsigned*)(F.ctl + CW_CNT) + F.tid, RLX_AGENT);
    __syncthreads();
    if (F.tid == 0) { int s = 0; for (int e = 0; e < NE; ++e) { tstart[e] = s; s += (tstart[40 + e] + 255) >> 8; } tstart[NE] = s; }
    __syncthreads();
    if (blockIdx.x == 0) { const int nt = tstart[NE]; for (int t = F.tid; t <= MAXTILES; t += 512) { int e = -1; if (t < nt) { e = 0; while (tstart[e + 1] <= t) ++e; } if (t < MAXTILES) tile_e[t] = (e < 0) ? 0 : e; else tile_e[MAXTILES] = nt; } }
    for (int e = F.vcu; e < NE; e += F.G) { const int cn = tstart[40 + e], base = 256 * tstart[e], pe = ((cn + 255) >> 8) << 8; for (int s = cn + F.tid; s < pe; s += 512) slot_tok[base + s] = 0; }
    const int gt = F.vcu * 512 + F.tid, NGT = F.G * 512;
    for (int p = gt; p < NASSIGN; p += NGT) { const int e = tk_e[p], slot = 256 * tstart[e] + tk_rank[p]; tok_slot[p] = slot; slot_w[slot] = tk_gate[p]; slot_tok[slot] = p >> 2; }
}

__device__ __forceinline__ void p13_final(Frame& F, const Args& args) {
    const bf16* X1 = (const bf16*)(F.ws + WS_X1); const float* mod = (const float*)(F.ws + WS_MOD); const unsigned char* YE = F.ws + WS_YE; const int* tok_slot = (const int*)(F.ws + WS_ROUTE + RT_TOKSLOT);
    const int gw = F.vcu * NWAVES + F.wave, NGW = F.G * NWAVES;
    typedef int i32x4 __attribute__((ext_vector_type(4)));
    f32x4 fg[8];
#pragma unroll
    for (int j = 0; j < 4; ++j)
#pragma unroll
        for (int hh = 0; hh < 2; ++hh) fg[2 * j + hh] = *(const GAS f32x4*)(args.in[29] + 512 * j + 8 * F.lane + 4 * hh);
    i32x4 sl = *(const GAS i32x4*)(tok_slot + 4 * (gw < M ? gw : 0));
    for (int m = gw; m < M; m += NGW) {
        const int b = m / SEQ; const float* g2 = mod + (size_t)b * 12288 + 5 * D;
        const int s0 = sl.x, s1 = sl.y, s2 = sl.z, s3 = sl.w;
        { const int mn = (m + NGW < M) ? m + NGW : m; sl = *(const GAS i32x4*)(tok_slot + 4 * mn); }
        const GAS v4u* xr = (const GAS v4u*)(X1 + (size_t)m * D) + F.lane;
        f32x4 v[8]; float ss = 0.f;
#pragma unroll
        for (int j = 0; j < 4; ++j) { const int c = 512 * j + 8 * F.lane;
            const v2u y0 = *(const GAS v2u*)(YE + (size_t)s0 * D + c), y1 = *(const GAS v2u*)(YE + (size_t)s1 * D + c), y2 = *(const GAS v2u*)(YE + (size_t)s2 * D + c), y3 = *(const GAS v2u*)(YE + (size_t)s3 * D + c);
            const v4u xv = xr[64 * j];
            const unsigned q0[2] = {y0.x, y0.y}, q1[2] = {y1.x, y1.y}, q2[2] = {y2.x, y2.y}, q3[2] = {y3.x, y3.y}; const unsigned xw[4] = {xv.x, xv.y, xv.z, xv.w};
#pragma unroll
            for (int hh = 0; hh < 2; ++hh) {
                const f32x2 a0 = __builtin_amdgcn_cvt_pk_f32_fp8((int)q0[hh], false), a1 = __builtin_amdgcn_cvt_pk_f32_fp8((int)q0[hh], true), b0 = __builtin_amdgcn_cvt_pk_f32_fp8((int)q1[hh], false), b1 = __builtin_amdgcn_cvt_pk_f32_fp8((int)q1[hh], true);
                const f32x2 c0 = __builtin_amdgcn_cvt_pk_f32_fp8((int)q2[hh], false), c1 = __builtin_amdgcn_cvt_pk_f32_fp8((int)q2[hh], true), d0 = __builtin_amdgcn_cvt_pk_f32_fp8((int)q3[hh], false), d1 = __builtin_amdgcn_cvt_pk_f32_fp8((int)q3[hh], true);
                const f32x2 lo = ((a0 + b0) + c0) + d0, hi = ((a1 + b1) + c1) + d1;
                const f32x4 f = (f32x4){lo.x, lo.y, hi.x, hi.y} * (1.0f / Y8_SCALE);
                const f32x4 x4 = (f32x4){bflo(xw[2 * hh]), bfhi(xw[2 * hh]), bflo(xw[2 * hh + 1]), bfhi(xw[2 * hh + 1])};
                v[2 * j + hh] = x4 + *(const GAS f32x4*)(g2 + c + 4 * hh) * f;
                ss += (v[2 * j + hh].x * v[2 * j + hh].x + v[2 * j + hh].y * v[2 * j + hh].y) + (v[2 * j + hh].z * v[2 * j + hh].z + v[2 * j + hh].w * v[2 * j + hh].w); } }
        const float rstd = 1.0f / sqrtf(wave_sum(ss) * (1.0f / D) + NORM_EPS);
        float* orow = args.out + (size_t)m * D;
#pragma unroll
        for (int j = 0; j < 4; ++j)
#pragma unroll
            for (int hh = 0; hh < 2; ++hh) { const int c = 512 * j + 8 * F.lane + 4 * hh; *(GAS f32x4*)(orow + c) = v[2 * j + hh] * rstd * fg[2 * j + hh]; }
    }
}

__global__ void __launch_bounds__(NWAVES * 64, 2) mk_fwd(Args args) {
    extern __shared__ __attribute__((aligned(16))) unsigned char lds[];
    Frame F;
    F.lds = (LAS unsigned char*)lds;
    F.MISC = (volatile LAS unsigned*)(F.lds + MISC_OFF);
    F.tid = threadIdx.x; F.lane = F.tid & 63; F.wave = __builtin_amdgcn_readfirstlane(F.tid >> 6);
    F.G = gridDim.x; { const int bx = blockIdx.x; F.vcu = (F.G % 8 == 0) ? (bx % 8) * (F.G / 8) + bx / 8 : bx; }
    F.ws = args.ws; F.ctl = (gu32*)(args.ws + WS_CTL);
    for (int u = F.tid; u < 64; u += NWAVES * 64) ((LAS unsigned*)(F.lds + MISC_OFF))[u] = 0u;
    __syncthreads();
    XcdBarrier bar; bar.bar = (unsigned*)(F.ctl + CW_BAR); bar.x = 0; bar.st = nullptr;
    if (N_LAUNCHES == 1) bar = xcd_barrier_post((unsigned*)(F.ctl + CW_BAR), F.MISC + 8);
#define GRID_BAR() do { if (N_LAUNCHES == 1) { xcd_barrier(bar); } } while (0)
    const int lo = args.ph_lo, hi = args.ph_hi;
#ifndef PROBE_REPEAT
#define PROBE_REPEAT 0
#endif
#define REP(k) for (int rep_ = 0; rep_ < (((PROBE_REPEAT) >> (k)) & 1) + 1; ++rep_)
#define IN(k) (lo <= (k) && (k) < hi)
#define BOTH(k) (IN(k) && IN((k) + 1))
    unsigned char* ws = args.ws;
    pg8::bf16_t* const Hb = (pg8::bf16_t*)(ws + WS_H); pg8::bf16_t* const PROJ = (pg8::bf16_t*)(ws + WS_PROJ);

    if (IN(0)) REP(0) { p0_prologue(F, args); if (BOTH(0)) GRID_BAR(); }
    if (IN(1)) REP(1) { p1_norm1(F, args); if (BOTH(1)) GRID_BAR(); }
    if (IN(2)) REP(2) {
        const int bx = (int)blockIdx.x; const bool ded = (F.G == 256) && bx >= P2_GEMM_WGS;
        pg8::Gemm g{Hb, (const pg8::bf16_t*)(ws + WS_WIN), M, NPROJ, D, 0}; pg8::StaticOrder S; S.init(M, NPROJ, (F.G == 256) ? P2_GEMM_WGS : F.G, bx);
        pg8::EpiBf16<0> E{PROJ, NPROJ, nullptr, 0, 0, 1.f};
        if (!ded) pg8::gemm_phase<pg8::EpiBf16<0>, pg8::StaticOrder, PG8_ALIGN, PG8_SP2>(F.lds, g, S, E);
        if (F.G == 256) {
            if (ded) p8_convert(F, args, P8_SPLITD, P8_SPLITR, (bx - P2_GEMM_WGS) * NWAVES + F.wave, (256 - P2_GEMM_WGS) * NWAVES, 0);
            else if (bx >= P2_NFULL) p8_convert(F, args, P8_SPLITA, P8_SPLIT, (bx - P2_NFULL) * NWAVES + F.wave, (P2_GEMM_WGS - P2_NFULL) * NWAVES, 0); }
        else { p8_convert(F, args, P8_SPLITD, P8_SPLITR, F.vcu * NWAVES + F.wave, F.G * NWAVES, 0); p8_convert(F, args, P8_SPLITA, P8_SPLIT, F.vcu * NWAVES + F.wave, F.G * NWAVES, 0); }
        if (BOTH(2)) GRID_BAR();
    }
    if (IN(3)) REP(3) { p3_lora_a(F, args); if (BOTH(3)) GRID_BAR(); }
    if (IN(4)) REP(4) {
        pg8::Gemm g{(const pg8::bf16_t*)(ws + WS_LORA_A), (const pg8::bf16_t*)(ws + WS_WLORA), M, LORA_N, LORA_K, 0}; pg8::StaticOrder S; S.init(M, LORA_N, F.G, (int)blockIdx.x);
        pg8::EpiBf16<0> E{(pg8::bf16_t*)(ws + WS_LORA_O), LORA_N, nullptr, 0, 0, 1.f};
        pg8::gemm_phase<pg8::EpiBf16<0>, pg8::StaticOrder, PG8_ALIGN, PG8_SP2>(F.lds, g, S, E);
        if (BOTH(4)) GRID_BAR();
    }
    if (IN(5)) REP(5) {
        if (F.G == 256) { const int bx = (int)blockIdx.x;
            if (bx < 128) { rwkv_chunk_scan(F, args, bx); __syncthreads(); p8_convert(F, args, P8_SPLITR, P8_SPLITH, bx * NWAVES + F.wave, 128 * NWAVES, 0); } else if (bx < 192) { hgrn_chunk_scan(F, args, bx - 128); __syncthreads(); p8_convert(F, args, P8_SPLITH, P8_SPLITA, (bx - 128) * NWAVES + F.wave, 64 * NWAVES, 0); } else p8_convert(F, args, P8_SPLIT, P8_N, (bx - 192) * NWAVES + F.wave, 64 * NWAVES, 0); }
        else { for (int u = F.vcu; u < 192; u += F.G) { if (u < 128) rwkv_chunk_scan(F, args, u); else hgrn_chunk_scan(F, args, u - 128); } __syncthreads(); p8_convert(F, args, P8_SPLITR, P8_SPLITA, F.vcu * NWAVES + F.wave, F.G * NWAVES, 0); p8_convert(F, args, P8_SPLIT, P8_N, F.vcu * NWAVES + F.wave, F.G * NWAVES, 0); }
        if (BOTH(5)) GRID_BAR();
        if ((PROBE_REPEAT >> 14) & 1) { for (int u = F.vcu; u < 192; u += F.G) { if (u < 128) rwkv_chunk_scan(F, args, u); } GRID_BAR(); }
        if ((PROBE_REPEAT >> 15) & 1) { for (int u = F.vcu; u < 192; u += F.G) { if (u >= 128) hgrn_chunk_scan(F, args, u - 128); } GRID_BAR(); }
    }
    if (IN(6)) {   }
    if (IN(7)) REP(7) {
        pg8::Gemm g{(const pg8::bf16_t*)(ws + WS_YA), (const pg8::bf16_t*)(ws + WS_WPA), M, D, RW, 0, nullptr, (const pg8::bf16_t*)(ws + WS_YB), (const pg8::bf16_t*)(ws + WS_WPB)}; pg8::PairOrder S; S.init(M, D, F.G, (int)blockIdx.x);
        pg8::EpiMerge E{PROJ + GATE_BASE, NPROJ, D, (pg8::bf16_t*)(ws + WS_MERGED), D};
        pg8::gemm_phase<pg8::EpiMerge, pg8::PairOrder, PG8_ALIGN, PG8_SP2>(F.lds, g, S, E);
        if (BOTH(7)) GRID_BAR();
    }
    if (IN(8)) REP(8) {
        pg8::Gemm g{(const pg8::bf16_t*)(ws + WS_MERGED), (const pg8::bf16_t*)(ws + WS_WOUT), M, D, D, 0}; pg8::StaticOrder S; S.init(M, D, F.G, (int)blockIdx.x);
        pg8::EpiRes E{args.in[0], (pg8::bf16_t*)(ws + WS_X1), D, (const float*)(ws + WS_MOD) + 2 * D, 12288, SEQ, (float*)(ws + WS_MODP)};
        pg8::gemm_phase<pg8::EpiRes, pg8::StaticOrder, PG8_ALIGN, PG8_SP2>(F.lds, g, S, E);
        if (BOTH(8)) GRID_BAR();
    }
    if ((PROBE_REPEAT >> 16) & 1) { if (IN(8)) {
        pg8::Gemm g{(const pg8::bf16_t*)(ws + WS_MERGED), (const pg8::bf16_t*)(ws + WS_WOUT), M, D, D, 0}; pg8::StaticOrder S; S.init(M, D, F.G, (int)blockIdx.x);
        pg8::EpiNull E{(float*)(ws + WS_T1)};
        pg8::gemm_phase<pg8::EpiNull, pg8::StaticOrder, PG8_ALIGN, PG8_SP2>(F.lds, g, S, E);
        GRID_BAR();
        if ((PROBE_REPEAT >> 17) & 1) { pg8::gemm_phase<pg8::EpiNull, pg8::StaticOrder, PG8_ALIGN, PG8_SP2>(F.lds, g, S, E); GRID_BAR(); } } }
    if (IN(9)) REP(9) { p9_norm2_router(F, args); if (BOTH(9)) GRID_BAR(); }
    if (IN(10)) REP(10) { p10_dispatch(F, args); if (BOTH(10)) GRID_BAR(); }
    if (IN(11)) REP(11) {
        const int* tile_e = (const int*)(ws + WS_ROUTE + RT_TILEE); const int nt = tile_e[MAXTILES];
        pg8::Gemm g{(const pg8::bf16_t*)(ws + WS_XG), (const pg8::bf16_t*)(ws + WS_WGU), nt * 256, 2 * DE, D / 2, (size_t)2 * DE * D, (const int*)(ws + WS_ROUTE + RT_SLOTTOK)};     pg8::GroupedOrder S; S.init(nt * 256, 2 * DE, F.G, (int)blockIdx.x); S.tile_e = tile_e;
        pg8::EpiSwigluF8 E{ws + WS_ACT, DE, args.in[26], DE, 1.0f / (W8_SCALE * H8_SCALE), A8_SCALE};
        pg8::gemm_phase<pg8::EpiSwigluF8, pg8::GroupedOrder, PG8_ALIGN, PG8_SP2, true, true>(F.lds, g, S, E);
        {
            const int nwg = nt * ((2 * DE) / 256), R = (nwg + F.G - 1) / F.G, nfull = nwg - F.G * (R - 1), s = F.G - nfull, bx = (int)blockIdx.x;
            const int capA = (P11_TAIL_ITEMS * s < P8_Q) ? P11_TAIL_ITEMS * s : P8_Q;
            if (s > 0 && bx >= nfull) p8_convert(F, args, P8_N, P8_N + capA, (bx - nfull) * NWAVES + F.wave, s * NWAVES, 0);
            if (capA < P8_Q) p8_convert(F, args, P8_N + capA, P8_N + P8_Q, F.vcu * NWAVES + F.wave, F.G * NWAVES, 0);
        }
        if (BOTH(11)) GRID_BAR();
    }
    if (IN(12)) REP(12) {
        const int* tile_e = (const int*)(ws + WS_ROUTE + RT_TILEE); const int nt = tile_e[MAXTILES];
        pg8::Gemm g{(const pg8::bf16_t*)(ws + WS_ACT), (const pg8::bf16_t*)(ws + WS_WDN), nt * 256, D, DE / 2, (size_t)D * DE, nullptr}; pg8::GroupedOrder S; S.init(nt * 256, D, F.G, (int)blockIdx.x); S.tile_e = tile_e;
        pg8::EpiDown E{ws + WS_YE, D, args.in[28], (const float*)(ws + WS_ROUTE + RT_SLOTW), 1.0f / (W8_SCALE * A8_SCALE), Y8_SCALE};
        pg8::gemm_phase<pg8::EpiDown, pg8::GroupedOrder, PG8_ALIGN, PG8_SP2, false, true>(F.lds, g, S, E);
        if (BOTH(12)) GRID_BAR();
    }
    if (IN(13)) REP(13) { p13_final(F, args); }
#undef IN
#undef BOTH
}

extern "C" void kernel_launch(void* const* d_in, const int* in_sizes, int n_in, void* d_out, int out_size, void* d_ws, size_t ws_size, hipStream_t stream) {
    static int grid = 0;
    if (grid == 0) {
        if (n_in != 30 || out_size != M * D || ws_size < WS_END) { fprintf(stderr, "kernel_launch: unexpected shapes (n_in %d, out %d, ws %zu)\n", n_in, out_size, ws_size); grid = -1; return; }
        int dev = 0, cus = 0, per_cu = 0;
        if (hipGetDevice(&dev) != hipSuccess || hipDeviceGetAttribute(&cus, hipDeviceAttributeMultiprocessorCount, dev) != hipSuccess) { grid = -1; return; }
        if (hipFuncSetAttribute((const void*)mk_fwd, hipFuncAttributeMaxDynamicSharedMemorySize, LDS_BYTES) != hipSuccess) { fprintf(stderr, "kernel_launch: hipFuncSetAttribute failed\n"); grid = -1; return; }
        if (hipOccupancyMaxActiveBlocksPerMultiprocessor(&per_cu, (const void*)mk_fwd, NWAVES * 64, LDS_BYTES) != hipSuccess || per_cu < 1) fprintf(stderr, "kernel_launch: occupancy query reports %d\n", per_cu);
        (void)hipGetLastError();
        grid = cus;
    }
    if (grid < 0) return;
    (void)in_sizes;
    if (hipMemsetAsync((char*)d_ws + WS_CTL, 0, CTL_ZERO_BYTES, stream) != hipSuccess) return;
    Args a{};
    for (int i = 0; i < 30; ++i) a.in[i] = (const float*)d_in[i];
    a.out = (float*)d_out; a.ws = (unsigned char*)d_ws;
    for (int li = 0; li < N_LAUNCHES; ++li) {
        a.ph_lo = (N_LAUNCHES == 1) ? 0 : li; a.ph_hi = (N_LAUNCHES == 1) ? N_PHASES : li + 1; a.li = li; a.pad = 0;
        hipLaunchKernelGGL(mk_fwd, dim3(grid), dim3(NWAVES * 64), LDS_BYTES, stream, a);
        const hipError_t le = hipPeekAtLastError();
        if (le != hipSuccess) { fprintf(stderr, "kernel_launch: launch %d failed: %s\n", li, hipGetErrorName(le)); break; }
    }
}
```

```cpp
#include <hip/hip_runtime.h>
#include <cstdio>
#include <cstdint>
namespace pg8 {
#define PG8_LAS __attribute__((address_space(3)))
typedef unsigned short bf16_t;
typedef short bf16x8 __attribute__((ext_vector_type(8)));
typedef float f32x4 __attribute__((ext_vector_type(4)));
typedef unsigned u32x4 __attribute__((ext_vector_type(4)));
typedef int i32x4_t __attribute__((ext_vector_type(4)));
constexpr int BM = 256, BK = 64, HALF = 128, HTB = HALF * BK * 2  , STAGE_BYTES = 8 * HTB, NXCD = 8, WGM = 8;

__host__ __device__ __forceinline__ int lds_byte(int r, int c) { const int st = (r >> 4) * 2 + (c >> 5), rr = r & 15, cc = c & 31, ob = rr * 64 + cc * 2; return st * 1024 + (ob ^ (((ob >> 9) & 1) << 5)); }
__host__ __device__ __forceinline__ void stage_rc(int b, int& R, int& C) { const int st = b / 1024, sb = b % 1024, swz = sb ^ (((sb >> 9) & 1) << 5); R = (st >> 1) * 16 + swz / 64; C = (st & 1) * 32 + (swz % 64) / 2; }
__host__ __device__ __forceinline__ int perm32(int rho) { const int n = rho >> 4, i = rho & 15; return 8 * (i >> 2) + 4 * n + (i & 3); }

struct Unit { int pm, pn, e, kh; };
struct Gemm { const bf16_t* A; const bf16_t* Bt; int M, N, K; size_t bgs; const int* gather; const bf16_t* A2; const bf16_t* Bt2; };

struct StaticOrder {
    static constexpr bool PAIRS = false;
    int nM, nN, nwg, G, c;
    __host__ __device__ void init(int M, int N, int G_, int c_) { nM = M / BM; nN = N / BM; nwg = nM * nN; G = G_; c = c_; }
    __host__ __device__ bool next(int i, Unit& u) const {
        const long L = (long)i * G + c; if (L >= nwg) return false;
        int wgid = (int)L; { const int q = nwg / NXCD, r = nwg % NXCD, xcd = wgid % NXCD, off = wgid / NXCD; wgid = (xcd < r ? xcd * (q + 1) : r * (q + 1) + (xcd - r) * q) + off; }
        const int nig = WGM * nN, gid = wgid / nig, fm = gid * WGM, gsz = (nM - fm) < WGM ? (nM - fm) : WGM;
        u.pm = fm + ((wgid % nig) % gsz); u.pn = (wgid % nig) / gsz; u.e = 0; u.kh = 0; return true;
    }
    __device__ __forceinline__ void a_ready(const Unit&) const {}
    __device__ __forceinline__ void done(const Unit&) const {}
};

__device__ __forceinline__ unsigned cvt_pk_bf16(float lo, float hi) { unsigned r; asm volatile("v_cvt_pk_bf16_f32 %0, %1, %2" : "=v"(r) : "v"(lo), "v"(hi)); return r; }
typedef float f32x2 __attribute__((ext_vector_type(2)));
__device__ __forceinline__ f32x2 gelu_pk(f32x2 v) {
    const f32x2 av = __builtin_elementwise_abs(v), d = av * 0.2316418882f + 1.0f;
    f32x2 t; t.x = __builtin_amdgcn_rcpf(d.x); t.y = __builtin_amdgcn_rcpf(d.y);
    f32x2 q = t * 0.5307027145f + (-0.7265760135f); q = q * t + 0.7107068705f; q = q * t + (-0.142248368f); q = q * t + 0.127414796f; q = q * t;
    const f32x2 s = (v * v) * (-0.72134752044f);
    f32x2 e; e.x = __builtin_amdgcn_exp2f(s.x); e.y = __builtin_amdgcn_exp2f(s.y);
    const f32x2 m = v * (q * e), r = v - m;
    f32x2 o; o.x = v.x < 0.f ? m.x : r.x; o.y = v.y < 0.f ? m.y : r.y; return o;
}

template <int ACT  > struct EpiBf16 {
    static constexpr bool PERM = true, AFTER_DRAIN = false, MID = false; static_assert(ACT == 0 || ACT == 1, "EpiBf16: ACT is 0 (none) or 1 (gelu_pk)");
    bf16_t* O; int ldc; const float* bias; int split_cols; size_t split_stride; float scale0;
    __device__ __forceinline__ void operator()(const f32x4 (&acc)[2][2][4][2], const Unit& u, int wr, int wc, int fr, int fq) const {
        const int row0 = u.pm * BM + wr * 64 + fr; int colt = u.pn * BM; bf16_t* base = O;
        float sc = 1.f; if (split_cols) { const int t = colt / split_cols; base += (size_t)t * split_stride; colt -= t * split_cols; if (t == 0) sc = scale0; }
        const int col0 = colt + wc * 32 + 8 * fq, bcol0 = u.pn * BM + wc * 32 + 8 * fq;
        f32x4 bv[2][2];
#pragma unroll
        for (int bj = 0; bj < 2; ++bj)
#pragma unroll
            for (int n = 0; n < 2; ++n) bv[bj][n] = bias ? *(const f32x4*)(bias + bcol0 + bj * HALF + 4 * n) : (f32x4){0.f, 0.f, 0.f, 0.f};
#pragma unroll
        for (int ai = 0; ai < 2; ++ai)
#pragma unroll
            for (int m = 0; m < 4; ++m) { bf16_t* rowp = base + (size_t)(row0 + ai * HALF + m * 16) * ldc + col0;
#pragma unroll
                for (int bj = 0; bj < 2; ++bj) { f32x4 v0 = acc[ai][bj][m][0] + bv[bj][0], v1 = acc[ai][bj][m][1] + bv[bj][1];
                    if (ACT == 1) { f32x2 a = gelu_pk((f32x2){v0[0], v0[1]}), b = gelu_pk((f32x2){v0[2], v0[3]}), c = gelu_pk((f32x2){v1[0], v1[1]}), d = gelu_pk((f32x2){v1[2], v1[3]});
                        v0 = (f32x4){a.x, a.y, b.x, b.y}; v1 = (f32x4){c.x, c.y, d.x, d.y}; }
                    v0 = v0 * sc; v1 = v1 * sc; u32x4 w; w.x = cvt_pk_bf16(v0[0], v0[1]); w.y = cvt_pk_bf16(v0[2], v0[3]); w.z = cvt_pk_bf16(v1[0], v1[1]); w.w = cvt_pk_bf16(v1[2], v1[3]);
                    *(u32x4*)(rowp + bj * HALF) = w; } }
    }
};


__device__ __forceinline__ float bf_lo(unsigned w) { return __uint_as_float(w << 16); }
__device__ __forceinline__ float bf_hi(unsigned w) { return __uint_as_float(w & 0xffff0000u); }
__device__ __forceinline__ float sigm(float x) { return __builtin_amdgcn_rcpf(1.0f + __expf(-x)); }
typedef unsigned u32x2 __attribute__((ext_vector_type(2)));

struct EpiF32 {
    static constexpr bool PERM = false, AFTER_DRAIN = false, MID = false;
    float* C; int ldc;
    __device__ __forceinline__ void operator()(const f32x4 (&acc)[2][2][4][2], const Unit& u, int wr, int wc, int fr, int fq) const {
        const int row0 = u.pm * BM + wr * 64 + fr, col0 = u.pn * BM + wc * 32 + 4 * fq;
#pragma unroll
        for (int ai = 0; ai < 2; ++ai)
#pragma unroll
            for (int m = 0; m < 4; ++m) { float* rowp = C + (size_t)(row0 + ai * HALF + m * 16) * ldc + col0;
#pragma unroll
                for (int bj = 0; bj < 2; ++bj)
#pragma unroll
                    for (int n = 0; n < 2; ++n) *(f32x4*)(rowp + bj * HALF + n * 16) = acc[ai][bj][m][n]; }
    }
};
template <int PASS> struct EpiGate {
    static constexpr bool PERM = false, AFTER_DRAIN = false, MID = false;
    const bf16_t* gate; int ldg; bf16_t* T1; bf16_t* O; int ldc;
    __device__ __forceinline__ void operator()(const f32x4 (&acc)[2][2][4][2], const Unit& u, int wr, int wc, int fr, int fq) const {
        const int row0 = u.pm * BM + wr * 64 + fr, col0 = u.pn * BM + wc * 32 + 4 * fq;
#pragma unroll
        for (int ai = 0; ai < 2; ++ai) {
            u32x2 gv[4][2][2];
#pragma unroll
            for (int m = 0; m < 4; ++m) { const size_t r = (size_t)(row0 + ai * HALF + m * 16);
#pragma unroll
                for (int bj = 0; bj < 2; ++bj)
#pragma unroll
                    for (int n = 0; n < 2; ++n) gv[m][bj][n] = *(const u32x2*)(gate + r * ldg + col0 + bj * HALF + n * 16); }
#pragma unroll
            for (int mh = 0; mh < 2; ++mh) {
                u32x2 tv[2][2][2];
                if (PASS == 1) {
#pragma unroll
                    for (int m2 = 0; m2 < 2; ++m2) { const size_t r = (size_t)(row0 + ai * HALF + (2 * mh + m2) * 16);
#pragma unroll
                        for (int bj = 0; bj < 2; ++bj)
#pragma unroll
                            for (int n = 0; n < 2; ++n) tv[m2][bj][n] = *(const u32x2*)(T1 + r * ldc + col0 + bj * HALF + n * 16); } }
#pragma unroll
                for (int m2 = 0; m2 < 2; ++m2) { const int m = 2 * mh + m2; const size_t r = (size_t)(row0 + ai * HALF + m * 16);
#pragma unroll
                    for (int bj = 0; bj < 2; ++bj)
#pragma unroll
                        for (int n = 0; n < 2; ++n) { const int c = col0 + bj * HALF + n * 16; const u32x2 g2 = gv[m][bj][n];
                            f32x4 s; s[0] = sigm(bf_lo(g2.x)); s[1] = sigm(bf_hi(g2.x)); s[2] = sigm(bf_lo(g2.y)); s[3] = sigm(bf_hi(g2.y));
                            f32x4 v = acc[ai][bj][m][n] * s;
                            if (PASS == 0) { u32x2 w; w.x = cvt_pk_bf16(v[0], v[1]); w.y = cvt_pk_bf16(v[2], v[3]); *(u32x2*)(T1 + r * ldc + c) = w; }
                            else { const u32x2 t2 = tv[m2][bj][n]; v[0] += bf_lo(t2.x); v[1] += bf_hi(t2.x); v[2] += bf_lo(t2.y); v[3] += bf_hi(t2.y); u32x2 w; w.x = cvt_pk_bf16(v[0], v[1]); w.y = cvt_pk_bf16(v[2], v[3]); *(u32x2*)(O + r * ldc + c) = w; } } }
                asm volatile("" ::: "memory"); }
        }
    }
};
struct EpiMerge {
    static constexpr bool PERM = true, AFTER_DRAIN = false, MID = true;
    const bf16_t* gate; int ldg; int gboff; bf16_t* O; int ldc;
    __device__ __forceinline__ void mid(f32x4 (&acc)[2][2][4][2], const Unit& u, int wr, int wc, int fr, int fq) const {
        const int row0 = u.pm * BM + wr * 64 + fr, col0 = u.pn * BM + wc * 32 + 8 * fq;
#pragma unroll
        for (int ai = 0; ai < 2; ++ai) {
            u32x4 ga[4][2], gb[4][2];
#pragma unroll
            for (int m = 0; m < 4; ++m) { const bf16_t* gp = gate + (size_t)(row0 + ai * HALF + m * 16) * ldg + col0;
#pragma unroll
                for (int bj = 0; bj < 2; ++bj) { ga[m][bj] = *(const u32x4*)(gp + bj * HALF); gb[m][bj] = *(const u32x4*)(gp + gboff + bj * HALF); } }
#pragma unroll
            for (int m = 0; m < 4; ++m)
#pragma unroll
                for (int bj = 0; bj < 2; ++bj) { const u32x4 a = ga[m][bj], b = gb[m][bj]; f32x4 s0, s1;
                    s0[0] = sigm(bf_lo(a.x)) * (1.0f + __expf(-bf_lo(b.x))); s0[1] = sigm(bf_hi(a.x)) * (1.0f + __expf(-bf_hi(b.x)));
                    s0[2] = sigm(bf_lo(a.y)) * (1.0f + __expf(-bf_lo(b.y))); s0[3] = sigm(bf_hi(a.y)) * (1.0f + __expf(-bf_hi(b.y)));
                    s1[0] = sigm(bf_lo(a.z)) * (1.0f + __expf(-bf_lo(b.z))); s1[1] = sigm(bf_hi(a.z)) * (1.0f + __expf(-bf_hi(b.z)));
                    s1[2] = sigm(bf_lo(a.w)) * (1.0f + __expf(-bf_lo(b.w))); s1[3] = sigm(bf_hi(a.w)) * (1.0f + __expf(-bf_hi(b.w)));
                    acc[ai][bj][m][0] = acc[ai][bj][m][0] * s0; acc[ai][bj][m][1] = acc[ai][bj][m][1] * s1; }
            asm volatile("" ::: "memory"); }
    }
    __device__ __forceinline__ void operator()(const f32x4 (&acc)[2][2][4][2], const Unit& u, int wr, int wc, int fr, int fq) const {
        const int row0 = u.pm * BM + wr * 64 + fr, col0 = u.pn * BM + wc * 32 + 8 * fq;
#pragma unroll
        for (int ai = 0; ai < 2; ++ai) {
            u32x4 gb[4][2];
#pragma unroll
            for (int m = 0; m < 4; ++m) { const bf16_t* gp = gate + (size_t)(row0 + ai * HALF + m * 16) * ldg + col0 + gboff;
#pragma unroll
                for (int bj = 0; bj < 2; ++bj) gb[m][bj] = *(const u32x4*)(gp + bj * HALF); }
#pragma unroll
            for (int m = 0; m < 4; ++m) { bf16_t* op = O + (size_t)(row0 + ai * HALF + m * 16) * ldc + col0;
#pragma unroll
                for (int bj = 0; bj < 2; ++bj) { const u32x4 b = gb[m][bj]; const f32x4 a0 = acc[ai][bj][m][0], a1 = acc[ai][bj][m][1];
                    u32x4 w; w.x = cvt_pk_bf16(a0[0] * sigm(bf_lo(b.x)), a0[1] * sigm(bf_hi(b.x))); w.y = cvt_pk_bf16(a0[2] * sigm(bf_lo(b.y)), a0[3] * sigm(bf_hi(b.y)));
                    w.z = cvt_pk_bf16(a1[0] * sigm(bf_lo(b.z)), a1[1] * sigm(bf_hi(b.z))); w.w = cvt_pk_bf16(a1[2] * sigm(bf_lo(b.w)), a1[3] * sigm(bf_hi(b.w)));
                    *(u32x4*)(op + bj * HALF) = w; } }
            asm volatile("" ::: "memory"); }
    }
};
struct EpiRes {
    static constexpr bool PERM = true, AFTER_DRAIN = false, MID = false;
    const float* base; bf16_t* out; int ldc; const float* gvec; int bpitch; int rows_per_batch; float* ssq;
    __device__ __forceinline__ void operator()(const f32x4 (&acc)[2][2][4][2], const Unit& u, int wr, int wc, int fr, int fq) const {
        const int row0 = u.pm * BM + wr * 64 + fr, col0 = u.pn * BM + wc * 32 + 8 * fq;
        const float* gb = gvec + (size_t)((u.pm * BM) / rows_per_batch) * bpitch + col0;
        f32x4 gv[2][2];
#pragma unroll
        for (int bj = 0; bj < 2; ++bj)
#pragma unroll
            for (int n = 0; n < 2; ++n) gv[bj][n] = *(const f32x4*)(gb + bj * HALF + n * 4);
#pragma unroll
        for (int ai = 0; ai < 2; ++ai) {
            f32x4 bs[4][2][2];
#pragma unroll
            for (int m = 0; m < 4; ++m) { const size_t off = (size_t)(row0 + ai * HALF + m * 16) * ldc + col0;
#pragma unroll
                for (int bj = 0; bj < 2; ++bj)
#pragma unroll
                    for (int n = 0; n < 2; ++n) bs[m][bj][n] = *(const f32x4*)(base + off + bj * HALF + n * 4); }
#pragma unroll
            for (int m = 0; m < 4; ++m) { const size_t off = (size_t)(row0 + ai * HALF + m * 16) * ldc + col0; float sq = 0.f;
#pragma unroll
                for (int bj = 0; bj < 2; ++bj) { const f32x4 o0 = bs[m][bj][0] + gv[bj][0] * acc[ai][bj][m][0], o1 = bs[m][bj][1] + gv[bj][1] * acc[ai][bj][m][1];
                    u32x4 w; w.x = cvt_pk_bf16(o0[0], o0[1]); w.y = cvt_pk_bf16(o0[2], o0[3]); w.z = cvt_pk_bf16(o1[0], o1[1]); w.w = cvt_pk_bf16(o1[2], o1[3]);
                    *(u32x4*)(out + off + bj * HALF) = w;
                    sq += ((o0[0] * o0[0] + o0[1] * o0[1]) + (o0[2] * o0[2] + o0[3] * o0[3])) + ((o1[0] * o1[0] + o1[1] * o1[1]) + (o1[2] * o1[2] + o1[3] * o1[3])); }
                sq += __shfl_xor(sq, 16); sq += __shfl_xor(sq, 32);
                if (fq == 0) ssq[(size_t)(row0 + ai * HALF + m * 16) * 32 + 4 * u.pn + wc] = sq; }
            asm volatile("" ::: "memory"); }
    }
};
struct EpiSwiglu {
    static constexpr bool PERM = true, AFTER_DRAIN = false, MID = false;
    bf16_t* O; int ldc; const float* bias; int de;
    __device__ __forceinline__ void operator()(const f32x4 (&acc)[2][2][4][2], const Unit& u, int wr, int wc, int fr, int fq) const {
        const int row0 = u.pm * BM + wr * 64 + fr, cl = u.pn * HALF + wc * 32 + 8 * fq;
        const float* bb = bias + (size_t)u.e * 2 * de + cl;
        f32x4 bg[2], bl[2];
#pragma unroll
        for (int n = 0; n < 2; ++n) { bg[n] = *(const f32x4*)(bb + 4 * n); bl[n] = *(const f32x4*)(bb + de + 4 * n); }
#pragma unroll
        for (int ai = 0; ai < 2; ++ai)
#pragma unroll
            for (int m = 0; m < 4; ++m) { bf16_t* rowp = O + (size_t)(row0 + ai * HALF + m * 16) * ldc + cl;
                f32x4 a[2];
#pragma unroll
                for (int n = 0; n < 2; ++n) { const f32x4 g = acc[ai][0][m][n] + bg[n], l = acc[ai][1][m][n] + bl[n];
#pragma unroll
                    for (int j = 0; j < 4; ++j) { const float gg = fminf(g[j], 7.0f), ll = fminf(fmaxf(l[j], -7.0f), 7.0f); a[n][j] = gg * sigm(1.702f * gg) * (ll + 1.0f); } }
                u32x4 w; w.x = cvt_pk_bf16(a[0][0], a[0][1]); w.y = cvt_pk_bf16(a[0][2], a[0][3]); w.z = cvt_pk_bf16(a[1][0], a[1][1]); w.w = cvt_pk_bf16(a[1][2], a[1][3]);
                *(u32x4*)rowp = w; }
    }
};
__device__ __forceinline__ float clamp448(float v) { return fminf(fmaxf(v, -448.0f), 448.0f); }
struct EpiSwigluF8 {
    static constexpr bool PERM = true, AFTER_DRAIN = false, MID = false;
    unsigned char* O; int ldc; const float* bias; int de; float ascale, oscale;
    __device__ __forceinline__ void operator()(const f32x4 (&acc)[2][2][4][2], const Unit& u, int wr, int wc, int fr, int fq) const {
        const int row0 = u.pm * BM + wr * 64 + fr, cl = u.pn * HALF + wc * 32 + 8 * fq;
        const float* bb = bias + (size_t)u.e * 2 * de + cl;
        f32x4 bg[2], bl[2];
#pragma unroll
        for (int n = 0; n < 2; ++n) { bg[n] = *(const f32x4*)(bb + 4 * n); bl[n] = *(const f32x4*)(bb + de + 4 * n); }
#pragma unroll
        for (int ai = 0; ai < 2; ++ai)
#pragma unroll
            for (int m = 0; m < 4; ++m) { unsigned char* rowp = O + (size_t)(row0 + ai * HALF + m * 16) * ldc + cl;
                f32x4 a[2];
#pragma unroll
                for (int n = 0; n < 2; ++n) { const f32x4 g = acc[ai][0][m][n] * ascale + bg[n], l = acc[ai][1][m][n] * ascale + bl[n];
                    f32x4 gg, ll, ex, rc;
#pragma unroll
                    for (int j = 0; j < 4; ++j) { gg[j] = fminf(g[j], 7.0f); ll[j] = __builtin_amdgcn_fmed3f(l[j], -7.0f, 7.0f); }
                    const f32x4 t = gg * (-1.702f * 1.44269504089f);
#pragma unroll
                    for (int j = 0; j < 4; ++j) ex[j] = __builtin_amdgcn_exp2f(t[j]);
                    const f32x4 d = ex + 1.0f;
#pragma unroll
                    for (int j = 0; j < 4; ++j) rc[j] = __builtin_amdgcn_rcpf(d[j]);
                    a[n] = (gg * rc) * (ll * oscale + oscale); }
                int w0 = 0, w1 = 0;
                w0 = __builtin_amdgcn_cvt_pk_fp8_f32(a[0][0], a[0][1], w0, false); w0 = __builtin_amdgcn_cvt_pk_fp8_f32(a[0][2], a[0][3], w0, true);
                w1 = __builtin_amdgcn_cvt_pk_fp8_f32(a[1][0], a[1][1], w1, false); w1 = __builtin_amdgcn_cvt_pk_fp8_f32(a[1][2], a[1][3], w1, true);
                u32x2 w; w.x = (unsigned)w0; w.y = (unsigned)w1; *(u32x2*)rowp = w; }
    }
};
struct EpiDown {
    static constexpr bool PERM = true, AFTER_DRAIN = false, MID = false;
    unsigned char* O; int ldc; const float* bias; const float* sw; float ascale, oscale;
    __device__ __forceinline__ void operator()(const f32x4 (&acc)[2][2][4][2], const Unit& u, int wr, int wc, int fr, int fq) const {
        const int row0 = u.pm * BM + wr * 64 + fr, col0 = u.pn * BM + wc * 32 + 8 * fq;
        const float* bb = bias + (size_t)u.e * ldc + col0;
        f32x4 bv[2][2];
#pragma unroll
        for (int bj = 0; bj < 2; ++bj)
#pragma unroll
            for (int n = 0; n < 2; ++n) bv[bj][n] = *(const f32x4*)(bb + bj * HALF + 4 * n);
        float wq[2][4];
#pragma unroll
        for (int ai = 0; ai < 2; ++ai)
#pragma unroll
            for (int m = 0; m < 4; ++m) wq[ai][m] = sw[row0 + ai * HALF + m * 16];
        asm volatile("s_waitcnt vmcnt(0)" ::: "memory");
#pragma unroll
        for (int ai = 0; ai < 2; ++ai)
#pragma unroll
            for (int m = 0; m < 4; ++m) { const int r = row0 + ai * HALF + m * 16; const float w8 = wq[ai][m] * oscale; unsigned char* rowp = O + (size_t)r * ldc + col0;
#pragma unroll
                for (int bj = 0; bj < 2; ++bj) { f32x4 v0 = (acc[ai][bj][m][0] * ascale + bv[bj][0]) * w8, v1 = (acc[ai][bj][m][1] * ascale + bv[bj][1]) * w8;
#pragma unroll
                    for (int j = 0; j < 4; ++j) { v0[j] = __builtin_amdgcn_fmed3f(v0[j], -448.0f, 448.0f); v1[j] = __builtin_amdgcn_fmed3f(v1[j], -448.0f, 448.0f); }
                    int w0 = 0, w1 = 0;
                    w0 = __builtin_amdgcn_cvt_pk_fp8_f32(v0[0], v0[1], w0, false); w0 = __builtin_amdgcn_cvt_pk_fp8_f32(v0[2], v0[3], w0, true);
                    w1 = __builtin_amdgcn_cvt_pk_fp8_f32(v1[0], v1[1], w1, false); w1 = __builtin_amdgcn_cvt_pk_fp8_f32(v1[2], v1[3], w1, true);
                    u32x2 w; w.x = (unsigned)w0; w.y = (unsigned)w1; *(u32x2*)(rowp + bj * HALF) = w; } }
    }
};
struct EpiNull {
    static constexpr bool PERM = false, AFTER_DRAIN = false, MID = false;
    float* dummy;
    __device__ __forceinline__ void operator()(const f32x4 (&acc)[2][2][4][2], const Unit& u, int wr, int wc, int fr, int fq) const {
        f32x4 s = (f32x4){0.f, 0.f, 0.f, 0.f};
#pragma unroll
        for (int ai = 0; ai < 2; ++ai)
#pragma unroll
            for (int bj = 0; bj < 2; ++bj)
#pragma unroll
                for (int m = 0; m < 4; ++m)
#pragma unroll
                    for (int n = 0; n < 2; ++n) s = s + acc[ai][bj][m][n];
        const float t = (s[0] + s[1]) + (s[2] + s[3]);
        if (t == 123456.789f) dummy[u.pm * 64 + u.pn] = t;
    }
};
struct PairOrder : StaticOrder {
    static constexpr bool PAIRS = true;
    __device__ bool next(int i, Unit& u) const { if (!StaticOrder::next(i >> 1, u)) return false; u.kh = i & 1; return true; }
};
struct FixedOrder : StaticOrder {
    static constexpr bool PAIRS = false;
    __device__ bool next(int i, Unit& u) const { if (i >= 2) return false; u.pm = 0; u.pn = 0; u.e = 0; u.kh = 0; return true; }
};
struct GroupedOrder : StaticOrder {
    static constexpr bool PAIRS = false;
    const int* tile_e;
    __device__ bool next(int i, Unit& u) const { if (!StaticOrder::next(i, u)) return false; u.e = tile_e[u.pm]; return true; }
};
template <class Epi, class Sched, bool ALIGN_EPI = false, bool SP2 = false, bool GATHER = false, bool F8 = false>
__device__ __forceinline__ void gemm_phase(PG8_LAS unsigned char* lds, const Gemm g, const Sched& S, const Epi& E) {
    const int tid = threadIdx.x, wid = __builtin_amdgcn_readfirstlane(tid >> 6), lane = tid & 63, wr = wid >> 2, wc = wid & 3, fr = lane & 15, fq = lane >> 4;
    const int K = g.K, nt = K / BK;
    unsigned voffA[2], voffB[2];
#pragma unroll
    for (int i = 0; i < 2; ++i) { int R, C; stage_rc(tid * 16 + i * 8192, R, C); const int Rb = Epi::PERM ? ((R & ~31) + perm32(R & 31)) : R;
        voffA[i] = (unsigned)(R * K + C) * 2u; voffB[i] = (unsigned)(Rb * K + C) * 2u; }
    static_assert(SP2 || !GATHER, "the gathered-A path is written for the SP2 loop only");
    unsigned gc0[2] = {0u, 0u}, gc1[2] = {0u, 0u}, gn0[2] = {0u, 0u}, gn1[2] = {0u, 0u};
    auto load_gather = [&](const Unit& u, unsigned (&o0)[2], unsigned (&o1)[2]) {
#pragma unroll
        for (int i = 0; i < 2; ++i) { int R, C; stage_rc(tid * 16 + i * 8192, R, C); const int t0 = g.gather[u.pm * BM + R], t1 = g.gather[u.pm * BM + HALF + R];
            o0[i] = (unsigned)(t0 * K + C) * 2u; o1[i] = (unsigned)(t1 * K + C) * 2u; } };
    const size_t kstep = (size_t)(BK * 2);
    const size_t hstep = (size_t)HALF * K * 2;
    const size_t tstep = 2 * hstep;
    const unsigned ldsw = (unsigned)wid * 1024u;
    const int aoff = lds_byte(wr * 64 + fr, F8 ? fq * 16 : fq * 8), boff = lds_byte(wc * 32 + fr, F8 ? fq * 16 : fq * 8);
    const int sc1 = 0x7f7f7f7f;
    constexpr int KFR = F8 ? 16 : 1024;
#define PG8_SA(b, h) (((b) * 2 + (h)) * HTB)
#define PG8_SB(b, h) ((4 + (b) * 2 + (h)) * HTB)
#define PG8_STAGE(bufoff, gbase, voff) do { _Pragma("unroll") for (int _i = 0; _i < 2; ++_i) \
        __builtin_amdgcn_global_load_lds((const unsigned*)((const char*)(gbase) + (voff)[_i]), (PG8_LAS unsigned*)(lds + (bufoff) + ldsw + _i * 8192), 16, 0, 0); } while (0)
#define PG8_STAGE_A(bufoff, gbase, hh, nx) do { if constexpr (GATHER) { _Pragma("unroll") for (int _i = 0; _i < 2; ++_i) { const unsigned _o = (nx) ? ((hh) ? gn1[_i] : gn0[_i]) : ((hh) ? gc1[_i] : gc0[_i]); \
        __builtin_amdgcn_global_load_lds((const unsigned*)((const char*)(gbase) + _o), (PG8_LAS unsigned*)(lds + (bufoff) + ldsw + _i * 8192), 16, 0, 0); } } \
        else { PG8_STAGE(bufoff, (gbase) + ((hh) ? hstep : 0), voffA); } } while (0)
#define PG8_LDA(dst, b, h) do { _Pragma("unroll") for (int m = 0; m < 4; ++m) _Pragma("unroll") for (int k = 0; k < 2; ++k) dst[m][k] = *(const PG8_LAS bf16x8*)(lds + PG8_SA(b, h) + aoff + m * 2048 + k * KFR); } while (0)
#define PG8_LDB(dst, b, h) do { _Pragma("unroll") for (int n = 0; n < 2; ++n) _Pragma("unroll") for (int k = 0; k < 2; ++k) dst[n][k] = *(const PG8_LAS bf16x8*)(lds + PG8_SB(b, h) + boff + n * 2048 + k * KFR); } while (0)
#define PG8_V8(x) __builtin_shufflevector(__builtin_bit_cast(i32x4_t, (x)[0]), __builtin_bit_cast(i32x4_t, (x)[1]), 0, 1, 2, 3, 4, 5, 6, 7)
#define PG8_MMA(ai, bj, At, Bt) do { __builtin_amdgcn_s_setprio(1); if constexpr (F8) { _Pragma("unroll") for (int m = 0; m < 4; ++m) _Pragma("unroll") for (int n = 0; n < 2; ++n) \
        asm volatile("v_mfma_scale_f32_16x16x128_f8f6f4 %0, %1, %2, %0, %3, %3 op_sel_hi:[0,0,0]" : "+v"(acc[ai][bj][m][n]) : "v"(PG8_V8(Bt[n])), "v"(PG8_V8(At[m])), "v"(sc1)); } else { \
        _Pragma("unroll") for (int m = 0; m < 4; ++m) _Pragma("unroll") for (int n = 0; n < 2; ++n) _Pragma("unroll") for (int k = 0; k < 2; ++k) \
        acc[ai][bj][m][n] = __builtin_amdgcn_mfma_f32_16x16x32_bf16(Bt[n][k], At[m][k], acc[ai][bj][m][n], 0, 0, 0); } __builtin_amdgcn_s_setprio(0); } while (0)
#define PG8_WAIT_V(n) asm volatile("s_waitcnt vmcnt(" #n ")" ::: "memory")
#define PG8_WAIT_L(n) asm volatile("s_waitcnt lgkmcnt(" #n ")" ::: "memory")
#define PG8_BAR __builtin_amdgcn_s_barrier()
#define PG8_SCHED __builtin_amdgcn_sched_barrier(0)
    Unit cur, nxt; int ui = 0;
    if (!S.next(0, cur)) return;
    f32x4 acc[2][2][4][2];
#pragma unroll
    for (int a = 0; a < 2; ++a)
#pragma unroll
        for (int b = 0; b < 2; ++b)
#pragma unroll
            for (int m = 0; m < 4; ++m)
#pragma unroll
                for (int n = 0; n < 2; ++n) acc[a][b][m][n] = (f32x4){0.f, 0.f, 0.f, 0.f};
    bf16x8 At[4][2], B0[2][2], B1[2][2];
    const char* cA = (const char*)((Sched::PAIRS && cur.kh) ? g.A2 : g.A) + (GATHER ? (size_t)0 : (size_t)cur.pm * tstep); const char* cB = (const char*)((Sched::PAIRS && cur.kh) ? g.Bt2 : g.Bt) + (size_t)cur.e * g.bgs + (size_t)cur.pn * tstep;
    S.a_ready(cur);
    if constexpr (GATHER) load_gather(cur, gc0, gc1);
    if constexpr (SP2) {
        PG8_STAGE(PG8_SB(0, 0), cB, voffB); PG8_STAGE(PG8_SB(0, 1), cB + hstep, voffB); PG8_STAGE_A(PG8_SA(0, 0), cA, 0, false); PG8_STAGE_A(PG8_SA(0, 1), cA, 1, false);
        if (wr == 1) PG8_BAR;
        PG8_WAIT_V(2); PG8_BAR;
        PG8_STAGE(PG8_SB(1, 0), cB + kstep, voffB); PG8_STAGE_A(PG8_SA(1, 0), cA + kstep, 0, false); PG8_STAGE(PG8_SB(1, 1), cB + hstep + kstep, voffB);
        PG8_WAIT_V(6); PG8_BAR;
    } else {
        PG8_STAGE(PG8_SB(0, 0), cB, voffB); PG8_STAGE(PG8_SA(0, 0), cA, voffA); PG8_STAGE(PG8_SB(0, 1), cB + hstep, voffB); PG8_STAGE(PG8_SA(0, 1), cA + hstep, voffA);
        if (wr == 1) PG8_BAR;
        PG8_WAIT_V(4); PG8_BAR;
        PG8_STAGE(PG8_SB(1, 0), cB + kstep, voffB); PG8_STAGE(PG8_SA(1, 0), cA + kstep, voffA); PG8_STAGE(PG8_SB(1, 1), cB + hstep + kstep, voffB);
        PG8_WAIT_V(6); PG8_BAR;
    }
    for (;;) {
        const bool has_next = S.next(ui + 1, nxt);
        const char* nA = has_next ? (const char*)((Sched::PAIRS && nxt.kh) ? g.A2 : g.A) + (GATHER ? (size_t)0 : (size_t)nxt.pm * tstep) : cA;
        if constexpr (GATHER) { if (has_next) load_gather(nxt, gn0, gn1); else { gn0[0] = gc0[0]; gn0[1] = gc0[1]; gn1[0] = gc1[0]; gn1[1] = gc1[1]; } } const char* nB = has_next ? (const char*)((Sched::PAIRS && nxt.kh) ? g.Bt2 : g.Bt) + (size_t)nxt.e * g.bgs + (size_t)nxt.pn * tstep : cB;
        for (int t = 0; t < nt; t += 2) {
            const bool last = (t == nt - 2);
            const char* a1 = cA + (size_t)(t + 1) * kstep;
            const char* a2 = last ? nA : cA + (size_t)(t + 2) * kstep; const char* b2 = last ? nB : cB + (size_t)(t + 2) * kstep;
            const char* a3 = a2 + kstep; const char* b3 = b2 + kstep;
            if (last && has_next) S.a_ready(nxt);
            if constexpr (SP2) {
            PG8_LDB(B0, 0, 0); PG8_LDB(B1, 0, 1); PG8_SCHED; PG8_LDA(At, 0, 0); PG8_STAGE_A(PG8_SA(1, 1), a1, 1, false);
            PG8_WAIT_V(8); PG8_WAIT_L(0); PG8_BAR; PG8_MMA(0, 0, At, B0); PG8_MMA(0, 1, At, B1); PG8_BAR; PG8_SCHED;
            PG8_LDA(At, 0, 1); PG8_STAGE(PG8_SB(0, 0), b2, voffB); PG8_STAGE(PG8_SB(0, 1), b2 + hstep, voffB); PG8_STAGE_A(PG8_SA(0, 0), a2, 0, last);
            PG8_WAIT_V(8); PG8_WAIT_L(0); PG8_BAR; PG8_MMA(1, 0, At, B0); PG8_MMA(1, 1, At, B1); PG8_BAR; PG8_SCHED;
            PG8_LDB(B0, 1, 0); PG8_LDB(B1, 1, 1); PG8_SCHED; PG8_LDA(At, 1, 0); PG8_STAGE_A(PG8_SA(0, 1), a2, 1, last);
            PG8_WAIT_V(8); PG8_WAIT_L(0); PG8_BAR; PG8_MMA(0, 0, At, B0); PG8_MMA(0, 1, At, B1); PG8_BAR; PG8_SCHED;
            PG8_LDA(At, 1, 1); PG8_STAGE(PG8_SB(1, 0), b3, voffB); PG8_STAGE(PG8_SB(1, 1), b3 + hstep, voffB); PG8_STAGE_A(PG8_SA(1, 0), a3, 0, last);
            PG8_WAIT_V(8); PG8_WAIT_L(0); PG8_BAR; PG8_MMA(1, 0, At, B0); PG8_MMA(1, 1, At, B1); PG8_BAR; PG8_SCHED;
            } else {
            PG8_LDB(B0, 0, 0); PG8_SCHED; PG8_LDA(At, 0, 0); PG8_STAGE(PG8_SA(1, 1), a1 + hstep, voffA);
            PG8_WAIT_L(8); PG8_BAR; PG8_WAIT_L(0); PG8_MMA(0, 0, At, B0); PG8_BAR; PG8_SCHED;
            PG8_LDB(B1, 0, 1); PG8_STAGE(PG8_SB(0, 0), b2, voffB);
            PG8_BAR; PG8_WAIT_L(0); PG8_MMA(0, 1, At, B1); PG8_BAR;
            PG8_LDA(At, 0, 1); PG8_STAGE(PG8_SA(0, 0), a2, voffA);
            PG8_BAR; PG8_WAIT_L(0); PG8_MMA(1, 0, At, B0); PG8_BAR; PG8_SCHED;
            PG8_STAGE(PG8_SB(0, 1), b2 + hstep, voffB);
            PG8_WAIT_V(6); PG8_BAR; PG8_MMA(1, 1, At, B1); PG8_BAR;
            PG8_LDB(B0, 1, 0); PG8_SCHED; PG8_LDA(At, 1, 0); PG8_STAGE(PG8_SA(0, 1), a2 + hstep, voffA);
            PG8_WAIT_L(8); PG8_BAR; PG8_WAIT_L(0); PG8_MMA(0, 0, At, B0); PG8_BAR; PG8_SCHED;
            PG8_LDB(B1, 1, 1); PG8_STAGE(PG8_SB(1, 0), b3, voffB);
            PG8_BAR; PG8_WAIT_L(0); PG8_MMA(0, 1, At, B1); PG8_BAR;
            PG8_LDA(At, 1, 1); PG8_STAGE(PG8_SA(1, 0), a3, voffA);
            PG8_BAR; PG8_WAIT_L(0); PG8_MMA(1, 0, At, B0); PG8_BAR; PG8_SCHED;
            PG8_STAGE(PG8_SB(1, 1), b3 + hstep, voffB);
            PG8_WAIT_V(6); PG8_BAR; PG8_MMA(1, 1, At, B1); PG8_BAR;
            }
        }
        if constexpr (ALIGN_EPI) { if (wr == 0) PG8_BAR; }
        if constexpr (!Epi::AFTER_DRAIN) { if constexpr (Epi::MID) { if (cur.kh == 0) E.mid(acc, cur, wr, wc, fr, fq); else E(acc, cur, wr, wc, fr, fq); } else E(acc, cur, wr, wc, fr, fq); S.done(cur); }
        if (!has_next) break;
        if (!(Epi::MID && cur.kh == 0)) {
#pragma unroll
        for (int a = 0; a < 2; ++a)
#pragma unroll
            for (int b = 0; b < 2; ++b)
#pragma unroll
                for (int m = 0; m < 4; ++m)
#pragma unroll
                    for (int n = 0; n < 2; ++n) acc[a][b][m][n] = (f32x4){0.f, 0.f, 0.f, 0.f}; }
        cur = nxt; cA = nA; cB = nB; ++ui;
        if constexpr (GATHER) { gc0[0] = gn0[0]; gc0[1] = gn0[1]; gc1[0] = gn1[0]; gc1[1] = gn1[1]; }
        if constexpr (ALIGN_EPI) { if (wr == 1) PG8_BAR; }
    }
    PG8_WAIT_V(0);
    if constexpr (!ALIGN_EPI) { if (wr == 0) PG8_BAR; }
    PG8_BAR;
    if constexpr (Epi::AFTER_DRAIN) { E.fused(acc, cur, wr, wc, fr, fq, lds, wid, lane); S.done(cur); }
#undef PG8_SA
#undef PG8_SB
#undef PG8_STAGE
#undef PG8_STAGE_A
#undef PG8_LDA
#undef PG8_LDB
#undef PG8_MMA
#undef PG8_V8
#undef PG8_WAIT_V
#undef PG8_WAIT_L
#undef PG8_BAR
#undef PG8_SCHED
}
}

#ifndef PG8_SP2
#define PG8_SP2 true
#endif
#ifndef PG8_ALIGN
#define PG8_ALIGN true
#endif
constexpr int NWAVES = 8;
#ifndef MK_N_LAUNCHES
#define MK_N_LAUNCHES 1
#endif
constexpr int N_PHASES = 14;
constexpr int N_LAUNCHES = MK_N_LAUNCHES;

constexpr int D = 2048, NB = 8, SEQ = 2048, M = NB * SEQ;
constexpr int RW = 1024, RNH = 16;
constexpr int RWKV_COLS = 3360, HG_BASE = 3584, GATE_BASE = 7680, NPROJ = 11776;
constexpr int IN_COLS = 11552;
constexpr int HNH = 8;
constexpr int NE = 32, DE = 2048, NASSIGN = M * 4;
constexpr int LORA_K = 384, LORA_N = 3072;
constexpr int MAXTILES = 288, MAXSLOTS = MAXTILES * 256;
constexpr float NORM_EPS = 1e-5f, GN_EPS = 64e-5f;

constexpr size_t MiB = 1u << 20;
constexpr size_t WS_CTL = 0, CTL_ZERO_BYTES = 32768;
constexpr size_t WS_MODP = 2 * MiB;
constexpr size_t WS_MOD = 8 * MiB;
constexpr size_t WS_RWP = 9 * MiB;
constexpr size_t WS_ROUTE = 10 * MiB;
constexpr size_t WS_WLORA = 14 * MiB;
constexpr size_t WS_WIN = 18 * MiB;
constexpr size_t WS_WPA = 64 * MiB, WS_WPB = 68 * MiB, WS_WOUT = 72 * MiB;
constexpr size_t WS_WGU = 80 * MiB;
constexpr size_t WS_WDN = 592 * MiB;
constexpr size_t WS_H = 848 * MiB;
constexpr size_t WS_PROJ = 912 * MiB;
constexpr size_t WS_LORA_A = 1280 * MiB;
constexpr size_t WS_LORA_O = 1292 * MiB;
constexpr size_t WS_YA = 1484 * MiB, WS_YB = 1516 * MiB;
constexpr size_t WS_OHG = 1548 * MiB;
constexpr size_t WS_T1 = 1612 * MiB;
constexpr size_t WS_MERGED = 1740 * MiB;
constexpr size_t WS_X1 = 1804 * MiB;
constexpr size_t WS_XG = 1932 * MiB;
constexpr size_t WS_ACT = 2220 * MiB;
constexpr size_t WS_YE = 2508 * MiB;
constexpr size_t WS_END = 2796 * MiB;
constexpr size_t RT_E = 0, RT_RANK = 262144, RT_GATE = 524288, RT_TOKSLOT = 786432, RT_SLOTW = 1048576, RT_TILEE = 1048576 + 524288, RT_SLOTTOK = 2097152;
constexpr int CW_TMO = 0, CW_CODE = 1;
constexpr int CW_CNT = 64;
constexpr int CW_BAR = 4096;
constexpr int LDS_BYTES = 147456;
constexpr int MISC_OFF = LDS_BYTES - 256;
constexpr int SCR_BYTES = MISC_OFF;

#define GAS __attribute__((address_space(1)))
#define LAS __attribute__((address_space(3)))
typedef unsigned short bf16;
typedef unsigned v4u __attribute__((ext_vector_type(4)));
typedef unsigned v2u __attribute__((ext_vector_type(2)));
typedef float f32x4 __attribute__((ext_vector_type(4)));
typedef float f32x2 __attribute__((ext_vector_type(2)));
typedef GAS unsigned gu32;
#define RLX_AGENT __ATOMIC_RELAXED, __HIP_MEMORY_SCOPE_AGENT
#define LDS_WAIT() asm volatile("s_waitcnt lgkmcnt(0)" ::: "memory")
#define VM_WAIT() asm volatile("s_waitcnt vmcnt(0)" ::: "memory")
typedef __bf16 bf16x2_hw __attribute__((ext_vector_type(2)));
__device__ __forceinline__ unsigned pk2(float lo, float hi) { const f32x2 v = {lo, hi}; const bf16x2_hw r = __builtin_convertvector(v, bf16x2_hw); return __builtin_bit_cast(unsigned, r); }
__device__ __forceinline__ unsigned f2bf(float f) { return pk2(f, f) & 0xffffu; }
__device__ __forceinline__ float bf2f(unsigned short h) { return __uint_as_float(((unsigned)h) << 16); }
__device__ __forceinline__ float bflo(unsigned w) { return __uint_as_float(w << 16); }
__device__ __forceinline__ float bfhi(unsigned w) { return __uint_as_float(w & 0xffff0000u); }
__device__ __forceinline__ float sigmoidf_(float x) { return __builtin_amdgcn_rcpf(1.0f + __expf(-x)); }

#define XB_TMO      128
#define XB_XCNT(j)  (256  + 64 * (j))
#define XB_XSUB(j)  (1280 + 64 * (j))
#define XB_XGEN(j)  (2304 + 64 * (j))
#define XB_TOP      3328
#define XB_TOPGEN   3392
#define XCD_BAR_WORDS 3456
#define XB_SPIN_CAP (1u << 18)
__device__ __forceinline__ unsigned xb_ld(unsigned* p)              { return __hip_atomic_load(p, __ATOMIC_RELAXED, __HIP_MEMORY_SCOPE_AGENT); }
__device__ __forceinline__ unsigned xb_add(unsigned* p, unsigned v) { return __hip_atomic_fetch_add(p, v, __ATOMIC_RELAXED, __HIP_MEMORY_SCOPE_AGENT); }
__device__ __forceinline__ unsigned xb_xcc_id() { return (unsigned)__builtin_amdgcn_s_getreg((3 << 11) | 20) & 0xFu; }
#define XB_SPIN(cond, bar) do { unsigned _sp = 0; while (cond) { __builtin_amdgcn_s_sleep(1); \
    if ((++_sp & 255u) == 0u) { if (xb_ld(&(bar)[XB_TMO])) break; if (_sp > XB_SPIN_CAP) { atomicAdd(&(bar)[XB_TMO], 1u); break; } } } } while (0)
struct XcdBarrier { unsigned* bar; unsigned x; volatile LAS unsigned* st; };
__device__ __forceinline__ XcdBarrier xcd_barrier_post(unsigned* bar, volatile LAS unsigned* st) {
    XcdBarrier b; b.bar = bar; b.x = xb_xcc_id(); b.st = st;
    if (threadIdx.x == 0) (void)xb_add(&bar[XB_XCNT(b.x)], 1u);
    return b;
}
__device__ __forceinline__ void xcd_barrier_complete(unsigned* bar, unsigned x, unsigned& nloc, unsigned& nx) {
    const unsigned G = gridDim.x * gridDim.y * gridDim.z;
    unsigned sum, cnt, mine, sp = 0u;
    for (;;) {
        sum = 0u; cnt = 0u; mine = 0u;
#pragma unroll
        for (unsigned j = 0; j < 16; ++j) { const unsigned c = xb_ld(&bar[XB_XCNT(j)]); sum += c; cnt += (c > 0u) ? 1u : 0u; mine = (j == x) ? c : mine; }
        if (sum == G) break;
        __builtin_amdgcn_s_sleep(1);
        if ((++sp & 255u) == 0u) { if (xb_ld(&bar[XB_TMO])) break; if (sp > XB_SPIN_CAP) { atomicAdd(&bar[XB_TMO], 1u); break; } }
    }
    nloc = mine > 0u ? mine : 1u; nx = cnt > 0u ? cnt : 1u;
}
__device__ __forceinline__ void xcd_barrier(const XcdBarrier& b) {
    asm volatile("s_waitcnt vmcnt(0)" ::: "memory");
    __syncthreads();
    if (threadIdx.x == 0) {
        unsigned* bar = b.bar;
        __builtin_amdgcn_s_waitcnt(0);
        unsigned nloc = b.st[0], nx = b.st[1];
        if (nloc == 0u) { xcd_barrier_complete(bar, b.x, nloc, nx); b.st[0] = nloc; b.st[1] = nx; }
        const unsigned old = xb_add(&bar[XB_XSUB(b.x)], 1u);
        const unsigned gen = old / nloc;
        if (old + 1u == (gen + 1u) * nloc) {
            __builtin_amdgcn_fence(__ATOMIC_RELEASE, "agent");
            asm volatile("s_waitcnt vmcnt(0)" ::: "memory");
            const unsigned og = xb_add(&bar[XB_TOP], 1u);
            const unsigned tg = og / nx;
            if (og + 1u == (tg + 1u) * nx) xb_add(&bar[XB_TOPGEN], 1u);
            else XB_SPIN(xb_ld(&bar[XB_TOPGEN]) == tg, bar);
            __builtin_amdgcn_fence(__ATOMIC_ACQUIRE, "agent");
            xb_add(&bar[XB_XGEN(b.x)], 1u);
            asm volatile("s_waitcnt vmcnt(0)" ::: "memory");
        } else {
            XB_SPIN(xb_ld(&bar[XB_XGEN(b.x)]) == gen, bar);
            __builtin_amdgcn_fence(__ATOMIC_ACQUIRE, "agent");
            asm volatile("s_waitcnt vmcnt(0)" ::: "memory");
        }
    }
    __syncthreads();
}

struct Args { const float* in[30]; float* out; unsigned char* ws; int ph_lo, ph_hi, li, pad; };
struct Frame {
    LAS unsigned char* lds;
    volatile LAS unsigned* MISC;
    gu32* ctl;
    unsigned char* ws;
    int tid, lane, wave;
    int vcu, G;
};
__device__ __forceinline__ float wave_sum(float v) {
#pragma unroll
    for (int o = 1; o < 64; o <<= 1) v += __shfl_xor(v, o);
    return v;
}
template <int CTRL> __device__ __forceinline__ float dpp_mov(float v) { return __builtin_bit_cast(float, __builtin_amdgcn_update_dpp(0, __builtin_bit_cast(int, v), CTRL, 0xf, 0xf, false)); }
__device__ __forceinline__ float red8(float v) {
    v += dpp_mov<0xB1>(v);
    v += dpp_mov<0x4E>(v);
    v += dpp_mov<0x141>(v);
    return v;
}

struct TItem { const float* src; bf16* dst; int N, Kd; };
constexpr int P0_I_IN = 32 * (IN_COLS / 32), P0_I_PA = 16 * 64, P0_I_OUT = 32 * 64;
constexpr int P0_NITEMS = P0_I_IN + 2 * P0_I_PA + P0_I_OUT;
__device__ __forceinline__ TItem p0_decode(const Args& args, unsigned char* ws, int it) {
    TItem t; int r = it;
    if (r < P0_I_IN) { const int nblk = IN_COLS / 32, kb = r / nblk, nb = r % nblk, n0 = nb * 32; const int dr = n0 + (n0 >= RWKV_COLS ? (HG_BASE - RWKV_COLS) : 0);
        t.src = args.in[6] + (size_t)(kb * 64) * IN_COLS + n0; t.N = IN_COLS; t.dst = (bf16*)(ws + WS_WIN) + (size_t)dr * D + kb * 64; t.Kd = D; return t; }
    r -= P0_I_IN;
    if (r < P0_I_PA) { const int kb = r / 64, nb = r % 64; t.src = args.in[20] + (size_t)(kb * 64) * D + nb * 32; t.N = D; t.dst = (bf16*)(ws + WS_WPA) + (size_t)(nb * 32) * RW + kb * 64; t.Kd = RW; return t; }
    r -= P0_I_PA;
    if (r < P0_I_PA) { const int kb = r / 64, nb = r % 64; t.src = args.in[21] + (size_t)(kb * 64) * D + nb * 32; t.N = D; t.dst = (bf16*)(ws + WS_WPB) + (size_t)(nb * 32) * RW + kb * 64; t.Kd = RW; return t; }
    r -= P0_I_PA;
    if (r < P0_I_OUT) { const int kb = r / 64, nb = r % 64; t.src = args.in[22] + (size_t)(kb * 64) * D + nb * 32; t.N = D; t.dst = (bf16*)(ws + WS_WOUT) + (size_t)(nb * 32) * D + kb * 64; t.Kd = D; return t; }
    t.src = nullptr; t.dst = nullptr; t.N = 0; t.Kd = 0; return t;
}
__device__ __forceinline__ void p0_issue(const TItem& t, f32x4 (&v)[8], int lane) {
    const GAS f32x4* src = (const GAS f32x4*)((const GAS float*)t.src + (size_t)(lane >> 3) * t.N + 4 * (lane & 7));
#pragma unroll
    for (int i = 0; i < 8; ++i) v[i] = __builtin_nontemporal_load(src + (size_t)(2 * i) * t.N);
}
__device__ __forceinline__ void p0_finish(const TItem& t, const f32x4 (&v)[8], LAS float* scr, int lane) {
#pragma unroll
    for (int i = 0; i < 8; ++i) *(LAS f32x4*)(scr + (8 * i + (lane >> 3)) * 32 + (((lane & 7) ^ i) << 2)) = v[i];
    LDS_WAIT(); asm volatile("" ::: "memory");
    const int c = lane & 7;
#pragma unroll
    for (int j = 0; j < 4; ++j) { const int n = (lane >> 3) + 8 * j; const LAS float* s = scr + (8 * c) * 32 + ((((n >> 2) ^ c) << 2) | (n & 3));
        v4u o; o.x = pk2(s[0 * 32], s[1 * 32]); o.y = pk2(s[2 * 32], s[3 * 32]); o.z = pk2(s[4 * 32], s[5 * 32]); o.w = pk2(s[6 * 32], s[7 * 32]);
        *(GAS v4u*)(t.dst + (size_t)n * t.Kd + 8 * c) = o; }
    LDS_WAIT(); asm volatile("" ::: "memory");
}

__device__ __forceinline__ void p0_convert(Frame& F, const Args& args, int lo, int hi, int gw, int NGW, int nlight) {
    LAS float* scr = (LAS float*)(F.lds + F.wave * 8448);
    unsigned char* ws = F.ws;
    const int nA = NGW > nlight ? NGW - nlight : 0, nit = hi - lo, itemsA = nA * 16 < nit ? nA * 16 : nit;
    auto item_of = [&](int idx) -> int {
        if (gw >= nlight && idx < 16) { const int a = (gw - nlight) + nA * idx; return a < itemsA ? lo + a : hi + 1000000; }
        const int j = (gw >= nlight) ? idx - 16 : idx; return lo + itemsA + gw + NGW * j; };
    int idx = 0;
    while (idx < 16 && item_of(idx) >= hi + 1000000) ++idx;
    if (item_of(idx) < hi) {
        f32x4 va[8], vb[8];
        TItem ca = p0_decode(args, ws, item_of(idx)), cb = ca; p0_issue(ca, va, F.lane);
        for (;;) {
            int nx = item_of(++idx); bool has = nx < hi;
            if (has) { cb = p0_decode(args, ws, nx); p0_issue(cb, vb, F.lane); }
            p0_finish(ca, va, scr, F.lane);
            if (!has) break;
            nx = item_of(++idx); has = nx < hi;
            if (has) { ca = p0_decode(args, ws, nx); p0_issue(ca, va, F.lane); }
            p0_finish(cb, vb, scr, F.lane);
            if (!has) break;
        }
    }
}
#ifndef P0_SPLIT_PCT
#define P0_SPLIT_PCT 44
#endif
#ifndef P0_TAIL_PCT
#define P0_TAIL_PCT 6
#endif
#ifndef P0_HG_PCT
#define P0_HG_PCT 15
#endif
#ifndef P8_E0
#define P8_E0 25
#endif
constexpr int P8_GU1 = 16 * 128, P8_DN1 = 16 * 64, P8_N = P8_E0 * (P8_GU1 + P8_DN1) + (NE - P8_E0) * P8_GU1, P8_Q = (NE - P8_E0) * P8_DN1;
constexpr int P8_SPLIT = (int)((long long)P8_N * (100 - P0_SPLIT_PCT) / 100);
constexpr int P8_SPLITA = P8_SPLIT - (int)((long long)P8_N * P0_TAIL_PCT / 100);
constexpr int P8_SPLITH = P8_SPLITA - (int)((long long)P8_N * P0_HG_PCT / 100);
#ifndef P0_RW_PCT
#define P0_RW_PCT 5
#endif
constexpr int P8_SPLITR = P8_SPLITH - (int)((long long)P8_N * P0_RW_PCT / 100);
#ifndef P0_DED_PCT
#define P0_DED_PCT 30
#endif
constexpr int P8_SPLITD = (P8_SPLITR - (int)((long long)P8_N * P0_DED_PCT / 100)) > 0 ? (P8_SPLITR - (int)((long long)P8_N * P0_DED_PCT / 100)) : 0;
#ifndef P2_GEMM_WGS
#define P2_GEMM_WGS 232
#endif
constexpr int P2_ROUNDS = ((M / 256) * (NPROJ / 256) + P2_GEMM_WGS - 1) / P2_GEMM_WGS, P2_NFULL = (M / 256) * (NPROJ / 256) - (P2_ROUNDS - 1) * P2_GEMM_WGS;
#ifndef P11_TAIL_ITEMS
#define P11_TAIL_ITEMS 48
#endif
constexpr float W8_SCALE = 64.0f, H8_SCALE = 8.0f, A8_SCALE = 4.0f, Y8_SCALE = 64.0f;
struct TItem8 { const float* src; unsigned char* dst; int N, Kd; };
__device__ __forceinline__ TItem8 p8_decode(const Args& args, unsigned char* ws, int it) {
    TItem8 t;
    if (it >= P8_N) { const int j = it - P8_N; it = (P8_E0 + j / P8_DN1) * (P8_GU1 + P8_DN1) + P8_GU1 + j % P8_DN1; }
    else if (it >= P8_E0 * (P8_GU1 + P8_DN1)) { const int r = it - P8_E0 * (P8_GU1 + P8_DN1); it = (P8_E0 + r / P8_GU1) * (P8_GU1 + P8_DN1) + r % P8_GU1; }
    const int e = it / (P8_GU1 + P8_DN1), q = it % (P8_GU1 + P8_DN1);
    if (q < P8_GU1) { const int kb = q / 128, nb = q % 128, n0 = nb * 32;
        const int dr = (n0 < DE) ? (256 * (n0 / 128) + (n0 % 128)) : (256 * ((n0 - DE) / 128) + 128 + ((n0 - DE) % 128));
        t.src = args.in[25] + (size_t)e * D * 2 * DE + (size_t)(kb * 128) * (2 * DE) + n0; t.N = 2 * DE; t.dst = ws + WS_WGU + (size_t)e * 2 * DE * D + (size_t)dr * D + kb * 128; t.Kd = D; }
    else { const int q2 = q - P8_GU1, kb = q2 / 64, nb = q2 % 64;
        t.src = args.in[27] + (size_t)e * DE * D + (size_t)(kb * 128) * D + nb * 32; t.N = D; t.dst = ws + WS_WDN + (size_t)e * D * DE + (size_t)(nb * 32) * DE + kb * 128; t.Kd = DE; }
    return t;
}
__device__ __forceinline__ void p8_issue(const TItem8& t, f32x4 (&v)[16], int lane) {
    const GAS f32x4* src = (const GAS f32x4*)((const GAS float*)t.src + (size_t)(lane >> 3) * t.N + 4 * (lane & 7));
#pragma unroll
    for (int i = 0; i < 16; ++i) v[i] = __builtin_nontemporal_load(src + (size_t)(2 * i) * t.N);
}
__device__ __forceinline__ void p8_finish(const TItem8& t, const f32x4 (&v)[16], LAS float* scr, int lane) {
#pragma unroll
    for (int i = 0; i < 16; ++i) *(LAS f32x4*)(scr + (8 * i + (lane >> 3)) * 32 + (((lane & 7) ^ (i & 7)) << 2)) = v[i] * W8_SCALE;
    LDS_WAIT(); asm volatile("" ::: "memory");
    const int c = lane & 7;
#pragma unroll
    for (int j = 0; j < 4; ++j) { const int n = (lane >> 3) + 8 * j; float x[16];
#pragma unroll
        for (int i = 0; i < 16; ++i) { const int k = 16 * c + i; x[i] = scr[k * 32 + ((((n >> 2) ^ ((k >> 3) & 7)) << 2) | (n & 3))]; }
        int w[4];
#pragma unroll
        for (int g = 0; g < 4; ++g) { int q = 0; q = __builtin_amdgcn_cvt_pk_fp8_f32(fminf(fmaxf(x[4 * g], -448.f), 448.f), fminf(fmaxf(x[4 * g + 1], -448.f), 448.f), q, false);
            q = __builtin_amdgcn_cvt_pk_fp8_f32(fminf(fmaxf(x[4 * g + 2], -448.f), 448.f), fminf(fmaxf(x[4 * g + 3], -448.f), 448.f), q, true); w[g] = q; }
        v4u o; o.x = (unsigned)w[0]; o.y = (unsigned)w[1]; o.z = (unsigned)w[2]; o.w = (unsigned)w[3];
        __builtin_nontemporal_store(o, (GAS v4u*)(t.dst + (size_t)n * t.Kd + 16 * c)); }
    LDS_WAIT(); asm volatile("" ::: "memory");
}
__device__ __forceinline__ void p8_convert(Frame& F, const Args& args, int lo, int hi, int gw, int NGW, int nlight) {
    LAS float* scr = (LAS float*)(F.lds + F.wave * 16384);
    unsigned char* ws = F.ws;
    const int nA = NGW > nlight ? NGW - nlight : 0, nit = hi - lo, itemsA = (nlight > 0) ? (nA * 8 < nit ? nA * 8 : nit) : 0;
    auto item_of = [&](int idx) -> int {
        if (nlight > 0) { if (gw >= nlight && idx < 8) { const int a = (gw - nlight) + nA * idx; return a < itemsA ? lo + a : hi + 1000000; }
            const int j = (gw >= nlight) ? idx - 8 : idx; return lo + itemsA + gw + NGW * j; }
        return lo + gw + NGW * idx; };
    int idx = 0;
    while (nlight > 0 && idx < 8 && item_of(idx) >= hi + 1000000) ++idx;
    if (item_of(idx) < hi) {
        f32x4 va[16], vb[16];
        TItem8 ca = p8_decode(args, ws, item_of(idx)), cb = ca; p8_issue(ca, va, F.lane);
        for (;;) {
            int nx = item_of(++idx); bool has = nx < hi;
            if (has) { cb = p8_decode(args, ws, nx); p8_issue(cb, vb, F.lane); }
            p8_finish(ca, va, scr, F.lane);
            if (!has) break;
            nx = item_of(++idx); has = nx < hi;
            if (has) { ca = p8_decode(args, ws, nx); p8_issue(ca, va, F.lane); }
            p8_finish(cb, vb, scr, F.lane);
            if (!has) break;
        }
    }
}
__device__ __forceinline__ void p0_prologue(Frame& F, const Args& args) {
    const int gw = F.vcu * NWAVES + F.wave, NGW = F.G * NWAVES, gt = F.vcu * 512 + F.tid, NGT = F.G * 512;
    unsigned char* ws = F.ws;
    LAS float* sc = (LAS float*)(F.lds + 67584);
    for (int i = F.tid; i < NB * D; i += 512) { const int b = i / D, k = i % D; const float cv = args.in[1][i]; sc[k * 8 + b] = cv * sigmoidf_(cv); }
    __syncthreads();
    {
        float* modp = (float*)(ws + WS_MODP);
        for (int it = gw; it < 16 * 48; it += NGW) {
            const int kc = it / 48, jc = it % 48, j0 = jc * 256 + 4 * F.lane;
            f32x4 acc[8];
#pragma unroll
            for (int b = 0; b < 8; ++b) acc[b] = (f32x4){0.f, 0.f, 0.f, 0.f};
            const GAS f32x4* wp = (const GAS f32x4*)(args.in[2] + (size_t)(kc * 128) * 12288 + j0);
            const LAS f32x4* sp = (const LAS f32x4*)(sc + kc * 128 * 8);
#pragma unroll 8
            for (int kk = 0; kk < 128; ++kk) {
                const f32x4 w = wp[(size_t)kk * 3072]; const f32x4 s0 = sp[2 * kk], s1 = sp[2 * kk + 1];
                acc[0] += s0[0] * w; acc[1] += s0[1] * w; acc[2] += s0[2] * w; acc[3] += s0[3] * w;
                acc[4] += s1[0] * w; acc[5] += s1[1] * w; acc[6] += s1[2] * w; acc[7] += s1[3] * w;
            }
#pragma unroll
            for (int b = 0; b < 8; ++b) *(GAS f32x4*)(modp + (size_t)(kc * 8 + b) * 12288 + j0) = acc[b];
        }
    }
    {
        bf16* rwh = (bf16*)(ws + WS_RWP); bf16* rwl = rwh + NE * D;
        for (int o = gt; o < D * NE; o += NGT) { const int k = o & (D - 1), e = o >> 11; const float w = args.in[23][k * NE + e]; const unsigned hi = f2bf(w); rwh[o] = (bf16)hi; rwl[o] = (bf16)f2bf(w - bf2f((unsigned short)hi)); }
    }
    {
        bf16* wl = (bf16*)(ws + WS_WLORA);
        for (int o = gt; o < LORA_N * LORA_K; o += NGT) {
            const int n = o / LORA_K, k = o % LORA_K; float v = 0.f;
            if (n < 1024) { if (k < 64) v = args.in[9][k * 1024 + n]; }
            else if (n < 2048) { if (k >= 64 && k < 128) v = args.in[11][(k - 64) * 1024 + (n - 1024)]; }
            else { if (k >= 128 && k < 288) v = args.in[12][(k - 128) * 1024 + (n - 2048)]; }
            wl[o] = (bf16)f2bf(v);
        }
    }
    {
        GAS v4u* z = (GAS v4u*)(ws + WS_WIN + (size_t)RWKV_COLS * D * 2);
        for (int o = gt; o < (HG_BASE - RWKV_COLS) * D * 2 / 16; o += NGT) z[o] = (v4u){0u, 0u, 0u, 0u};
    }
    p0_convert(F, args, 0, P0_NITEMS, gw, NGW, 0);
    __syncthreads();
    if (P8_SPLITD > 0) p8_convert(F, args, 0, P8_SPLITD, gw, NGW, 768);
}

__device__ __forceinline__ void p1_norm1(Frame& F, const Args& args) {
    const float* modp = (const float*)(F.ws + WS_MODP); float* mod = (float*)(F.ws + WS_MOD); bf16* H = (bf16*)(F.ws + WS_H);
    LAS float* ml = (LAS float*)F.lds;
    for (int rg = F.vcu; rg < M / 64; rg += F.G) {
        const int b = rg / (SEQ / 64);
        __syncthreads();
        for (int j = F.tid; j < 2 * D; j += 512) { float s = args.in[3][j];
#pragma unroll
            for (int kc = 0; kc < 16; ++kc) s += modp[(size_t)(kc * 8 + b) * 12288 + j];
            ml[j] = s; }
        for (int idx = rg * 384 + F.tid; idx < (rg + 1) * 384 && F.tid < 384; idx += 512) { const int bb = idx / 12288, j = idx % 12288; float s = args.in[3][j];
#pragma unroll
            for (int kc = 0; kc < 16; ++kc) s += modp[(size_t)(kc * 8 + bb) * 12288 + j];
            mod[idx] = s; }
        __syncthreads();
        f32x4 g1q[8];
#pragma unroll
        for (int j = 0; j < 8; ++j) g1q[j] = *(const GAS f32x4*)(args.in[4] + 256 * j + 4 * F.lane);
        f32x4 vn[8];
        { const GAS f32x4* xr0 = (const GAS f32x4*)(args.in[0] + (size_t)(rg * 64 + F.wave * 8) * D) + F.lane;
#pragma unroll
          for (int j = 0; j < 8; ++j) vn[j] = xr0[64 * j]; }
        for (int i = 0; i < 8; ++i) {
            const int m = rg * 64 + F.wave * 8 + i;
            f32x4 v[8]; float ss = 0.f;
#pragma unroll
            for (int j = 0; j < 8; ++j) { v[j] = vn[j]; ss += (v[j].x * v[j].x + v[j].y * v[j].y) + (v[j].z * v[j].z + v[j].w * v[j].w); }
            if (i < 7) { const GAS f32x4* xr1 = (const GAS f32x4*)(args.in[0] + (size_t)(m + 1) * D) + F.lane;
#pragma unroll
                for (int j = 0; j < 8; ++j) vn[j] = xr1[64 * j]; }
            const float rstd = 1.0f / sqrtf(wave_sum(ss) * (1.0f / D) + NORM_EPS);
            GAS v2u* o8 = (GAS v2u*)(H + (size_t)m * D) + F.lane;
#pragma unroll
            for (int j = 0; j < 8; ++j) { const int c = 256 * j + 4 * F.lane;
                const f32x4 g = g1q[j], sh = *(const LAS f32x4*)(ml + c), scl = *(const LAS f32x4*)(ml + D + c);
                const f32x4 hv = v[j] * rstd * g * (scl + 1.0f) + sh;
                v2u w; w.x = pk2(hv.x, hv.y); w.y = pk2(hv.z, hv.w); o8[64 * j] = w; }
        }
    }
}

__device__ __forceinline__ void p3_lora_a(Frame& F, const Args& args) {
    const bf16* P = (const bf16*)(F.ws + WS_PROJ); bf16* A = (bf16*)(F.ws + WS_LORA_A);
    const int gw = F.vcu * NWAVES + F.wave, NGW = F.G * NWAVES;
    float muv[5];
#pragma unroll
    for (int jj = 0; jj < 5; ++jj) { const int c = F.lane + 64 * jj; muv[jj] = (c < 288) ? args.in[7][3072 + c] : 0.f; }
    for (int rg = gw; rg < M / 8; rg += NGW) {
        const int m0 = rg * 8; unsigned short raw[9][5];
#pragma unroll
        for (int r = 0; r < 9; ++r)
#pragma unroll
            for (int jj = 0; jj < 5; ++jj) { const int c = F.lane + 64 * jj; const bool first = (r == 0) && (m0 % SEQ) == 0; const int m = first ? m0 : m0 + r - 1;
                const unsigned short q = ((const GAS bf16*)P)[(size_t)m * NPROJ + 3072 + (c < 288 ? c : 287)]; raw[r][jj] = (c < 288 && !first) ? q : (unsigned short)0; }
#pragma unroll
        for (int r = 1; r < 9; ++r) { const int m = m0 + r - 1;
#pragma unroll
            for (int jj = 0; jj < 6; ++jj) { const int c = F.lane + 64 * jj; float o = 0.f;
                if (jj < 5 && c < 288) { const float p = bf2f(raw[r][jj < 5 ? jj : 0]), pp = bf2f(raw[r - 1][jj < 5 ? jj : 0]); const float s = p + (pp - p) * muv[jj < 5 ? jj : 0];
                    o = (c < 64) ? (2.0f * sigmoidf_(2.0f * s) - 1.0f) : ((c < 128) ? s : sigmoidf_(s)); }
                A[(size_t)m * LORA_K + c] = (bf16)f2bf(o); } }
    }
}

__device__ __forceinline__ float wave_sum_u(float v) {
    v += dpp_mov<0xB1>(v); v += dpp_mov<0x4E>(v); v += dpp_mov<0x141>(v); v += dpp_mov<0x140>(v);
    v += __builtin_bit_cast(float, __builtin_amdgcn_update_dpp(0, __builtin_bit_cast(int, v), 0x142, 0xa, 0xf, false));
    v += __builtin_bit_cast(float, __builtin_amdgcn_update_dpp(0, __builtin_bit_cast(int, v), 0x143, 0xc, 0xf, false));
    return __builtin_bit_cast(float, __builtin_amdgcn_readlane(__builtin_bit_cast(int, v), 63));
}
#define LO2(v) __builtin_shufflevector(v, v, 0, 1)
#define HI2(v) __builtin_shufflevector(v, v, 2, 3)
__device__ __forceinline__ float fma_s(float a, float b, float c) { float d; asm("v_fma_f32 %0, %1, %2, %3" : "=v"(d) : "v"(a), "v"(b), "v"(c)); return d; }
__device__ __forceinline__ float mul_s(float a, float b) { float d; asm("v_mul_f32 %0, %1, %2" : "=v"(d) : "v"(a), "v"(b)); return d; }
__device__ __forceinline__ float sub_s(float a, float b) { float d; asm("v_sub_f32 %0, %1, %2" : "=v"(d) : "v"(a), "v"(b)); return d; }
__device__ __forceinline__ float add_s(float a, float b) { float d; asm("v_add_f32 %0, %1, %2" : "=v"(d) : "v"(a), "v"(b)); return d; }
struct RStep { f32x4 kk0, kk1, w0, w1, nb0, nb1, k0, k1, r0, r1; float v; };
__device__ __forceinline__ void rwkv_scan(Frame& F, const Args& args, int bh) {
    constexpr int TT = 32, ARR = TT * 64, BUF = 8 * ARR + 64;
    const int b = bh >> 4, h = bh & 15, lane = F.lane, wave = F.wave;
    const bf16* P = (const bf16*)(F.ws + WS_PROJ); const bf16* LO = (const bf16*)(F.ws + WS_LORA_O); bf16* YA = (bf16*)(F.ws + WS_YA);
    LAS float* L = (LAS float*)F.lds;
    const int c = h * 64 + lane;
    const float mu_r = args.in[7][c], mu_k = args.in[7][1024 + c], mu_v = args.in[7][2048 + c], w0 = args.in[8][c], a0 = args.in[10][c], kkc = args.in[13][c], kac = args.in[14][c], rkc = args.in[15][c], gng = args.in[16][c], gnb = args.in[17][c];
    unsigned short rr[4], rk[4], rv[4], pr[4], pk[4], pv[4], rwl[4], ral[4], rg[4];
    auto load_raw = [&](int t0) {
#pragma unroll
        for (int i = 0; i < 4; ++i) { const int t = t0 + wave + 8 * i; const size_t m = (size_t)b * SEQ + t; const GAS bf16* pm = (const GAS bf16*)P + m * NPROJ + c;
            rr[i] = pm[0]; rk[i] = pm[1024]; rv[i] = pm[2048];
            if (t > 0) { pr[i] = pm[-NPROJ]; pk[i] = pm[1024 - NPROJ]; pv[i] = pm[2048 - NPROJ]; } else { pr[i] = 0; pk[i] = 0; pv[i] = 0; }
            const GAS bf16* lm = (const GAS bf16*)LO + m * LORA_N + c; rwl[i] = lm[0]; ral[i] = lm[1024]; rg[i] = lm[2048]; }
    };
    auto derive = [&](LAS float* B) {
#pragma unroll
        for (int i = 0; i < 4; ++i) { const int tl = wave + 8 * i;
            const float r0 = bf2f(rr[i]), k0 = bf2f(rk[i]), v0 = bf2f(rv[i]);
            const float r = r0 + (bf2f(pr[i]) - r0) * mu_r, k = k0 + (bf2f(pk[i]) - k0) * mu_k, v = v0 + (bf2f(pv[i]) - v0) * mu_v;
            const float decay = __expf(-0.6065306597126334f * sigmoidf_(w0 + bf2f(rwl[i])));
            const float a = sigmoidf_(a0 + bf2f(ral[i]));
            const float kkv = k * kkc; const float n2 = wave_sum_u(kkv * kkv); const float kk = kkv / fmaxf(sqrtf(n2), 1e-12f);
            const float k2 = k * (1.0f + (a - 1.0f) * kac);
            const float bon = wave_sum_u(r * k2 * rkc);
            B[0 * ARR + tl * 64 + lane] = kk; B[1 * ARR + tl * 64 + lane] = decay; B[2 * ARR + tl * 64 + lane] = -kk * a; B[3 * ARR + tl * 64 + lane] = k2;
            B[4 * ARR + tl * 64 + lane] = r; B[5 * ARR + tl * 64 + lane] = v; B[6 * ARR + tl * 64 + lane] = bf2f(rg[i]);
            if (lane == 0) B[8 * ARR + tl] = bon; }
    };
    const int rv8 = lane >> 3, kg = lane & 7, row = 8 * wave + rv8;
    float S[8];
#pragma unroll
    for (int i = 0; i < 8; ++i) S[i] = 0.f;
    auto ldstep = [&](const LAS float* B, int tl) -> RStep {
        const LAS f32x4* q = (const LAS f32x4*)(B + tl * 64 + 8 * kg); RStep s;
        s.kk0 = q[0]; s.kk1 = q[1]; s.w0 = q[ARR / 4]; s.w1 = q[ARR / 4 + 1]; s.nb0 = q[2 * ARR / 4]; s.nb1 = q[2 * ARR / 4 + 1];
        s.k0 = q[3 * ARR / 4]; s.k1 = q[3 * ARR / 4 + 1]; s.r0 = q[4 * ARR / 4]; s.r1 = q[4 * ARR / 4 + 1]; s.v = B[5 * ARR + tl * 64 + row]; return s;
    };
    float yacc = 0.f;
    auto step = [&](LAS float* B, const RStep& s, int tl) {
        float p0 = mul_s(S[0], s.kk0[0]), p1 = mul_s(S[1], s.kk0[1]);
        p0 = fma_s(S[2], s.kk0[2], p0); p1 = fma_s(S[3], s.kk0[3], p1); p0 = fma_s(S[4], s.kk1[0], p0); p1 = fma_s(S[5], s.kk1[1], p1); p0 = fma_s(S[6], s.kk1[2], p0); p1 = fma_s(S[7], s.kk1[3], p1);
        const float sa = red8(add_s(p0, p1));
#pragma unroll
        for (int i = 0; i < 4; ++i) { S[i] = fma_s(S[i], s.w0[i], fma_s(sa, s.nb0[i], mul_s(s.v, s.k0[i]))); S[4 + i] = fma_s(S[4 + i], s.w1[i], fma_s(sa, s.nb1[i], mul_s(s.v, s.k1[i]))); }
        float y0 = mul_s(S[0], s.r0[0]), y1 = mul_s(S[1], s.r0[1]);
        y0 = fma_s(S[2], s.r0[2], y0); y1 = fma_s(S[3], s.r0[3], y1); y0 = fma_s(S[4], s.r1[0], y0); y1 = fma_s(S[5], s.r1[1], y1); y0 = fma_s(S[6], s.r1[2], y0); y1 = fma_s(S[7], s.r1[3], y1);
        const float y = red8(add_s(y0, y1));
        yacc = ((tl & 7) == kg) ? y : yacc;
        if ((tl & 7) == 7) B[7 * ARR + ((tl & ~7) + kg) * 64 + row] = yacc;
    };
    __syncthreads();
    load_raw(0); derive(L);
    __syncthreads();
    for (int tile = 0; tile < SEQ / TT; ++tile) {
        LAS float* B = L + (tile & 1) * BUF; LAS float* Bn = L + ((tile + 1) & 1) * BUF;
        const bool more = (tile + 1) < SEQ / TT;
        if (more) load_raw((tile + 1) * TT);
        {
            RStep sa_ = ldstep(B, 0), sb_;
#pragma unroll
            for (int tl = 0; tl < TT; tl += 2) {
                sb_ = ldstep(B, tl + 1); __builtin_amdgcn_sched_barrier(0); step(B, sa_, tl); __builtin_amdgcn_sched_barrier(0);
                if (tl + 2 < TT) sa_ = ldstep(B, tl + 2);
                __builtin_amdgcn_sched_barrier(0); step(B, sb_, tl + 1); __builtin_amdgcn_sched_barrier(0);
            }
        }
        __syncthreads();
#pragma unroll
        for (int i = 0; i < 4; ++i) { const int tl = wave + 8 * i; const size_t m = (size_t)b * SEQ + tile * TT + tl;
            const float y = B[7 * ARR + tl * 64 + lane]; const float mean = wave_sum_u(y) * (1.0f / 64.0f); const float d = y - mean; const float var = wave_sum_u(d * d) * (1.0f / 64.0f);
            const float yn = d * (1.0f / sqrtf(var + GN_EPS)) * gng + gnb;
            const float o = (yn + B[8 * ARR + tl] * B[5 * ARR + tl * 64 + lane]) * B[6 * ARR + tl * 64 + lane];
            YA[m * RW + c] = (bf16)f2bf(o); }
        if (more) derive(Bn);
        __syncthreads();
    }
}

struct HStep { f32x4 f[4], q[4]; float v; };
__device__ __forceinline__ void hgrn_scan(Frame& F, const Args& args, int u) {
    constexpr int TT = 32, KP = 160, BUF = TT * (KP + KP + 64 + 64);
    const int half = u & 1, bh = u >> 1, b = bh >> 3, h = bh & 7, lane = F.lane, wave = F.wave, tid = F.tid;
    const bf16* P = (const bf16*)(F.ws + WS_PROJ); float* OH = (float*)(F.ws + WS_OHG);
    LAS float* L = (LAS float*)F.lds;
    const int j = tid & 127, ts = tid >> 7, jp = (j >> 4) * 20 + (j & 15);
    const float lb = 1.0f / (1.0f + __expf(args.in[18][1024 + h * 128 + j] - args.in[18][h * 128 + j]));
    unsigned short rq[8], rf[8], rvv[8];
    auto load_raw = [&](int t0) {
#pragma unroll
        for (int i = 0; i < 8; ++i) { const size_t m = (size_t)b * SEQ + t0 + ts + 4 * i; const GAS bf16* pm = (const GAS bf16*)P + m * NPROJ + HG_BASE + h * 128 + j;
            rq[i] = pm[0]; rf[i] = pm[1024]; rvv[i] = (j < 64) ? pm[2048 + half * 64] : (unsigned short)0; }
    };
    auto derive = [&](LAS float* B) {
#pragma unroll
        for (int i = 0; i < 8; ++i) { const int tl = ts + 4 * i; const float q = bf2f(rq[i]); const float f = lb + (1.0f - lb) * sigmoidf_(bf2f(rf[i]));
            B[tl * KP + jp] = f; B[TT * KP + tl * KP + jp] = q * sigmoidf_(q); if (j < 64) B[TT * 2 * KP + tl * 64 + j] = bf2f(rvv[i]); }
    };
    const int cv = lane >> 3, kg = lane & 7, col = 8 * wave + cv;
    float S[16];
#pragma unroll
    for (int i = 0; i < 16; ++i) S[i] = 0.f;
    auto ldstep = [&](const LAS float* B, int tl) -> HStep {
        const LAS f32x4* fp = (const LAS f32x4*)(B + tl * KP + 20 * kg); const LAS f32x4* qp = (const LAS f32x4*)(B + TT * KP + tl * KP + 20 * kg); HStep s; s.v = B[TT * 2 * KP + tl * 64 + col];
#pragma unroll
        for (int g4 = 0; g4 < 4; ++g4) { s.f[g4] = fp[g4]; s.q[g4] = qp[g4]; }
        return s;
    };
    float oacc = 0.f;
    auto step = [&](LAS float* B, const HStep& s, int tl) {
        float o0 = 0.f, o1 = 0.f;
#pragma unroll
        for (int g4 = 0; g4 < 4; ++g4) {
#pragma unroll
            for (int i = 0; i < 4; ++i) { S[4 * g4 + i] = fma_s(s.f[g4][i], sub_s(S[4 * g4 + i], s.v), s.v); }
            if (g4 == 0) { o0 = mul_s(s.q[0][0], S[0]); o1 = mul_s(s.q[0][1], S[1]); } else { o0 = fma_s(s.q[g4][0], S[4 * g4], o0); o1 = fma_s(s.q[g4][1], S[4 * g4 + 1], o1); }
            o0 = fma_s(s.q[g4][2], S[4 * g4 + 2], o0); o1 = fma_s(s.q[g4][3], S[4 * g4 + 3], o1); }
        const float o = red8(add_s(o0, o1));
        oacc = ((tl & 7) == kg) ? o : oacc;
        if ((tl & 7) == 7) B[TT * (2 * KP + 64) + ((tl & ~7) + kg) * 64 + col] = oacc;
    };
    __syncthreads();
    load_raw(0); derive(L);
    __syncthreads();
    for (int tile = 0; tile < SEQ / TT; ++tile) {
        LAS float* B = L + (tile & 1) * BUF; LAS float* Bn = L + ((tile + 1) & 1) * BUF;
        const bool more = (tile + 1) < SEQ / TT;
        if (more) load_raw((tile + 1) * TT);
        {
            HStep sa_ = ldstep(B, 0), sb_;
#pragma unroll
            for (int tl = 0; tl < TT; tl += 2) {
                sb_ = ldstep(B, tl + 1); __builtin_amdgcn_sched_barrier(0); step(B, sa_, tl); __builtin_amdgcn_sched_barrier(0);
                if (tl + 2 < TT) sa_ = ldstep(B, tl + 2);
                __builtin_amdgcn_sched_barrier(0); step(B, sb_, tl + 1); __builtin_amdgcn_sched_barrier(0);
            }
        }
        __syncthreads();
        {
            const int jj = tid & 63, t8 = tid >> 6;
#pragma unroll
            for (int i = 0; i < 4; ++i) { const int tl = t8 + 8 * i; const size_t m = (size_t)b * SEQ + tile * TT + tl; OH[m * 1024 + h * 128 + half * 64 + jj] = B[TT * (2 * KP + 64) + tl * 64 + jj]; }
        }
        if (more) derive(Bn);
        __syncthreads();
    }
}


typedef short bf16x8_t __attribute__((ext_vector_type(8)));
template <int KS> __device__ __forceinline__ f32x4 mm16(const LAS bf16* A, int lda, const LAS bf16* Bt, int ldb, f32x4 acc, int lane) {
    const LAS bf16* ap = A + (lane & 15) * lda + 8 * (lane >> 4); const LAS bf16* bp = Bt + (lane & 15) * ldb + 8 * (lane >> 4);
#pragma unroll
    for (int ks = 0; ks < KS; ++ks) { const bf16x8_t a = *(const LAS bf16x8_t*)(ap + 32 * ks), b = *(const LAS bf16x8_t*)(bp + 32 * ks); acc = __builtin_amdgcn_mfma_f32_16x16x32_bf16(a, b, acc, 0, 0, 0); }
    return acc;
}
__device__ __forceinline__ v2u pack4(f32x4 v) { v2u w; w.x = pk2(v[0], v[1]); w.y = pk2(v[2], v[3]); return w; }
__device__ __forceinline__ float row16_sum(float v) {
    v += dpp_mov<0xB1>(v); v += dpp_mov<0x4E>(v); v += dpp_mov<0x141>(v); v += dpp_mov<0x140>(v); return v;
}

__device__ __forceinline__ void hgrn_chunk_scan(Frame& F, const Args& args, int bh) {
    constexpr int CL = 32, PQ = 136, PS = 40, PO = 132;
    const int b = bh >> 3, h = bh & 7, lane_ = F.lane, wave = F.wave, tid_ = F.tid;
    const bf16* P = (const bf16*)(F.ws + WS_PROJ); bf16* YB = (bf16*)(F.ws + WS_YB);
    LAS bf16* QD = (LAS bf16*)F.lds;
    LAS bf16* KD = QD + 32 * PQ;
    LAS bf16* VT = KD + 32 * PQ;
    LAS bf16* KET = VT + 128 * PS;
    LAS bf16* ST = KET + 128 * PS;
    LAS bf16* AT = ST + 128 * PQ;
    LAS float* OB = (LAS float*)(AT + 32 * PS);
    LAS float* DEND = OB + 32 * PO;
    LAS float* TOT = DEND + 128;
    const float lb = 1.0f / (1.0f + __expf(args.in[18][1024 + h * 128 + (tid_ & 127)] - args.in[18][h * 128 + (tid_ & 127)]));
    unsigned short rq[8], rf[8], rvv[8];
    auto load_raw = [&](int t0) {
#pragma unroll
        for (int i = 0; i < 8; ++i) { const size_t m = (size_t)b * SEQ + t0 + 8 * (tid_ >> 7) + i; const GAS bf16* pm = (const GAS bf16*)P + m * NPROJ + HG_BASE + h * 128 + (tid_ & 127);
            rq[i] = pm[0]; rf[i] = pm[1024]; rvv[i] = pm[2048]; }
    };
    f32x4 Sacc[8];
#pragma unroll
    for (int vt = 0; vt < 8; ++vt) Sacc[vt] = (f32x4){0.f, 0.f, 0.f, 0.f};
    for (int i = tid_; i < 128 * PQ / 2; i += 512) ((LAS unsigned*)ST)[i] = 0u;
    const float gng0 = args.in[19][8 * (tid_ & 15)], gng1 = args.in[19][8 * (tid_ & 15) + 1], gng2 = args.in[19][8 * (tid_ & 15) + 2], gng3 = args.in[19][8 * (tid_ & 15) + 3],
                gng4 = args.in[19][8 * (tid_ & 15) + 4], gng5 = args.in[19][8 * (tid_ & 15) + 5], gng6 = args.in[19][8 * (tid_ & 15) + 6], gng7 = args.in[19][8 * (tid_ & 15) + 7];
    load_raw(0);
    const GAS bf16* ogp = (const GAS bf16*)P + ((size_t)b * SEQ + (tid_ >> 4)) * NPROJ + HG_BASE + 3072 + h * 128 + 8 * (tid_ & 15);
    v4u ogc = *(const GAS v4u*)ogp, ogn = ogc;
    __syncthreads();
    for (int ch = 0; ch < SEQ / CL; ++ch) {
        int lane = lane_, tid = tid_; asm volatile("" : "+v"(lane), "+v"(tid));
        const int j = tid & 127, tq = tid >> 7, q4 = lane >> 4, r16 = lane & 15;
        float fv[8], cs[8]; float run = 0.f;
#pragma unroll
        for (int i = 0; i < 8; ++i) { fv[i] = lb + (1.0f - lb) * sigmoidf_(bf2f(rf[i])); run += __logf(fv[i]); cs[i] = run; }
        TOT[tq * 128 + j] = run;
        {
            v4u w; w.x = (unsigned)rvv[0] | ((unsigned)rvv[1] << 16); w.y = (unsigned)rvv[2] | ((unsigned)rvv[3] << 16); w.z = (unsigned)rvv[4] | ((unsigned)rvv[5] << 16); w.w = (unsigned)rvv[6] | ((unsigned)rvv[7] << 16);
            *(LAS v4u*)(VT + j * PS + 8 * tq) = w; }
        __syncthreads();
        {
            const float t0 = TOT[j], t1 = TOT[128 + j], t2 = TOT[256 + j], t3 = TOT[384 + j];
            const float off = (tq > 0 ? t0 : 0.f) + (tq > 1 ? t1 : 0.f) + (tq > 2 ? t2 : 0.f); const float bl = ((t0 + t1) + t2) + t3; const float ebl = __expf(bl);
            if (tq == 0) DEND[j] = ebl;
            float ke[8];
#pragma unroll
            for (int i = 0; i < 8; ++i) { const float bb = off + cs[i]; const float eb = __expf(bb), enb = __builtin_amdgcn_rcpf(eb); const float qv = bf2f(rq[i]); const float kd = (1.0f - fv[i]) * enb;
                QD[(8 * tq + i) * PQ + j] = (bf16)f2bf(qv * sigmoidf_(qv) * eb); KD[(8 * tq + i) * PQ + j] = (bf16)f2bf(kd); ke[i] = kd * ebl; }
            v4u w; w.x = pk2(ke[0], ke[1]); w.y = pk2(ke[2], ke[3]); w.z = pk2(ke[4], ke[5]); w.w = pk2(ke[6], ke[7]);
            *(LAS v4u*)(KET + j * PS + 8 * tq) = w;
        }
        const bool more = (ch + 1) < SEQ / CL;
        if (more) { load_raw((ch + 1) * CL); ogn = *(const GAS v4u*)(ogp + (size_t)(ch + 1) * CL * NPROJ); }
        __syncthreads();
        if (wave < 4) { const int tt = wave >> 1, st = wave & 1;
            f32x4 a = mm16<4>(KD + 16 * st * PQ, PQ, QD + 16 * tt * PQ, PQ, (f32x4){0.f, 0.f, 0.f, 0.f}, lane);
            const int t = 16 * tt + r16, s0 = 16 * st + 4 * q4;
#pragma unroll
            for (int i = 0; i < 4; ++i) a[i] = (s0 + i <= t) ? a[i] : 0.f;
            *(LAS v2u*)(AT + t * PS + s0) = pack4(a); }
        const int ott = wave & 1, ovt0 = 2 * (wave >> 1);
        f32x4 o0 = mm16<4>(QD + 16 * ott * PQ, PQ, ST + 16 * ovt0 * PQ, PQ, (f32x4){0.f, 0.f, 0.f, 0.f}, lane);
        f32x4 o1 = mm16<4>(QD + 16 * ott * PQ, PQ, ST + 16 * (ovt0 + 1) * PQ, PQ, (f32x4){0.f, 0.f, 0.f, 0.f}, lane);
        __syncthreads();
        o0 = mm16<1>(AT + 16 * ott * PS, PS, VT + 16 * ovt0 * PS, PS, o0, lane);
        o1 = mm16<1>(AT + 16 * ott * PS, PS, VT + 16 * (ovt0 + 1) * PS, PS, o1, lane);
#pragma unroll
        for (int i = 0; i < 4; ++i) { OB[(16 * ott + 4 * q4 + i) * PO + 16 * ovt0 + r16] = o0[i]; OB[(16 * ott + 4 * q4 + i) * PO + 16 * (ovt0 + 1) + r16] = o1[i]; }
        {
            const f32x4 de = *(const LAS f32x4*)(DEND + 16 * wave + 4 * q4);
#pragma unroll
            for (int vt = 0; vt < 8; ++vt) { Sacc[vt] = Sacc[vt] * de; Sacc[vt] = mm16<1>(KET + 16 * wave * PS, PS, VT + 16 * vt * PS, PS, Sacc[vt], lane);
                *(LAS v2u*)(ST + (16 * vt + r16) * PQ + 16 * wave + 4 * q4) = pack4(Sacc[vt]); }
        }
        __syncthreads();
        {
            const int t = tid >> 4, vg = tid & 15; const size_t m = (size_t)b * SEQ + ch * CL + t;
            const f32x4 x0 = *(const LAS f32x4*)(OB + t * PO + 8 * vg), x1 = *(const LAS f32x4*)(OB + t * PO + 8 * vg + 4);
            float ss = (x0[0] * x0[0] + x0[1] * x0[1]) + (x0[2] * x0[2] + x0[3] * x0[3]) + ((x1[0] * x1[0] + x1[1] * x1[1]) + (x1[2] * x1[2] + x1[3] * x1[3]));
            ss = row16_sum(ss);
            const float rs = __builtin_amdgcn_rsqf(ss * (1.0f / 128.0f) + NORM_EPS);
            const v4u og = ogc; ogc = ogn;
            const float z0 = bflo(og.x), z1 = bfhi(og.x), z2 = bflo(og.y), z3 = bfhi(og.y), z4 = bflo(og.z), z5 = bfhi(og.z), z6 = bflo(og.w), z7 = bfhi(og.w);
            v4u w; w.x = pk2(x0[0] * rs * gng0 * (z0 * sigmoidf_(z0)), x0[1] * rs * gng1 * (z1 * sigmoidf_(z1))); w.y = pk2(x0[2] * rs * gng2 * (z2 * sigmoidf_(z2)), x0[3] * rs * gng3 * (z3 * sigmoidf_(z3)));
            w.z = pk2(x1[0] * rs * gng4 * (z4 * sigmoidf_(z4)), x1[1] * rs * gng5 * (z5 * sigmoidf_(z5))); w.w = pk2(x1[2] * rs * gng6 * (z6 * sigmoidf_(z6)), x1[3] * rs * gng7 * (z7 * sigmoidf_(z7)));
            *(GAS v4u*)(YB + m * 1024 + h * 128 + 8 * vg) = w;
        }
    }
}

__device__ __forceinline__ void rwkv_chunk_scan(Frame& F, const Args& args, int bh) {
    constexpr int CL = 32, P72 = 72, P40 = 40, PN = 36, PY = 68;
    const int b = bh >> 4, h = bh & 15, lane_ = F.lane, wave = F.wave, tid_ = F.tid;
    const bf16* P = (const bf16*)(F.ws + WS_PROJ); const bf16* LO = (const bf16*)(F.ws + WS_LORA_O); bf16* YA = (bf16*)(F.ws + WS_YA);
    LAS bf16* X1 = (LAS bf16*)F.lds;
    LAS bf16* X2 = X1 + 64 * P72;
    LAS bf16* BKT = X2 + 64 * P72;
    LAS bf16* VT = BKT + 64 * P72;
    LAS bf16* KKT = VT + 64 * P40;
    LAS bf16* MVT = KKT + 64 * P40;
    LAS bf16* UT = MVT + 64 * P40;
    LAS bf16* MAK = UT + 64 * P40;
    LAS bf16* TT = MAK + 32 * P40;
    LAS bf16* AR = TT + 32 * P40;
    LAS bf16* PM = AR + 32 * P72;
    LAS bf16* T11T = PM + 32 * P72;
    LAS bf16* WTm = T11T + 16 * P40;
    LAS bf16* N21B = WTm + 16 * P40;
    LAS bf16* T22B = N21B + 16 * P40;
    LAS bf16* ZT = T22B + 16 * P40;
    LAS float* NM = (LAS float*)(ZT + 2 * 64 * P72);
    LAS float* YBf = NM + 32 * PN;
    LAS float* WLv = YBf + 32 * PY;
    LAS float* CT = WLv + 64;
    LAS float* VGB = CT + 8 * 64;
    constexpr int VGB_SZ = 2 * 32 * 64 + 32;
    const int c = h * 64 + lane_;
    const float mu_r = args.in[7][c], mu_k = args.in[7][1024 + c], mu_v = args.in[7][2048 + c], w0 = args.in[8][c], a0 = args.in[10][c], kkc = args.in[13][c], kac = args.in[14][c], rkc = args.in[15][c], gng = args.in[16][c], gnb = args.in[17][c];
    unsigned short rr[5], rk[5], rv[5], rwl[4], ral[4], rg[4];
    auto load_raw = [&](int t0) {
#pragma unroll
        for (int i = 0; i < 5; ++i) { const int t = t0 + 4 * wave + i - 1;
            if (t >= 0) { const GAS bf16* pm = (const GAS bf16*)P + ((size_t)b * SEQ + t) * NPROJ + c; rr[i] = pm[0]; rk[i] = pm[1024]; rv[i] = pm[2048]; } else { rr[i] = 0; rk[i] = 0; rv[i] = 0; }
            if (i > 0) { const GAS bf16* lm = (const GAS bf16*)LO + ((size_t)b * SEQ + t) * LORA_N + c; rwl[i - 1] = lm[0]; ral[i - 1] = lm[1024]; rg[i - 1] = lm[2048]; } }
    };
    for (int i = tid_; i < (2 * 64 * P72) / 2; i += 512) ((LAS unsigned*)ZT)[i] = 0u;
    for (int i = tid_; i < (4 * 16 * P40) / 2; i += 512) ((LAS unsigned*)T11T)[i] = 0u;
    for (int i = tid_; i < (32 * P40) / 2; i += 512) ((LAS unsigned*)TT)[i] = 0u;
    f32x4 zacc[2] = {(f32x4){0.f, 0.f, 0.f, 0.f}, (f32x4){0.f, 0.f, 0.f, 0.f}};
    load_raw(0);
    __syncthreads();
    for (int ch = 0; ch < SEQ / CL; ++ch) {
        int lane = lane_; asm volatile("" : "+v"(lane));
        const int q4 = lane >> 4, r16 = lane & 15;
        LAS bf16* ZTc = ZT + (ch & 1) * 64 * P72; LAS bf16* ZTn = ZT + ((ch + 1) & 1) * 64 * P72;
        LAS float* VB = VGB + (ch & 1) * VGB_SZ; LAS float* GB = VB + 32 * 64; LAS float* BON = GB + 32 * 64;
        float er[4], ek2[4], ev[4], ekk[4], eb[4], elw[4], ecw[4]; float run = 0.f;
#pragma unroll
        for (int i = 0; i < 4; ++i) {
            const float r0 = bf2f(rr[i + 1]), k0 = bf2f(rk[i + 1]), v0 = bf2f(rv[i + 1]);
            const float r = r0 + (bf2f(rr[i]) - r0) * mu_r, k = k0 + (bf2f(rk[i]) - k0) * mu_k, v = v0 + (bf2f(rv[i]) - v0) * mu_v;
            const float lw = -0.6065306597126334f * sigmoidf_(w0 + bf2f(rwl[i]));
            const float a = sigmoidf_(a0 + bf2f(ral[i]));
            const float kkv = k * kkc; const float n2 = wave_sum_u(kkv * kkv); const float kk = kkv * __builtin_amdgcn_rsqf(fmaxf(n2, 1e-24f));
            const float k2 = k * (1.0f + (a - 1.0f) * kac);
            const float bon = wave_sum_u(r * k2 * rkc);
            run += lw; er[i] = r; ek2[i] = k2; ev[i] = v; ekk[i] = kk; eb[i] = kk * a; elw[i] = lw; ecw[i] = run;
            const int t = 4 * wave + i;
            VB[t * 64 + lane] = v; GB[t * 64 + lane] = bf2f(rg[i]); if (lane == 0) BON[t] = bon;
        }
        CT[wave * 64 + lane] = run;
        __syncthreads();
        {
            float off = 0.f, tot = 0.f;
#pragma unroll
            for (int w = 0; w < 8; ++w) { const float cv = CT[w * 64 + lane]; off += (w < wave) ? cv : 0.f; tot += cv; }
            const float etot = __expf(tot);
            if (wave == 0) WLv[lane] = etot;
            float fb[4], fk[4], fkk[4];
#pragma unroll
            for (int i = 0; i < 4; ++i) { const int t = 4 * wave + i; const float cw = off + ecw[i]; const float e1 = __expf(cw), e2 = __expf(cw - elw[i]), e3 = __builtin_amdgcn_rcpf(e1), e4 = etot * e3;
                fkk[i] = ekk[i] * e2; fb[i] = eb[i] * e4; fk[i] = ek2[i] * e4;
                X1[t * P72 + lane] = (bf16)f2bf(fkk[i]); X1[(32 + t) * P72 + lane] = (bf16)f2bf(er[i] * e1);
                X2[t * P72 + lane] = (bf16)f2bf(eb[i] * e3); X2[(32 + t) * P72 + lane] = (bf16)f2bf(ek2[i] * e3); }
            v2u w; w.x = pk2(fb[0], fb[1]); w.y = pk2(fb[2], fb[3]); *(LAS v2u*)(BKT + lane * P72 + 4 * wave) = w;
            w.x = pk2(fk[0], fk[1]); w.y = pk2(fk[2], fk[3]); *(LAS v2u*)(BKT + lane * P72 + 32 + 4 * wave) = w;
            w.x = pk2(fkk[0], fkk[1]); w.y = pk2(fkk[2], fkk[3]); *(LAS v2u*)(KKT + lane * P40 + 4 * wave) = w;
            w.x = pk2(ev[0], ev[1]); w.y = pk2(ev[2], ev[3]); *(LAS v2u*)(VT + lane * P40 + 4 * wave) = w;
        }
        const bool more = (ch + 1) < SEQ / CL;
        if (more) load_raw((ch + 1) * CL);
        __syncthreads();
#pragma unroll
        for (int u = 0; u < 2; ++u) { const int idx = 2 * wave + u, rt = idx >> 2, ct = idx & 3;
            if (rt == 0 && ct == 1) continue;
            f32x4 m = mm16<2>(X2 + 16 * ct * P72, P72, X1 + 16 * rt * P72, P72, (f32x4){0.f, 0.f, 0.f, 0.f}, lane);
            const int t = 16 * (rt & 1) + r16, s0 = 16 * (ct & 1) + 4 * q4;
            if (rt < 2) {
#pragma unroll
                for (int i = 0; i < 4; ++i) m[i] = (s0 + i < t) ? m[i] : 0.f;
                if (ct < 2) { *(LAS f32x4*)(NM + t * PN + s0) = m; if (rt == 1 && ct == 0) *(LAS v2u*)(N21B + r16 * P40 + 4 * q4) = pack4(m); }
                else *(LAS v2u*)(MAK + t * P40 + s0) = pack4(m);
            } else {
#pragma unroll
                for (int i = 0; i < 4; ++i) m[i] = (s0 + i <= t) ? m[i] : 0.f;
                *(LAS v2u*)(AR + t * P72 + (ct >= 2 ? 32 : 0) + s0) = pack4(m);
            }
        }
        __syncthreads();
        if (wave == 0) {
            const int blk = q4 & 1, jc = r16; float Tc[16];
            const LAS float* nrow = NM + (16 * blk) * PN + 16 * blk;
#pragma unroll
            for (int t = 0; t < 16; ++t) { float acc = (t == jc) ? 1.0f : 0.0f;
                if (t > 0) {
                    f32x4 nv[4];
#pragma unroll
                    for (int g = 0; g < 4; ++g) if (4 * g < t) nv[g] = *(const LAS f32x4*)(nrow + t * PN + 4 * g);
#pragma unroll
                    for (int s = 0; s < t; ++s) acc -= nv[s >> 2][s & 3] * Tc[s];
                }
                Tc[t] = acc; }
            if (lane < 32) {
#pragma unroll
                for (int s = 0; s < 16; ++s) TT[(16 * blk + s) * P40 + 16 * blk + jc] = (bf16)f2bf(Tc[s]);
                if (blk == 0) { v4u w0v, w1v; w0v.x = pk2(Tc[0], Tc[1]); w0v.y = pk2(Tc[2], Tc[3]); w0v.z = pk2(Tc[4], Tc[5]); w0v.w = pk2(Tc[6], Tc[7]); w1v.x = pk2(Tc[8], Tc[9]); w1v.y = pk2(Tc[10], Tc[11]); w1v.z = pk2(Tc[12], Tc[13]); w1v.w = pk2(Tc[14], Tc[15]);
                    *(LAS v4u*)(T11T + jc * P40) = w0v; *(LAS v4u*)(T11T + jc * P40 + 8) = w1v; }
                else {
#pragma unroll
                    for (int s = 0; s < 16; ++s) T22B[s * P40 + jc] = (bf16)f2bf(Tc[s]); }
            }
            LDS_WAIT();
            f32x4 wv = mm16<1>(N21B, P40, T11T, P40, (f32x4){0.f, 0.f, 0.f, 0.f}, lane);
            *(LAS v2u*)(WTm + r16 * P40 + 4 * q4) = pack4(wv);
            LDS_WAIT();
            f32x4 t21 = mm16<1>(WTm, P40, T22B, P40, (f32x4){0.f, 0.f, 0.f, 0.f}, lane);
            *(LAS v2u*)(TT + (16 + r16) * P40 + 4 * q4) = pack4(-t21);
        } else {
#pragma unroll
            for (int u = 0; u < 2; ++u) { const int tile = (wave - 1) + 7 * u; if (tile < 8) { const int tt = tile & 1, vt = tile >> 1;
                f32x4 mv = mm16<1>(MAK + 16 * tt * P40, P40, VT + 16 * vt * P40, P40, (f32x4){0.f, 0.f, 0.f, 0.f}, lane);
                *(LAS v2u*)(MVT + (16 * vt + r16) * P40 + 16 * tt + 4 * q4) = pack4(mv); } }
        }
        __syncthreads();
        const int ptt = wave & 1, pct = wave >> 1;
        {
            f32x4 pv = mm16<1>(KKT + 16 * pct * P40, P40, TT + 16 * ptt * P40, P40, (f32x4){0.f, 0.f, 0.f, 0.f}, lane);
            *(LAS v2u*)(PM + (16 * ptt + r16) * P72 + 16 * pct + 4 * q4) = pack4(-pv);
        }
        f32x4 uacc = -mm16<1>(TT + 16 * ptt * P40, P40, MVT + 16 * pct * P40, P40, (f32x4){0.f, 0.f, 0.f, 0.f}, lane);
        __syncthreads();
        uacc = mm16<2>(PM + 16 * ptt * P72, P72, ZTc + 16 * pct * P72, P72, uacc, lane);
        *(LAS v2u*)(UT + (16 * pct + r16) * P40 + 16 * ptt + 4 * q4) = pack4(uacc);
        __syncthreads();
        {
            f32x4 y = mm16<2>(X1 + (32 + 16 * ptt) * P72, P72, ZTc + 16 * pct * P72, P72, (f32x4){0.f, 0.f, 0.f, 0.f}, lane);
            y = mm16<1>(AR + 16 * ptt * P72, P72, UT + 16 * pct * P40, P40, y, lane);
            y = mm16<1>(AR + 16 * ptt * P72 + 32, P72, VT + 16 * pct * P40, P40, y, lane);
#pragma unroll
            for (int i = 0; i < 4; ++i) YBf[(16 * ptt + 4 * q4 + i) * PY + 16 * pct + r16] = y[i];
            const int kt = wave >> 1; const f32x4 wl = *(const LAS f32x4*)(WLv + 16 * kt + 4 * q4);
#pragma unroll
            for (int jv = 0; jv < 2; ++jv) { const int vt = 2 * (wave & 1) + jv;
                zacc[jv] = zacc[jv] * wl;
                zacc[jv] = mm16<1>(BKT + 16 * kt * P72, P72, UT + 16 * vt * P40, P40, zacc[jv], lane);
                zacc[jv] = mm16<1>(BKT + 16 * kt * P72 + 32, P72, VT + 16 * vt * P40, P40, zacc[jv], lane);
                *(LAS v2u*)(ZTn + (16 * vt + r16) * P72 + 16 * kt + 4 * q4) = pack4(zacc[jv]); }
        }
        __syncthreads();
#pragma unroll
        for (int i = 0; i < 4; ++i) { const int tl = wave + 8 * i; const size_t m = (size_t)b * SEQ + ch * CL + tl;
            const float y = YBf[tl * PY + lane]; const float mean = wave_sum_u(y) * (1.0f / 64.0f); const float d = y - mean; const float var = wave_sum_u(d * d) * (1.0f / 64.0f);
            const float yn = d * __builtin_amdgcn_rsqf(var + GN_EPS) * gng + gnb;
            const float o = (yn + BON[tl] * VB[tl * 64 + lane]) * GB[tl * 64 + lane];
            YA[m * RW + c] = (bf16)f2bf(o); }
    }
}

__device__ __forceinline__ void p6_hgrn_post(Frame& F, const Args& args) {
    const bf16* P = (const bf16*)(F.ws + WS_PROJ); const float* OH = (const float*)(F.ws + WS_OHG); bf16* YB = (bf16*)(F.ws + WS_YB);
    const int gw = F.vcu * NWAVES + F.wave, NGW = F.G * NWAVES;
    const float g0 = args.in[19][F.lane], g1 = args.in[19][64 + F.lane];
    for (int p = gw; p < M * HNH; p += NGW) { const int m = p >> 3, h = p & 7;
        const float o0 = OH[(size_t)m * 1024 + h * 128 + F.lane], o1 = OH[(size_t)m * 1024 + h * 128 + 64 + F.lane];
        const float rs = 1.0f / sqrtf(wave_sum(o0 * o0 + o1 * o1) * (1.0f / 128.0f) + NORM_EPS);
        const bf16* og = P + (size_t)m * NPROJ + HG_BASE + 3072 + h * 128 + F.lane; const float z0 = bf2f(og[0]), z1 = bf2f(og[64]);
        YB[(size_t)m * 1024 + h * 128 + F.lane] = (bf16)f2bf(o0 * rs * g0 * (z0 * sigmoidf_(z0)));
        YB[(size_t)m * 1024 + h * 128 + 64 + F.lane] = (bf16)f2bf(o1 * rs * g1 * (z1 * sigmoidf_(z1))); }
}

typedef float f32x4_ __attribute__((ext_vector_type(4)));
__device__ __forceinline__ void p9_norm2_router(Frame& F, const Args& args) {
    const bf16* X1 = (const bf16*)(F.ws + WS_X1); const float* mod = (const float*)(F.ws + WS_MOD); unsigned char* H8 = F.ws + WS_XG; const bf16* rwh = (const bf16*)(F.ws + WS_RWP); const bf16* rwl = rwh + NE * D;
    int* tk_e = (int*)(F.ws + WS_ROUTE + RT_E); int* tk_rank = (int*)(F.ws + WS_ROUTE + RT_RANK); float* tk_gate = (float*)(F.ws + WS_ROUTE + RT_GATE);
    constexpr int CP = 264;
    LAS bf16* hsh = (LAS bf16*)F.lds;
    LAS bf16* hsl = hsh + 64 * CP;
    LAS bf16* bsh = hsl + 64 * CP;
    LAS bf16* bsl = bsh + 32 * CP;
    LAS float* rstd_l = (LAS float*)(bsl + 32 * CP);
    LAS float* lg = rstd_l + 64;
    LAS int* lcnt = (LAS int*)(lg + 64 * 32);
    LAS int* lbase = lcnt + 32;
    LAS int* res_e = lbase + 32;
    LAS int* res_r = res_e + 256;
    LAS float* res_g = (LAS float*)(res_r + 256);
    const int lane = F.lane, wave = F.wave, tid = F.tid;
    for (int rg = F.vcu; rg < M / 64; rg += F.G) {
        const int b = rg / (SEQ / 64), m0 = rg * 64;
        const float* sh2 = mod + (size_t)b * 12288 + 3 * D; const float* sc2 = mod + (size_t)b * 12288 + 4 * D;
        __syncthreads();
        if (tid < 32) lcnt[tid] = 0;
        { float pq[8];
#pragma unroll
          for (int i = 0; i < 8; ++i) pq[i] = (lane < 32) ? ((const GAS float*)(F.ws + WS_MODP))[(size_t)(m0 + wave * 8 + i) * 32 + lane] : 0.f;
#pragma unroll
          for (int i = 0; i < 8; ++i) { const float rs = 1.0f / sqrtf(wave_sum(pq[i]) * (1.0f / D) + NORM_EPS); if (lane == 0) rstd_l[wave * 8 + i] = rs; } }
        __syncthreads();
        const int rt = wave >> 1, nt = wave & 1;
        f32x4 acc = (f32x4){0.f, 0.f, 0.f, 0.f};
        v2u xq[8];
#pragma unroll
        for (int p = 0; p < 8; ++p) xq[p] = *(const GAS v2u*)(X1 + (size_t)(m0 + p * 8 + (tid >> 6)) * D + 4 * (tid & 63));
        f32x4 gq = *(const GAS f32x4*)(args.in[5] + 4 * (tid & 63)), shq = *(const GAS f32x4*)(sh2 + 4 * (tid & 63)), scq = *(const GAS f32x4*)(sc2 + 4 * (tid & 63));
        v4u bq[4];
#pragma unroll
        for (int i = 0; i < 4; ++i) { const int idx = tid + 512 * i, e = (idx & 1023) >> 5, k16 = idx & 31; bq[i] = *(const GAS v4u*)(((idx >> 10) ? rwl : rwh) + (size_t)e * D + 8 * k16); }
        for (int ch = 0; ch < 8; ++ch) {
#pragma unroll
            for (int i = 0; i < 4; ++i) { const int idx = tid + 512 * i, e = (idx & 1023) >> 5, k16 = idx & 31; *(LAS v4u*)(((idx >> 10) ? bsl : bsh) + e * CP + 8 * k16) = bq[i]; }
#pragma unroll
            for (int p = 0; p < 8; ++p) { const int rl = p * 8 + (tid >> 6), c = ch * 256 + 4 * (tid & 63);
                const v2u xv = xq[p]; const f32x4 v = (f32x4){bflo(xv.x), bfhi(xv.x), bflo(xv.y), bfhi(xv.y)};
                const f32x4 hv = v * rstd_l[rl] * gq * (scq + 1.0f) + shq;
                { v2u wh, wl; wh.x = pk2(hv.x, hv.y); wh.y = pk2(hv.z, hv.w);
                  wl.x = pk2(hv.x - bflo(wh.x), hv.y - bfhi(wh.x)); wl.y = pk2(hv.z - bflo(wh.y), hv.w - bfhi(wh.y));
                  *(LAS v2u*)(hsh + rl * CP + 4 * (tid & 63)) = wh; *(LAS v2u*)(hsl + rl * CP + 4 * (tid & 63)) = wl; }
                int q8 = 0; q8 = __builtin_amdgcn_cvt_pk_fp8_f32(fminf(fmaxf(hv.x * H8_SCALE, -448.f), 448.f), fminf(fmaxf(hv.y * H8_SCALE, -448.f), 448.f), q8, false);
                q8 = __builtin_amdgcn_cvt_pk_fp8_f32(fminf(fmaxf(hv.z * H8_SCALE, -448.f), 448.f), fminf(fmaxf(hv.w * H8_SCALE, -448.f), 448.f), q8, true);
                *(GAS int*)(H8 + (size_t)(m0 + rl) * D + c) = q8; }
            if (ch < 7) { const int cn = (ch + 1) * 256 + 4 * (tid & 63);
#pragma unroll
                for (int p = 0; p < 8; ++p) xq[p] = *(const GAS v2u*)(X1 + (size_t)(m0 + p * 8 + (tid >> 6)) * D + cn);
                gq = *(const GAS f32x4*)(args.in[5] + cn); shq = *(const GAS f32x4*)(sh2 + cn); scq = *(const GAS f32x4*)(sc2 + cn);
#pragma unroll
                for (int i = 0; i < 4; ++i) { const int idx = tid + 512 * i, e = (idx & 1023) >> 5, k16 = idx & 31; bq[i] = *(const GAS v4u*)(((idx >> 10) ? rwl : rwh) + (size_t)e * D + (ch + 1) * 256 + 8 * k16); } }
            __syncthreads();
#pragma unroll
            for (int ks = 0; ks < 8; ++ks) {
                const int ao = (16 * rt + (lane & 15)) * CP + 32 * ks + 8 * (lane >> 4);
                const int bo = (16 * nt + (lane & 15)) * CP + 32 * ks + 8 * (lane >> 4);
                const bf16x8_t ah = *(const LAS bf16x8_t*)(hsh + ao), al = *(const LAS bf16x8_t*)(hsl + ao), bh = *(const LAS bf16x8_t*)(bsh + bo), bl = *(const LAS bf16x8_t*)(bsl + bo);
                acc = __builtin_amdgcn_mfma_f32_16x16x32_bf16(ah, bh, acc, 0, 0, 0); acc = __builtin_amdgcn_mfma_f32_16x16x32_bf16(ah, bl, acc, 0, 0, 0); acc = __builtin_amdgcn_mfma_f32_16x16x32_bf16(al, bh, acc, 0, 0, 0);
            }
            __syncthreads();
        }
#pragma unroll
        for (int i = 0; i < 4; ++i) lg[(16 * rt + 4 * (lane >> 4) + i) * 32 + 16 * nt + (lane & 15)] = acc[i] + args.in[24][16 * nt + (lane & 15)];
        __syncthreads();
        if (tid < 64) {
            float v[32];
#pragma unroll
            for (int e = 0; e < 32; ++e) v[e] = lg[tid * 32 + e];
            float tv[4]; int ti[4];
#pragma unroll
            for (int k = 0; k < 4; ++k) { float best = -3.0e38f; int bi = 0;
#pragma unroll
                for (int e = 0; e < 32; ++e) { const bool gt = v[e] > best; best = gt ? v[e] : best; bi = gt ? e : bi; }
                tv[k] = best; ti[k] = bi;
#pragma unroll
                for (int e = 0; e < 32; ++e) v[e] = (e == bi) ? -3.0e38f : v[e]; }
            const float e1 = __expf(tv[1] - tv[0]), e2 = __expf(tv[2] - tv[0]), e3 = __expf(tv[3] - tv[0]); const float inv = 1.0f / (1.0f + e1 + e2 + e3);
            const float gt4[4] = {inv, e1 * inv, e2 * inv, e3 * inv};
#pragma unroll
            for (int k = 0; k < 4; ++k) { res_e[tid * 4 + k] = ti[k]; res_g[tid * 4 + k] = gt4[k]; res_r[tid * 4 + k] = atomicAdd((int*)&lcnt[ti[k]], 1); }
        }
        __syncthreads();
        if (tid < 32) lbase[tid] = (int)__hip_atomic_fetch_add((unsigned*)(F.ctl + CW_CNT) + tid, (unsigned)lcnt[tid], RLX_AGENT);
        __syncthreads();
        if (tid < 256) { const int e = res_e[tid]; const size_t p = (size_t)m0 * 4 + tid; tk_e[p] = e; tk_rank[p] = lbase[e] + res_r[tid]; tk_gate[p] = res_g[tid]; }
    }
}

__device__ __forceinline__ void p10_dispatch(Frame& F, const Args& args) {
    const int* tk_e = (const int*)(F.ws + WS_ROUTE + RT_E); const int* tk_rank = (const int*)(F.ws + WS_ROUTE + RT_RANK); const float* tk_gate = (const float*)(F.ws + WS_ROUTE + RT_GATE);
    int* tok_slot = (int*)(F.ws + WS_ROUTE + RT_TOKSLOT); float* slot_w = (float*)(F.ws + WS_ROUTE + RT_SLOTW); int* tile_e = (int*)(F.ws + WS_ROUTE + RT_TILEE); int* slot_tok = (int*)(F.ws + WS_ROUTE + RT_SLOTTOK);
    LAS int* tstart = (LAS int*)F.lds;
    __syncthreads();
    if (F.tid < NE) tstart[40 + F.tid] = (int)__hip_atomic_load((unsigned*)(F.ctl + CW_CNT) + F.tid, RLX_AGENT);
    __syncthreads();
    if (F.tid == 0) { int s = 0; for (int e = 0; e < NE; ++e) { tstart[e] = s; s += (tstart[40 + e] + 255) >> 8; } tstart[NE] = s; }
    __syncthreads();
    if (blockIdx.x == 0) { const int nt = tstart[NE]; for (int t = F.tid; t <= MAXTILES; t += 512) { int e = -1; if (t < nt) { e = 0; while (tstart[e + 1] <= t) ++e; } if (t < MAXTILES) tile_e[t] = (e < 0) ? 0 : e; else tile_e[MAXTILES] = nt; } }
    for (int e = F.vcu; e < NE; e += F.G) { const int cn = tstart[40 + e], base = 256 * tstart[e], pe = ((cn + 255) >> 8) << 8; for (int s = cn + F.tid; s < pe; s += 512) slot_tok[base + s] = 0; }
    const int gt = F.vcu * 512 + F.tid, NGT = F.G * 512;
    for (int p = gt; p < NASSIGN; p += NGT) { const int e = tk_e[p], slot = 256 * tstart[e] + tk_rank[p]; tok_slot[p] = slot; slot_w[slot] = tk_gate[p]; slot_tok[slot] = p >> 2; }
}

__device__ __forceinline__ void p13_final(Frame& F, const Args& args) {
    const bf16* X1 = (const bf16*)(F.ws + WS_X1); const float* mod = (const float*)(F.ws + WS_MOD); const unsigned char* YE = F.ws + WS_YE; const int* tok_slot = (const int*)(F.ws + WS_ROUTE + RT_TOKSLOT);
    const int gw = F.vcu * NWAVES + F.wave, NGW = F.G * NWAVES;
    typedef int i32x4 __attribute__((ext_vector_type(4)));
    f32x4 fg[8];
#pragma unroll
    for (int j = 0; j < 4; ++j)
#pragma unroll
        for (int hh = 0; hh < 2; ++hh) fg[2 * j + hh] = *(const GAS f32x4*)(args.in[29] + 512 * j + 8 * F.lane + 4 * hh);
    i32x4 sl = *(const GAS i32x4*)(tok_slot + 4 * (gw < M ? gw : 0));
    for (int m = gw; m < M; m += NGW) {
        const int b = m / SEQ; const float* g2 = mod + (size_t)b * 12288 + 5 * D;
        const int s0 = sl.x, s1 = sl.y, s2 = sl.z, s3 = sl.w;
        { const int mn = (m + NGW < M) ? m + NGW : m; sl = *(const GAS i32x4*)(tok_slot + 4 * mn); }
        const GAS v4u* xr = (const GAS v4u*)(X1 + (size_t)m * D) + F.lane;
        f32x4 v[8]; float ss = 0.f;
#pragma unroll
        for (int j = 0; j < 4; ++j) { const int c = 512 * j + 8 * F.lane;
            const v2u y0 = *(const GAS v2u*)(YE + (size_t)s0 * D + c), y1 = *(const GAS v2u*)(YE + (size_t)s1 * D + c), y2 = *(const GAS v2u*)(YE + (size_t)s2 * D + c), y3 = *(const GAS v2u*)(YE + (size_t)s3 * D + c);
            const v4u xv = xr[64 * j];
            const unsigned q0[2] = {y0.x, y0.y}, q1[2] = {y1.x, y1.y}, q2[2] = {y2.x, y2.y}, q3[2] = {y3.x, y3.y}; const unsigned xw[4] = {xv.x, xv.y, xv.z, xv.w};
#pragma unroll
            for (int hh = 0; hh < 2; ++hh) {
                const f32x2 a0 = __builtin_amdgcn_cvt_pk_f32_fp8((int)q0[hh], false), a1 = __builtin_amdgcn_cvt_pk_f32_fp8((int)q0[hh], true), b0 = __builtin_amdgcn_cvt_pk_f32_fp8((int)q1[hh], false), b1 = __builtin_amdgcn_cvt_pk_f32_fp8((int)q1[hh], true);
                const f32x2 c0 = __builtin_amdgcn_cvt_pk_f32_fp8((int)q2[hh], false), c1 = __builtin_amdgcn_cvt_pk_f32_fp8((int)q2[hh], true), d0 = __builtin_amdgcn_cvt_pk_f32_fp8((int)q3[hh], false), d1 = __builtin_amdgcn_cvt_pk_f32_fp8((int)q3[hh], true);
                const f32x2 lo = ((a0 + b0) + c0) + d0, hi = ((a1 + b1) + c1) + d1;
                const f32x4 f = (f32x4){lo.x, lo.y, hi.x, hi.y} * (1.0f / Y8_SCALE);
                const f32x4 x4 = (f32x4){bflo(xw[2 * hh]), bfhi(xw[2 * hh]), bflo(xw[2 * hh + 1]), bfhi(xw[2 * hh + 1])};
                v[2 * j + hh] = x4 + *(const GAS f32x4*)(g2 + c + 4 * hh) * f;
                ss += (v[2 * j + hh].x * v[2 * j + hh].x + v[2 * j + hh].y * v[2 * j + hh].y) + (v[2 * j + hh].z * v[2 * j + hh].z + v[2 * j + hh].w * v[2 * j + hh].w); } }
        const float rstd = 1.0f / sqrtf(wave_sum(ss) * (1.0f / D) + NORM_EPS);
        float* orow = args.out + (size_t)m * D;
#pragma unroll
        for (int j = 0; j < 4; ++j)
#pragma unroll
            for (int hh = 0; hh < 2; ++hh) { const int c = 512 * j + 8 * F.lane + 4 * hh; *(GAS f32x4*)(orow + c) = v[2 * j + hh] * rstd * fg[2 * j + hh]; }
    }
}

__global__ void __launch_bounds__(NWAVES * 64, 2) mk_fwd(Args args) {
    extern __shared__ __attribute__((aligned(16))) unsigned char lds[];
    Frame F;
    F.lds = (LAS unsigned char*)lds;
    F.MISC = (volatile LAS unsigned*)(F.lds + MISC_OFF);
    F.tid = threadIdx.x; F.lane = F.tid & 63; F.wave = __builtin_amdgcn_readfirstlane(F.tid >> 6);
    F.G = gridDim.x; { const int bx = blockIdx.x; F.vcu = (F.G % 8 == 0) ? (bx % 8) * (F.G / 8) + bx / 8 : bx; }
    F.ws = args.ws; F.ctl = (gu32*)(args.ws + WS_CTL);
    for (int u = F.tid; u < 64; u += NWAVES * 64) ((LAS unsigned*)(F.lds + MISC_OFF))[u] = 0u;
    __syncthreads();
    XcdBarrier bar; bar.bar = (unsigned*)(F.ctl + CW_BAR); bar.x = 0; bar.st = nullptr;
    if (N_LAUNCHES == 1) bar = xcd_barrier_post((unsigned*)(F.ctl + CW_BAR), F.MISC + 8);
#define GRID_BAR() do { if (N_LAUNCHES == 1) { xcd_barrier(bar); } } while (0)
    const int lo = args.ph_lo, hi = args.ph_hi;
#ifndef PROBE_REPEAT
#define PROBE_REPEAT 0
#endif
#define REP(k) for (int rep_ = 0; rep_ < (((PROBE_REPEAT) >> (k)) & 1) + 1; ++rep_)
#define IN(k) (lo <= (k) && (k) < hi)
#define BOTH(k) (IN(k) && IN((k) + 1))
    unsigned char* ws = args.ws;
    pg8::bf16_t* const Hb = (pg8::bf16_t*)(ws + WS_H); pg8::bf16_t* const PROJ = (pg8::bf16_t*)(ws + WS_PROJ);

    if (IN(0)) REP(0) { p0_prologue(F, args); if (BOTH(0)) GRID_BAR(); }
    if (IN(1)) REP(1) { p1_norm1(F, args); if (BOTH(1)) GRID_BAR(); }
    if (IN(2)) REP(2) {
        const int bx = (int)blockIdx.x; const bool ded = (F.G == 256) && bx >= P2_GEMM_WGS;
        pg8::Gemm g{Hb, (const pg8::bf16_t*)(ws + WS_WIN), M, NPROJ, D, 0}; pg8::StaticOrder S; S.init(M, NPROJ, (F.G == 256) ? P2_GEMM_WGS : F.G, bx);
        pg8::EpiBf16<0> E{PROJ, NPROJ, nullptr, 0, 0, 1.f};
        if (!ded) pg8::gemm_phase<pg8::EpiBf16<0>, pg8::StaticOrder, PG8_ALIGN, PG8_SP2>(F.lds, g, S, E);
        if (F.G == 256) {
            if (ded) p8_convert(F, args, P8_SPLITD, P8_SPLITR, (bx - P2_GEMM_WGS) * NWAVES + F.wave, (256 - P2_GEMM_WGS) * NWAVES, 0);
            else if (bx >= P2_NFULL) p8_convert(F, args, P8_SPLITA, P8_SPLIT, (bx - P2_NFULL) * NWAVES + F.wave, (P2_GEMM_WGS - P2_NFULL) * NWAVES, 0); }
        else { p8_convert(F, args, P8_SPLITD, P8_SPLITR, F.vcu * NWAVES + F.wave, F.G * NWAVES, 0); p8_convert(F, args, P8_SPLITA, P8_SPLIT, F.vcu * NWAVES + F.wave, F.G * NWAVES, 0); }
        if (BOTH(2)) GRID_BAR();
    }
    if (IN(3)) REP(3) { p3_lora_a(F, args); if (BOTH(3)) GRID_BAR(); }
    if (IN(4)) REP(4) {
        pg8::Gemm g{(const pg8::bf16_t*)(ws + WS_LORA_A), (const pg8::bf16_t*)(ws + WS_WLORA), M, LORA_N, LORA_K, 0}; pg8::StaticOrder S; S.init(M, LORA_N, F.G, (int)blockIdx.x);
        pg8::EpiBf16<0> E{(pg8::bf16_t*)(ws + WS_LORA_O), LORA_N, nullptr, 0, 0, 1.f};
        pg8::gemm_phase<pg8::EpiBf16<0>, pg8::StaticOrder, PG8_ALIGN, PG8_SP2>(F.lds, g, S, E);
        if (BOTH(4)) GRID_BAR();
    }
    if (IN(5)) REP(5) {
        if (F.G == 256) { const int bx = (int)blockIdx.x;
            if (bx < 128) { rwkv_chunk_scan(F, args, bx); __syncthreads(); p8_convert(F, args, P8_SPLITR, P8_SPLITH, bx * NWAVES + F.wave, 128 * NWAVES, 0); } else if (bx < 192) { hgrn_chunk_scan(F, args, bx - 128); __syncthreads(); p8_convert(F, args, P8_SPLITH, P8_SPLITA, (bx - 128) * NWAVES + F.wave, 64 * NWAVES, 0); } else p8_convert(F, args, P8_SPLIT, P8_N, (bx - 192) * NWAVES + F.wave, 64 * NWAVES, 0); }
        else { for (int u = F.vcu; u < 192; u += F.G) { if (u < 128) rwkv_chunk_scan(F, args, u); else hgrn_chunk_scan(F, args, u - 128); } __syncthreads(); p8_convert(F, args, P8_SPLITR, P8_SPLITA, F.vcu * NWAVES + F.wave, F.G * NWAVES, 0); p8_convert(F, args, P8_SPLIT, P8_N, F.vcu * NWAVES + F.wave, F.G * NWAVES, 0); }
        if (BOTH(5)) GRID_BAR();
        if ((PROBE_REPEAT >> 14) & 1) { for (int u = F.vcu; u < 192; u += F.G) { if (u < 128) rwkv_chunk_scan(F, args, u); } GRID_BAR(); }
        if ((PROBE_REPEAT >> 15) & 1) { for (int u = F.vcu; u < 192; u += F.G) { if (u >= 128) hgrn_chunk_scan(F, args, u - 128); } GRID_BAR(); }
    }
    if (IN(6)) {   }
    if (IN(7)) REP(7) {
        pg8::Gemm g{(const pg8::bf16_t*)(ws + WS_YA), (const pg8::bf16_t*)(ws + WS_WPA), M, D, RW, 0, nullptr, (const pg8::bf16_t*)(ws + WS_YB), (const pg8::bf16_t*)(ws + WS_WPB)}; pg8::PairOrder S; S.init(M, D, F.G, (int)blockIdx.x);
        pg8::EpiMerge E{PROJ + GATE_BASE, NPROJ, D, (pg8::bf16_t*)(ws + WS_MERGED), D};
        pg8::gemm_phase<pg8::EpiMerge, pg8::PairOrder, PG8_ALIGN, PG8_SP2>(F.lds, g, S, E);
        if (BOTH(7)) GRID_BAR();
    }
    if (IN(8)) REP(8) {
        pg8::Gemm g{(const pg8::bf16_t*)(ws + WS_MERGED), (const pg8::bf16_t*)(ws + WS_WOUT), M, D, D, 0}; pg8::StaticOrder S; S.init(M, D, F.G, (int)blockIdx.x);
        pg8::EpiRes E{args.in[0], (pg8::bf16_t*)(ws + WS_X1), D, (const float*)(ws + WS_MOD) + 2 * D, 12288, SEQ, (float*)(ws + WS_MODP)};
        pg8::gemm_phase<pg8::EpiRes, pg8::StaticOrder, PG8_ALIGN, PG8_SP2>(F.lds, g, S, E);
        if (BOTH(8)) GRID_BAR();
    }
    if ((PROBE_REPEAT >> 16) & 1) { if (IN(8)) {
        pg8::Gemm g{(const pg8::bf16_t*)(ws + WS_MERGED), (const pg8::bf16_t*)(ws + WS_WOUT), M, D, D, 0}; pg8::StaticOrder S; S.init(M, D, F.G, (int)blockIdx.x);
        pg8::EpiNull E{(float*)(ws + WS_T1)};
        pg8::gemm_phase<pg8::EpiNull, pg8::StaticOrder, PG8_ALIGN, PG8_SP2>(F.lds, g, S, E);
        GRID_BAR();
        if ((PROBE_REPEAT >> 17) & 1) { pg8::gemm_phase<pg8::EpiNull, pg8::StaticOrder, PG8_ALIGN, PG8_SP2>(F.lds, g, S, E); GRID_BAR(); } } }
    if (IN(9)) REP(9) { p9_norm2_router(F, args); if (BOTH(9)) GRID_BAR(); }
    if (IN(10)) REP(10) { p10_dispatch(F, args); if (BOTH(10)) GRID_BAR(); }
    if (IN(11)) REP(11) {
        const int* tile_e = (const int*)(ws + WS_ROUTE + RT_TILEE); const int nt = tile_e[MAXTILES];
        pg8::Gemm g{(const pg8::bf16_t*)(ws + WS_XG), (const pg8::bf16_t*)(ws + WS_WGU), nt * 256, 2 * DE, D / 2, (size_t)2 * DE * D, (const int*)(ws + WS_ROUTE + RT_SLOTTOK)};     pg8::GroupedOrder S; S.init(nt * 256, 2 * DE, F.G, (int)blockIdx.x); S.tile_e = tile_e;
        pg8::EpiSwigluF8 E{ws + WS_ACT, DE, args.in[26], DE, 1.0f / (W8_SCALE * H8_SCALE), A8_SCALE};
        pg8::gemm_phase<pg8::EpiSwigluF8, pg8::GroupedOrder, PG8_ALIGN, PG8_SP2, true, true>(F.lds, g, S, E);
        {
            const int nwg = nt * ((2 * DE) / 256), R = (nwg + F.G - 1) / F.G, nfull = nwg - F.G * (R - 1), s = F.G - nfull, bx = (int)blockIdx.x;
            const int capA = (P11_TAIL_ITEMS * s < P8_Q) ? P11_TAIL_ITEMS * s : P8_Q;
            if (s > 0 && bx >= nfull) p8_convert(F, args, P8_N, P8_N + capA, (bx - nfull) * NWAVES + F.wave, s * NWAVES, 0);
            if (capA < P8_Q) p8_convert(F, args, P8_N + capA, P8_N + P8_Q, F.vcu * NWAVES + F.wave, F.G * NWAVES, 0);
        }
        if (BOTH(11)) GRID_BAR();
    }
    if (IN(12)) REP(12) {
        const int* tile_e = (const int*)(ws + WS_ROUTE + RT_TILEE); const int nt = tile_e[MAXTILES];
        pg8::Gemm g{(const pg8::bf16_t*)(ws + WS_ACT), (const pg8::bf16_t*)(ws + WS_WDN), nt * 256, D, DE / 2, (size_t)D * DE, nullptr}; pg8::GroupedOrder S; S.init(nt * 256, D, F.G, (int)blockIdx.x); S.tile_e = tile_e;
        pg8::EpiDown E{ws + WS_YE, D, args.in[28], (const float*)(ws + WS_ROUTE + RT_SLOTW), 1.0f / (W8_SCALE * A8_SCALE), Y8_SCALE};
        pg8::gemm_phase<pg8::EpiDown, pg8::GroupedOrder, PG8_ALIGN, PG8_SP2, false, true>(F.lds, g, S, E);
        if (BOTH(12)) GRID_BAR();
    }
    if (IN(13)) REP(13) { p13_final(F, args); }
#undef IN
#undef BOTH
}

extern "C" void kernel_launch(void* const* d_in, const int* in_sizes, int n_in, void* d_out, int out_size, void* d_ws, size_t ws_size, hipStream_t stream) {
    static int grid = 0;
    if (grid == 0) {
        if (n_in != 30 || out_size != M * D || ws_size < WS_END) { fprintf(stderr, "kernel_launch: unexpected shapes (n_in %d, out %d, ws %zu)\n", n_in, out_size, ws_size); grid = -1; return; }
        int dev = 0, cus = 0, per_cu = 0;
        if (hipGetDevice(&dev) != hipSuccess || hipDeviceGetAttribute(&cus, hipDeviceAttributeMultiprocessorCount, dev) != hipSuccess) { grid = -1; return; }
        if (hipFuncSetAttribute((const void*)mk_fwd, hipFuncAttributeMaxDynamicSharedMemorySize, LDS_BYTES) != hipSuccess) { fprintf(stderr, "kernel_launch: hipFuncSetAttribute failed\n"); grid = -1; return; }
        if (hipOccupancyMaxActiveBlocksPerMultiprocessor(&per_cu, (const void*)mk_fwd, NWAVES * 64, LDS_BYTES) != hipSuccess || per_cu < 1) fprintf(stderr, "kernel_launch: occupancy query reports %d\n", per_cu);
        (void)hipGetLastError();
        grid = cus;
    }
    if (grid < 0) return;
    (void)in_sizes;
    if (hipMemsetAsync((char*)d_ws + WS_CTL, 0, CTL_ZERO_BYTES, stream) != hipSuccess) return;
    Args a{};
    for (int i = 0; i < 30; ++i) a.in[i] = (const float*)d_in[i];
    a.out = (float*)d_out; a.ws = (unsigned char*)d_ws;
    for (int li = 0; li < N_LAUNCHES; ++li) {
        a.ph_lo = (N_LAUNCHES == 1) ? 0 : li; a.ph_hi = (N_LAUNCHES == 1) ? N_PHASES : li + 1; a.li = li; a.pad = 0;
        hipLaunchKernelGGL(mk_fwd, dim3(grid), dim3(NWAVES * 64), LDS_BYTES, stream, a);
        const hipError_t le = hipPeekAtLastError();
        if (le != hipSuccess) { fprintf(stderr, "kernel_launch: launch %d failed: %s\n", li, hipGetErrorName(le)); break; }
    }
}
```

```cpp
#include <hip/hip_runtime.h>
#include <cstdio>
#include <cstdint>
namespace pg8 {
#define PG8_LAS __attribute__((address_space(3)))
typedef unsigned short bf16_t;
typedef short bf16x8 __attribute__((ext_vector_type(8)));
typedef float f32x4 __attribute__((ext_vector_type(4)));
typedef unsigned u32x4 __attribute__((ext_vector_type(4)));
typedef int i32x4_t __attribute__((ext_vector_type(4)));
constexpr int BM = 256, BK = 64, HALF = 128, HTB = HALF * BK * 2  , STAGE_BYTES = 8 * HTB, NXCD = 8, WGM = 8;

__host__ __device__ __forceinline__ int lds_byte(int r, int c) { const int st = (r >> 4) * 2 + (c >> 5), rr = r & 15, cc = c & 31, ob = rr * 64 + cc * 2; return st * 1024 + (ob ^ (((ob >> 9) & 1) << 5)); }
__host__ __device__ __forceinline__ void stage_rc(int b, int& R, int& C) { const int st = b / 1024, sb = b % 1024, swz = sb ^ (((sb >> 9) & 1) << 5); R = (st >> 1) * 16 + swz / 64; C = (st & 1) * 32 + (swz % 64) / 2; }
__host__ __device__ __forceinline__ int perm32(int rho) { const int n = rho >> 4, i = rho & 15; return 8 * (i >> 2) + 4 * n + (i & 3); }

struct Unit { int pm, pn, e, kh; };
struct Gemm { const bf16_t* A; const bf16_t* Bt; int M, N, K; size_t bgs; const int* gather; const bf16_t* A2; const bf16_t* Bt2; };

struct StaticOrder {
    static constexpr bool PAIRS = false;
    int nM, nN, nwg, G, c;
    __host__ __device__ void init(int M, int N, int G_, int c_) { nM = M / BM; nN = N / BM; nwg = nM * nN; G = G_; c = c_; }
    __host__ __device__ bool next(int i, Unit& u) const {
        const long L = (long)i * G + c; if (L >= nwg) return false;
        int wgid = (int)L; { const int q = nwg / NXCD, r = nwg % NXCD, xcd = wgid % NXCD, off = wgid / NXCD; wgid = (xcd < r ? xcd * (q + 1) : r * (q + 1) + (xcd - r) * q) + off; }
        const int nig = WGM * nN, gid = wgid / nig, fm = gid * WGM, gsz = (nM - fm) < WGM ? (nM - fm) : WGM;
        u.pm = fm + ((wgid % nig) % gsz); u.pn = (wgid % nig) / gsz; u.e = 0; u.kh = 0; return true;
    }
    __device__ __forceinline__ void a_ready(const Unit&) const {}
    __device__ __forceinline__ void done(const Unit&) const {}
};

__device__ __forceinline__ unsigned cvt_pk_bf16(float lo, float hi) { unsigned r; asm volatile("v_cvt_pk_bf16_f32 %0, %1, %2" : "=v"(r) : "v"(lo), "v"(hi)); return r; }
typedef float f32x2 __attribute__((ext_vector_type(2)));
__device__ __forceinline__ f32x2 gelu_pk(f32x2 v) {
    const f32x2 av = __builtin_elementwise_abs(v), d = av * 0.2316418882f + 1.0f;
    f32x2 t; t.x = __builtin_amdgcn_rcpf(d.x); t.y = __builtin_amdgcn_rcpf(d.y);
    f32x2 q = t * 0.5307027145f + (-0.7265760135f); q = q * t + 0.7107068705f; q = q * t + (-0.142248368f); q = q * t + 0.127414796f; q = q * t;
    const f32x2 s = (v * v) * (-0.72134752044f);
    f32x2 e; e.x = __builtin_amdgcn_exp2f(s.x); e.y = __builtin_amdgcn_exp2f(s.y);
    const f32x2 m = v * (q * e), r = v - m;
    f32x2 o; o.x = v.x < 0.f ? m.x : r.x; o.y = v.y < 0.f ? m.y : r.y; return o;
}

template <int ACT  > struct EpiBf16 {
    static constexpr bool PERM = true, AFTER_DRAIN = false, MID = false; static_assert(ACT == 0 || ACT == 1, "EpiBf16: ACT is 0 (none) or 1 (gelu_pk)");
    bf16_t* O; int ldc; const float* bias; int split_cols; size_t split_stride; float scale0;
    __device__ __forceinline__ void operator()(const f32x4 (&acc)[2][2][4][2], const Unit& u, int wr, int wc, int fr, int fq) const {
        const int row0 = u.pm * BM + wr * 64 + fr; int colt = u.pn * BM; bf16_t* base = O;
        float sc = 1.f; if (split_cols) { const int t = colt / split_cols; base += (size_t)t * split_stride; colt -= t * split_cols; if (t == 0) sc = scale0; }
        const int col0 = colt + wc * 32 + 8 * fq, bcol0 = u.pn * BM + wc * 32 + 8 * fq;
        f32x4 bv[2][2];
#pragma unroll
        for (int bj = 0; bj < 2; ++bj)
#pragma unroll
            for (int n = 0; n < 2; ++n) bv[bj][n] = bias ? *(const f32x4*)(bias + bcol0 + bj * HALF + 4 * n) : (f32x4){0.f, 0.f, 0.f, 0.f};
#pragma unroll
        for (int ai = 0; ai < 2; ++ai)
#pragma unroll
            for (int m = 0; m < 4; ++m) { bf16_t* rowp = base + (size_t)(row0 + ai * HALF + m * 16) * ldc + col0;
#pragma unroll
                for (int bj = 0; bj < 2; ++bj) { f32x4 v0 = acc[ai][bj][m][0] + bv[bj][0], v1 = acc[ai][bj][m][1] + bv[bj][1];
                    if (ACT == 1) { f32x2 a = gelu_pk((f32x2){v0[0], v0[1]}), b = gelu_pk((f32x2){v0[2], v0[3]}), c = gelu_pk((f32x2){v1[0], v1[1]}), d = gelu_pk((f32x2){v1[2], v1[3]});
                        v0 = (f32x4){a.x, a.y, b.x, b.y}; v1 = (f32x4){c.x, c.y, d.x, d.y}; }
                    v0 = v0 * sc; v1 = v1 * sc; u32x4 w; w.x = cvt_pk_bf16(v0[0], v0[1]); w.y = cvt_pk_bf16(v0[2], v0[3]); w.z = cvt_pk_bf16(v1[0], v1[1]); w.w = cvt_pk_bf16(v1[2], v1[3]);
                    *(u32x4*)(rowp + bj * HALF) = w; } }
    }
};


__device__ __forceinline__ float bf_lo(unsigned w) { return __uint_as_float(w << 16); }
__device__ __forceinline__ float bf_hi(unsigned w) { return __uint_as_float(w & 0xffff0000u); }
__device__ __forceinline__ float sigm(float x) { return __builtin_amdgcn_rcpf(1.0f + __expf(-x)); }
typedef unsigned u32x2 __attribute__((ext_vector_type(2)));

struct EpiF32 {
    static constexpr bool PERM = false, AFTER_DRAIN = false, MID = false;
    float* C; int ldc;
    __device__ __forceinline__ void operator()(const f32x4 (&acc)[2][2][4][2], const Unit& u, int wr, int wc, int fr, int fq) const {
        const int row0 = u.pm * BM + wr * 64 + fr, col0 = u.pn * BM + wc * 32 + 4 * fq;
#pragma unroll
        for (int ai = 0; ai < 2; ++ai)
#pragma unroll
            for (int m = 0; m < 4; ++m) { float* rowp = C + (size_t)(row0 + ai * HALF + m * 16) * ldc + col0;
#pragma unroll
                for (int bj = 0; bj < 2; ++bj)
#pragma unroll
                    for (int n = 0; n < 2; ++n) *(f32x4*)(rowp + bj * HALF + n * 16) = acc[ai][bj][m][n]; }
    }
};
template <int PASS> struct EpiGate {
    static constexpr bool PERM = false, AFTER_DRAIN = false, MID = false;
    const bf16_t* gate; int ldg; bf16_t* T1; bf16_t* O; int ldc;
    __device__ __forceinline__ void operator()(const f32x4 (&acc)[2][2][4][2], const Unit& u, int wr, int wc, int fr, int fq) const {
        const int row0 = u.pm * BM + wr * 64 + fr, col0 = u.pn * BM + wc * 32 + 4 * fq;
#pragma unroll
        for (int ai = 0; ai < 2; ++ai) {
            u32x2 gv[4][2][2];
#pragma unroll
            for (int m = 0; m < 4; ++m) { const size_t r = (size_t)(row0 + ai * HALF + m * 16);
#pragma unroll
                for (int bj = 0; bj < 2; ++bj)
#pragma unroll
                    for (int n = 0; n < 2; ++n) gv[m][bj][n] = *(const u32x2*)(gate + r * ldg + col0 + bj * HALF + n * 16); }
#pragma unroll
            for (int mh = 0; mh < 2; ++mh) {
                u32x2 tv[2][2][2];
                if (PASS == 1) {
#pragma unroll
                    for (int m2 = 0; m2 < 2; ++m2) { const size_t r = (size_t)(row0 + ai * HALF + (2 * mh + m2) * 16);
#pragma unroll
                        for (int bj = 0; bj < 2; ++bj)
#pragma unroll
                            for (int n = 0; n < 2; ++n) tv[m2][bj][n] = *(const u32x2*)(T1 + r * ldc + col0 + bj * HALF + n * 16); } }
#pragma unroll
                for (int m2 = 0; m2 < 2; ++m2) { const int m = 2 * mh + m2; const size_t r = (size_t)(row0 + ai * HALF + m * 16);
#pragma unroll
                    for (int bj = 0; bj < 2; ++bj)
#pragma unroll
                        for (int n = 0; n < 2; ++n) { const int c = col0 + bj * HALF + n * 16; const u32x2 g2 = gv[m][bj][n];
                            f32x4 s; s[0] = sigm(bf_lo(g2.x)); s[1] = sigm(bf_hi(g2.x)); s[2] = sigm(bf_lo(g2.y)); s[3] = sigm(bf_hi(g2.y));
                            f32x4 v = acc[ai][bj][m][n] * s;
                            if (PASS == 0) { u32x2 w; w.x = cvt_pk_bf16(v[0], v[1]); w.y = cvt_pk_bf16(v[2], v[3]); *(u32x2*)(T1 + r * ldc + c) = w; }
                            else { const u32x2 t2 = tv[m2][bj][n]; v[0] += bf_lo(t2.x); v[1] += bf_hi(t2.x); v[2] += bf_lo(t2.y); v[3] += bf_hi(t2.y); u32x2 w; w.x = cvt_pk_bf16(v[0], v[1]); w.y = cvt_pk_bf16(v[2], v[3]); *(u32x2*)(O + r * ldc + c) = w; } } }
                asm volatile("" ::: "memory"); }
        }
    }
};
struct EpiMerge {
    static constexpr bool PERM = true, AFTER_DRAIN = false, MID = true;
    const bf16_t* gate; int ldg; int gboff; bf16_t* O; int ldc;
    __device__ __forceinline__ void mid(f32x4 (&acc)[2][2][4][2], const Unit& u, int wr, int wc, int fr, int fq) const {
        const int row0 = u.pm * BM + wr * 64 + fr, col0 = u.pn * BM + wc * 32 + 8 * fq;
#pragma unroll
        for (int ai = 0; ai < 2; ++ai) {
            u32x4 ga[4][2], gb[4][2];
#pragma unroll
            for (int m = 0; m < 4; ++m) { const bf16_t* gp = gate + (size_t)(row0 + ai * HALF + m * 16) * ldg + col0;
#pragma unroll
                for (int bj = 0; bj < 2; ++bj) { ga[m][bj] = *(const u32x4*)(gp + bj * HALF); gb[m][bj] = *(const u32x4*)(gp + gboff + bj * HALF); } }
#pragma unroll
            for (int m = 0; m < 4; ++m)
#pragma unroll
                for (int bj = 0; bj < 2; ++bj) { const u32x4 a = ga[m][bj], b = gb[m][bj]; f32x4 s0, s1;
                    s0[0] = sigm(bf_lo(a.x)) * (1.0f + __expf(-bf_lo(b.x))); s0[1] = sigm(bf_hi(a.x)) * (1.0f + __expf(-bf_hi(b.x)));
                    s0[2] = sigm(bf_lo(a.y)) * (1.0f + __expf(-bf_lo(b.y))); s0[3] = sigm(bf_hi(a.y)) * (1.0f + __expf(-bf_hi(b.y)));
                    s1[0] = sigm(bf_lo(a.z)) * (1.0f + __expf(-bf_lo(b.z))); s1[1] = sigm(bf_hi(a.z)) * (1.0f + __expf(-bf_hi(b.z)));
                    s1[2] = sigm(bf_lo(a.w)) * (1.0f + __expf(-bf_lo(b.w))); s1[3] = sigm(bf_hi(a.w)) * (1.0f + __expf(-bf_hi(b.w)));
                    acc[ai][bj][m][0] = acc[ai][bj][m][0] * s0; acc[ai][bj][m][1] = acc[ai][bj][m][1] * s1; }
            asm volatile("" ::: "memory"); }
    }
    __device__ __forceinline__ void operator()(const f32x4 (&acc)[2][2][4][2], const Unit& u, int wr, int wc, int fr, int fq) const {
        const int row0 = u.pm * BM + wr * 64 + fr, col0 = u.pn * BM + wc * 32 + 8 * fq;
#pragma unroll
        for (int ai = 0; ai < 2; ++ai) {
            u32x4 gb[4][2];
#pragma unroll
            for (int m = 0; m < 4; ++m) { const bf16_t* gp = gate + (size_t)(row0 + ai * HALF + m * 16) * ldg + col0 + gboff;
#pragma unroll
                for (int bj = 0; bj < 2; ++bj) gb[m][bj] = *(const u32x4*)(gp + bj * HALF); }
#pragma unroll
            for (int m = 0; m < 4; ++m) { bf16_t* op = O + (size_t)(row0 + ai * HALF + m * 16) * ldc + col0;
#pragma unroll
                for (int bj = 0; bj < 2; ++bj) { const u32x4 b = gb[m][bj]; const f32x4 a0 = acc[ai][bj][m][0], a1 = acc[ai][bj][m][1];
                    u32x4 w; w.x = cvt_pk_bf16(a0[0] * sigm(bf_lo(b.x)), a0[1] * sigm(bf_hi(b.x))); w.y = cvt_pk_bf16(a0[2] * sigm(bf_lo(b.y)), a0[3] * sigm(bf_hi(b.y)));
                    w.z = cvt_pk_bf16(a1[0] * sigm(bf_lo(b.z)), a1[1] * sigm(bf_hi(b.z))); w.w = cvt_pk_bf16(a1[2] * sigm(bf_lo(b.w)), a1[3] * sigm(bf_hi(b.w)));
                    *(u32x4*)(op + bj * HALF) = w; } }
            asm volatile("" ::: "memory"); }
    }
};
struct EpiRes {
    static constexpr bool PERM = true, AFTER_DRAIN = false, MID = false;
    const float* base; bf16_t* out; int ldc; const float* gvec; int bpitch; int rows_per_batch; float* ssq;
    __device__ __forceinline__ void operator()(const f32x4 (&acc)[2][2][4][2], const Unit& u, int wr, int wc, int fr, int fq) const {
        const int row0 = u.pm * BM + wr * 64 + fr, col0 = u.pn * BM + wc * 32 + 8 * fq;
        const float* gb = gvec + (size_t)((u.pm * BM) / rows_per_batch) * bpitch + col0;
        f32x4 gv[2][2];
#pragma unroll
        for (int bj = 0; bj < 2; ++bj)
#pragma unroll
            for (int n = 0; n < 2; ++n) gv[bj][n] = *(const f32x4*)(gb + bj * HALF + n * 4);
#pragma unroll
        for (int ai = 0; ai < 2; ++ai) {
            f32x4 bs[4][2][2];
#pragma unroll
            for (int m = 0; m < 4; ++m) { const size_t off = (size_t)(row0 + ai * HALF + m * 16) * ldc + col0;
#pragma unroll
                for (int bj = 0; bj < 2; ++bj)
#pragma unroll
                    for (int n = 0; n < 2; ++n) bs[m][bj][n] = *(const f32x4*)(base + off + bj * HALF + n * 4); }
#pragma unroll
            for (int m = 0; m < 4; ++m) { const size_t off = (size_t)(row0 + ai * HALF + m * 16) * ldc + col0; float sq = 0.f;
#pragma unroll
                for (int bj = 0; bj < 2; ++bj) { const f32x4 o0 = bs[m][bj][0] + gv[bj][0] * acc[ai][bj][m][0], o1 = bs[m][bj][1] + gv[bj][1] * acc[ai][bj][m][1];
                    u32x4 w; w.x = cvt_pk_bf16(o0[0], o0[1]); w.y = cvt_pk_bf16(o0[2], o0[3]); w.z = cvt_pk_bf16(o1[0], o1[1]); w.w = cvt_pk_bf16(o1[2], o1[3]);
                    *(u32x4*)(out + off + bj * HALF) = w;
                    sq += ((o0[0] * o0[0] + o0[1] * o0[1]) + (o0[2] * o0[2] + o0[3] * o0[3])) + ((o1[0] * o1[0] + o1[1] * o1[1]) + (o1[2] * o1[2] + o1[3] * o1[3])); }
                sq += __shfl_xor(sq, 16); sq += __shfl_xor(sq, 32);
                if (fq == 0) ssq[(size_t)(row0 + ai * HALF + m * 16) * 32 + 4 * u.pn + wc] = sq; }
            asm volatile("" ::: "memory"); }
    }
};
struct EpiSwiglu {
    static constexpr bool PERM = true, AFTER_DRAIN = false, MID = false;
    bf16_t* O; int ldc; const float* bias; int de;
    __device__ __forceinline__ void operator()(const f32x4 (&acc)[2][2][4][2], const Unit& u, int wr, int wc, int fr, int fq) const {
        const int row0 = u.pm * BM + wr * 64 + fr, cl = u.pn * HALF + wc * 32 + 8 * fq;
        const float* bb = bias + (size_t)u.e * 2 * de + cl;
        f32x4 bg[2], bl[2];
#pragma unroll
        for (int n = 0; n < 2; ++n) { bg[n] = *(const f32x4*)(bb + 4 * n); bl[n] = *(const f32x4*)(bb + de + 4 * n); }
#pragma unroll
        for (int ai = 0; ai < 2; ++ai)
#pragma unroll
            for (int m = 0; m < 4; ++m) { bf16_t* rowp = O + (size_t)(row0 + ai * HALF + m * 16) * ldc + cl;
                f32x4 a[2];
#pragma unroll
                for (int n = 0; n < 2; ++n) { const f32x4 g = acc[ai][0][m][n] + bg[n], l = acc[ai][1][m][n] + bl[n];
#pragma unroll
                    for (int j = 0; j < 4; ++j) { const float gg = fminf(g[j], 7.0f), ll = fminf(fmaxf(l[j], -7.0f), 7.0f); a[n][j] = gg * sigm(1.702f * gg) * (ll + 1.0f); } }
                u32x4 w; w.x = cvt_pk_bf16(a[0][0], a[0][1]); w.y = cvt_pk_bf16(a[0][2], a[0][3]); w.z = cvt_pk_bf16(a[1][0], a[1][1]); w.w = cvt_pk_bf16(a[1][2], a[1][3]);
                *(u32x4*)rowp = w; }
    }
};
__device__ __forceinline__ float clamp448(float v) { return fminf(fmaxf(v, -448.0f), 448.0f); }
struct EpiSwigluF8 {
    static constexpr bool PERM = true, AFTER_DRAIN = false, MID = false;
    unsigned char* O; int ldc; const float* bias; int de; float ascale, oscale;
    __device__ __forceinline__ void operator()(const f32x4 (&acc)[2][2][4][2], const Unit& u, int wr, int wc, int fr, int fq) const {
        const int row0 = u.pm * BM + wr * 64 + fr, cl = u.pn * HALF + wc * 32 + 8 * fq;
        const float* bb = bias + (size_t)u.e * 2 * de + cl;
        f32x4 bg[2], bl[2];
#pragma unroll
        for (int n = 0; n < 2; ++n) { bg[n] = *(const f32x4*)(bb + 4 * n); bl[n] = *(const f32x4*)(bb + de + 4 * n); }
#pragma unroll
        for (int ai = 0; ai < 2; ++ai)
#pragma unroll
            for (int m = 0; m < 4; ++m) { unsigned char* rowp = O + (size_t)(row0 + ai * HALF + m * 16) * ldc + cl;
                f32x4 a[2];
#pragma unroll
                for (int n = 0; n < 2; ++n) { const f32x4 g = acc[ai][0][m][n] * ascale + bg[n], l = acc[ai][1][m][n] * ascale + bl[n];
                    f32x4 gg, ll, ex, rc;
#pragma unroll
                    for (int j = 0; j < 4; ++j) { gg[j] = fminf(g[j], 7.0f); ll[j] = __builtin_amdgcn_fmed3f(l[j], -7.0f, 7.0f); }
                    const f32x4 t = gg * (-1.702f * 1.44269504089f);
#pragma unroll
                    for (int j = 0; j < 4; ++j) ex[j] = __builtin_amdgcn_exp2f(t[j]);
                    const f32x4 d = ex + 1.0f;
#pragma unroll
                    for (int j = 0; j < 4; ++j) rc[j] = __builtin_amdgcn_rcpf(d[j]);
                    a[n] = (gg * rc) * (ll * oscale + oscale); }
                int w0 = 0, w1 = 0;
                w0 = __builtin_amdgcn_cvt_pk_fp8_f32(a[0][0], a[0][1], w0, false); w0 = __builtin_amdgcn_cvt_pk_fp8_f32(a[0][2], a[0][3], w0, true);
                w1 = __builtin_amdgcn_cvt_pk_fp8_f32(a[1][0], a[1][1], w1, false); w1 = __builtin_amdgcn_cvt_pk_fp8_f32(a[1][2], a[1][3], w1, true);
                u32x2 w; w.x = (unsigned)w0; w.y = (unsigned)w1; *(u32x2*)rowp = w; }
    }
};
struct EpiDown {
    static constexpr bool PERM = true, AFTER_DRAIN = false, MID = false;
    unsigned char* O; int ldc; const float* bias; const float* sw; float ascale, oscale;
    __device__ __forceinline__ void operator()(const f32x4 (&acc)[2][2][4][2], const Unit& u, int wr, int wc, int fr, int fq) const {
        const int row0 = u.pm * BM + wr * 64 + fr, col0 = u.pn * BM + wc * 32 + 8 * fq;
        const float* bb = bias + (size_t)u.e * ldc + col0;
        f32x4 bv[2][2];
#pragma unroll
        for (int bj = 0; bj < 2; ++bj)
#pragma unroll
            for (int n = 0; n < 2; ++n) bv[bj][n] = *(const f32x4*)(bb + bj * HALF + 4 * n);
        float wq[2][4];
#pragma unroll
        for (int ai = 0; ai < 2; ++ai)
#pragma unroll
            for (int m = 0; m < 4; ++m) wq[ai][m] = sw[row0 + ai * HALF + m * 16];
        asm volatile("s_waitcnt vmcnt(0)" ::: "memory");
#pragma unroll
        for (int ai = 0; ai < 2; ++ai)
#pragma unroll
            for (int m = 0; m < 4; ++m) { const int r = row0 + ai * HALF + m * 16; const float w8 = wq[ai][m] * oscale; unsigned char* rowp = O + (size_t)r * ldc + col0;
#pragma unroll
                for (int bj = 0; bj < 2; ++bj) { f32x4 v0 = (acc[ai][bj][m][0] * ascale + bv[bj][0]) * w8, v1 = (acc[ai][bj][m][1] * ascale + bv[bj][1]) * w8;
#pragma unroll
                    for (int j = 0; j < 4; ++j) { v0[j] = __builtin_amdgcn_fmed3f(v0[j], -448.0f, 448.0f); v1[j] = __builtin_amdgcn_fmed3f(v1[j], -448.0f, 448.0f); }
                    int w0 = 0, w1 = 0;
                    w0 = __builtin_amdgcn_cvt_pk_fp8_f32(v0[0], v0[1], w0, false); w0 = __builtin_amdgcn_cvt_pk_fp8_f32(v0[2], v0[3], w0, true);
                    w1 = __builtin_amdgcn_cvt_pk_fp8_f32(v1[0], v1[1], w1, false); w1 = __builtin_amdgcn_cvt_pk_fp8_f32(v1[2], v1[3], w1, true);
                    u32x2 w; w.x = (unsigned)w0; w.y = (unsigned)w1; *(u32x2*)(rowp + bj * HALF) = w; } }
    }
};
struct EpiNull {
    static constexpr bool PERM = false, AFTER_DRAIN = false, MID = false;
    float* dummy;
    __device__ __forceinline__ void operator()(const f32x4 (&acc)[2][2][4][2], const Unit& u, int wr, int wc, int fr, int fq) const {
        f32x4 s = (f32x4){0.f, 0.f, 0.f, 0.f};
#pragma unroll
        for (int ai = 0; ai < 2; ++ai)
#pragma unroll
            for (int bj = 0; bj < 2; ++bj)
#pragma unroll
                for (int m = 0; m < 4; ++m)
#pragma unroll
                    for (int n = 0; n < 2; ++n) s = s + acc[ai][bj][m][n];
        const float t = (s[0] + s[1]) + (s[2] + s[3]);
        if (t == 123456.789f) dummy[u.pm * 64 + u.pn] = t;
    }
};
struct PairOrder : StaticOrder {
    static constexpr bool PAIRS = true;
    __device__ bool next(int i, Unit& u) const { if (!StaticOrder::next(i >> 1, u)) return false; u.kh = i & 1; return true; }
};
struct FixedOrder : StaticOrder {
    static constexpr bool PAIRS = false;
    __device__ bool next(int i, Unit& u) const { if (i >= 2) return false; u.pm = 0; u.pn = 0; u.e = 0; u.kh = 0; return true; }
};
struct GroupedOrder : StaticOrder {
    static constexpr bool PAIRS = false;
    const int* tile_e;
    __device__ bool next(int i, Unit& u) const { if (!StaticOrder::next(i, u)) return false; u.e = tile_e[u.pm]; return true; }
};
template <class Epi, class Sched, bool ALIGN_EPI = false, bool SP2 = false, bool GATHER = false, bool F8 = false>
__device__ __forceinline__ void gemm_phase(PG8_LAS unsigned char* lds, const Gemm g, const Sched& S, const Epi& E) {
    const int tid = threadIdx.x, wid = __builtin_amdgcn_readfirstlane(tid >> 6), lane = tid & 63, wr = wid >> 2, wc = wid & 3, fr = lane & 15, fq = lane >> 4;
    const int K = g.K, nt = K / BK;
    unsigned voffA[2], voffB[2];
#pragma unroll
    for (int i = 0; i < 2; ++i) { int R, C; stage_rc(tid * 16 + i * 8192, R, C); const int Rb = Epi::PERM ? ((R & ~31) + perm32(R & 31)) : R;
        voffA[i] = (unsigned)(R * K + C) * 2u; voffB[i] = (unsigned)(Rb * K + C) * 2u; }
    static_assert(SP2 || !GATHER, "the gathered-A path is written for the SP2 loop only");
    unsigned gc0[2] = {0u, 0u}, gc1[2] = {0u, 0u}, gn0[2] = {0u, 0u}, gn1[2] = {0u, 0u};
    auto load_gather = [&](const Unit& u, unsigned (&o0)[2], unsigned (&o1)[2]) {
#pragma unroll
        for (int i = 0; i < 2; ++i) { int R, C; stage_rc(tid * 16 + i * 8192, R, C); const int t0 = g.gather[u.pm * BM + R], t1 = g.gather[u.pm * BM + HALF + R];
            o0[i] = (unsigned)(t0 * K + C) * 2u; o1[i] = (unsigned)(t1 * K + C) * 2u; } };
    const size_t kstep = (size_t)(BK * 2);
    const size_t hstep = (size_t)HALF * K * 2;
    const size_t tstep = 2 * hstep;
    const unsigned ldsw = (unsigned)wid * 1024u;
    const int aoff = lds_byte(wr * 64 + fr, F8 ? fq * 16 : fq * 8), boff = lds_byte(wc * 32 + fr, F8 ? fq * 16 : fq * 8);
    const int sc1 = 0x7f7f7f7f;
    constexpr int KFR = F8 ? 16 : 1024;
#define PG8_SA(b, h) (((b) * 2 + (h)) * HTB)
#define PG8_SB(b, h) ((4 + (b) * 2 + (h)) * HTB)
#define PG8_STAGE(bufoff, gbase, voff) do { _Pragma("unroll") for (int _i = 0; _i < 2; ++_i) \
        __builtin_amdgcn_global_load_lds((const unsigned*)((const char*)(gbase) + (voff)[_i]), (PG8_LAS unsigned*)(lds + (bufoff) + ldsw + _i * 8192), 16, 0, 0); } while (0)
#define PG8_STAGE_A(bufoff, gbase, hh, nx) do { if constexpr (GATHER) { _Pragma("unroll") for (int _i = 0; _i < 2; ++_i) { const unsigned _o = (nx) ? ((hh) ? gn1[_i] : gn0[_i]) : ((hh) ? gc1[_i] : gc0[_i]); \
        __builtin_amdgcn_global_load_lds((const unsigned*)((const char*)(gbase) + _o), (PG8_LAS unsigned*)(lds + (bufoff) + ldsw + _i * 8192), 16, 0, 0); } } \
        else { PG8_STAGE(bufoff, (gbase) + ((hh) ? hstep : 0), voffA); } } while (0)
#define PG8_LDA(dst, b, h) do { _Pragma("unroll") for (int m = 0; m < 4; ++m) _Pragma("unroll") for (int k = 0; k < 2; ++k) dst[m][k] = *(const PG8_LAS bf16x8*)(lds + PG8_SA(b, h) + aoff + m * 2048 + k * KFR); } while (0)
#define PG8_LDB(dst, b, h) do { _Pragma("unroll") for (int n = 0; n < 2; ++n) _Pragma("unroll") for (int k = 0; k < 2; ++k) dst[n][k] = *(const PG8_LAS bf16x8*)(lds + PG8_SB(b, h) + boff + n * 2048 + k * KFR); } while (0)
#define PG8_V8(x) __builtin_shufflevector(__builtin_bit_cast(i32x4_t, (x)[0]), __builtin_bit_cast(i32x4_t, (x)[1]), 0, 1, 2, 3, 4, 5, 6, 7)
#define PG8_MMA(ai, bj, At, Bt) do { __builtin_amdgcn_s_setprio(1); if constexpr (F8) { _Pragma("unroll") for (int m = 0; m < 4; ++m) _Pragma("unroll") for (int n = 0; n < 2; ++n) \
        asm volatile("v_mfma_scale_f32_16x16x128_f8f6f4 %0, %1, %2, %0, %3, %3 op_sel_hi:[0,0,0]" : "+v"(acc[ai][bj][m][n]) : "v"(PG8_V8(Bt[n])), "v"(PG8_V8(At[m])), "v"(sc1)); } else { \
        _Pragma("unroll") for (int m = 0; m < 4; ++m) _Pragma("unroll") for (int n = 0; n < 2; ++n) _Pragma("unroll") for (int k = 0; k < 2; ++k) \
        acc[ai][bj][m][n] = __builtin_amdgcn_mfma_f32_16x16x32_bf16(Bt[n][k], At[m][k], acc[ai][bj][m][n], 0, 0, 0); } __builtin_amdgcn_s_setprio(0); } while (0)
#define PG8_WAIT_V(n) asm volatile("s_waitcnt vmcnt(" #n ")" ::: "memory")
#define PG8_WAIT_L(n) asm volatile("s_waitcnt lgkmcnt(" #n ")" ::: "memory")
#define PG8_BAR __builtin_amdgcn_s_barrier()
#define PG8_SCHED __builtin_amdgcn_sched_barrier(0)
    Unit cur, nxt; int ui = 0;
    if (!S.next(0, cur)) return;
    f32x4 acc[2][2][4][2];
#pragma unroll
    for (int a = 0; a < 2; ++a)
#pragma unroll
        for (int b = 0; b < 2; ++b)
#pragma unroll
            for (int m = 0; m < 4; ++m)
#pragma unroll
                for (int n = 0; n < 2; ++n) acc[a][b][m][n] = (f32x4){0.f, 0.f, 0.f, 0.f};
    bf16x8 At[4][2], B0[2][2], B1[2][2];
    const char* cA = (const char*)((Sched::PAIRS && cur.kh) ? g.A2 : g.A) + (GATHER ? (size_t)0 : (size_t)cur.pm * tstep); const char* cB = (const char*)((Sched::PAIRS && cur.kh) ? g.Bt2 : g.Bt) + (size_t)cur.e * g.bgs + (size_t)cur.pn * tstep;
    S.a_ready(cur);
    if constexpr (GATHER) load_gather(cur, gc0, gc1);
    if constexpr (SP2) {
        PG8_STAGE(PG8_SB(0, 0), cB, voffB); PG8_STAGE(PG8_SB(0, 1), cB + hstep, voffB); PG8_STAGE_A(PG8_SA(0, 0), cA, 0, false); PG8_STAGE_A(PG8_SA(0, 1), cA, 1, false);
        if (wr == 1) PG8_BAR;
        PG8_WAIT_V(2); PG8_BAR;
        PG8_STAGE(PG8_SB(1, 0), cB + kstep, voffB); PG8_STAGE_A(PG8_SA(1, 0), cA + kstep, 0, false); PG8_STAGE(PG8_SB(1, 1), cB + hstep + kstep, voffB);
        PG8_WAIT_V(6); PG8_BAR;
    } else {
        PG8_STAGE(PG8_SB(0, 0), cB, voffB); PG8_STAGE(PG8_SA(0, 0), cA, voffA); PG8_STAGE(PG8_SB(0, 1), cB + hstep, voffB); PG8_STAGE(PG8_SA(0, 1), cA + hstep, voffA);
        if (wr == 1) PG8_BAR;
        PG8_WAIT_V(4); PG8_BAR;
        PG8_STAGE(PG8_SB(1, 0), cB + kstep, voffB); PG8_STAGE(PG8_SA(1, 0), cA + kstep, voffA); PG8_STAGE(PG8_SB(1, 1), cB + hstep + kstep, voffB);
        PG8_WAIT_V(6); PG8_BAR;
    }
    for (;;) {
        const bool has_next = S.next(ui + 1, nxt);
        const char* nA = has_next ? (const char*)((Sched::PAIRS && nxt.kh) ? g.A2 : g.A) + (GATHER ? (size_t)0 : (size_t)nxt.pm * tstep) : cA;
        if constexpr (GATHER) { if (has_next) load_gather(nxt, gn0, gn1); else { gn0[0] = gc0[0]; gn0[1] = gc0[1]; gn1[0] = gc1[0]; gn1[1] = gc1[1]; } } const char* nB = has_next ? (const char*)((Sched::PAIRS && nxt.kh) ? g.Bt2 : g.Bt) + (size_t)nxt.e * g.bgs + (size_t)nxt.pn * tstep : cB;
        for (int t = 0; t < nt; t += 2) {
            const bool last = (t == nt - 2);
            const char* a1 = cA + (size_t)(t + 1) * kstep;
            const char* a2 = last ? nA : cA + (size_t)(t + 2) * kstep; const char* b2 = last ? nB : cB + (size_t)(t + 2) * kstep;
            const char* a3 = a2 + kstep; const char* b3 = b2 + kstep;
            if (last && has_next) S.a_ready(nxt);
            if constexpr (SP2) {
            PG8_LDB(B0, 0, 0); PG8_LDB(B1, 0, 1); PG8_SCHED; PG8_LDA(At, 0, 0); PG8_STAGE_A(PG8_SA(1, 1), a1, 1, false);
            PG8_WAIT_V(8); PG8_WAIT_L(0); PG8_BAR; PG8_MMA(0, 0, At, B0); PG8_MMA(0, 1, At, B1); PG8_BAR; PG8_SCHED;
            PG8_LDA(At, 0, 1); PG8_STAGE(PG8_SB(0, 0), b2, voffB); PG8_STAGE(PG8_SB(0, 1), b2 + hstep, voffB); PG8_STAGE_A(PG8_SA(0, 0), a2, 0, last);
            PG8_WAIT_V(8); PG8_WAIT_L(0); PG8_BAR; PG8_MMA(1, 0, At, B0); PG8_MMA(1, 1, At, B1); PG8_BAR; PG8_SCHED;
            PG8_LDB(B0, 1, 0); PG8_LDB(B1, 1, 1); PG8_SCHED; PG8_LDA(At, 1, 0); PG8_STAGE_A(PG8_SA(0, 1), a2, 1, last);
            PG8_WAIT_V(8); PG8_WAIT_L(0); PG8_BAR; PG8_MMA(0, 0, At, B0); PG8_MMA(0, 1, At, B1); PG8_BAR; PG8_SCHED;
            PG8_LDA(At, 1, 1); PG8_STAGE(PG8_SB(1, 0), b3, voffB); PG8_STAGE(PG8_SB(1, 1), b3 + hstep, voffB); PG8_STAGE_A(PG8_SA(1, 0), a3, 0, last);
            PG8_WAIT_V(8); PG8_WAIT_L(0); PG8_BAR; PG8_MMA(1, 0, At, B0); PG8_MMA(1, 1, At, B1); PG8_BAR; PG8_SCHED;
            } else {
            PG8_LDB(B0, 0, 0); PG8_SCHED; PG8_LDA(At, 0, 0); PG8_STAGE(PG8_SA(1, 1), a1 + hstep, voffA);
            PG8_WAIT_L(8); PG8_BAR; PG8_WAIT_L(0); PG8_MMA(0, 0, At, B0); PG8_BAR; PG8_SCHED;
            PG8_LDB(B1, 0, 1); PG8_STAGE(PG8_SB(0, 0), b2, voffB);
            PG8_BAR; PG8_WAIT_L(0); PG8_MMA(0, 1, At, B1); PG8_BAR;
            PG8_LDA(At, 0, 1); PG8_STAGE(PG8_SA(0, 0), a2, voffA);
            PG8_BAR; PG8_WAIT_L(0); PG8_MMA(1, 0, At, B0); PG8_BAR; PG8_SCHED;
            PG8_STAGE(PG8_SB(0, 1), b2 + hstep, voffB);
            PG8_WAIT_V(6); PG8_BAR; PG8_MMA(1, 1, At, B1); PG8_BAR;
            PG8_LDB(B0, 1, 0); PG8_SCHED; PG8_LDA(At, 1, 0); PG8_STAGE(PG8_SA(0, 1), a2 + hstep, voffA);
            PG8_WAIT_L(8); PG8_BAR; PG8_WAIT_L(0); PG8_MMA(0, 0, At, B0); PG8_BAR; PG8_SCHED;
            PG8_LDB(B1, 1, 1); PG8_STAGE(PG8_SB(1, 0), b3, voffB);
            PG8_BAR; PG8_WAIT_L(0); PG8_MMA(0, 1, At, B1); PG8_BAR;
            PG8_LDA(At, 1, 1); PG8_STAGE(PG8_SA(1, 0), a3, voffA);
            PG8_BAR; PG8_WAIT_L(0); PG8_MMA(1, 0, At, B0); PG8_BAR; PG8_SCHED;
            PG8_STAGE(PG8_SB(1, 1), b3 + hstep, voffB);
            PG8_WAIT_V(6); PG8_BAR; PG8_MMA(1, 1, At, B1); PG8_BAR;
            }
        }
        if constexpr (ALIGN_EPI) { if (wr == 0) PG8_BAR; }
        if constexpr (!Epi::AFTER_DRAIN) { if constexpr (Epi::MID) { if (cur.kh == 0) E.mid(acc, cur, wr, wc, fr, fq); else E(acc, cur, wr, wc, fr, fq); } else E(acc, cur, wr, wc, fr, fq); S.done(cur); }
        if (!has_next) break;
        if (!(Epi::MID && cur.kh == 0)) {
#pragma unroll
        for (int a = 0; a < 2; ++a)
#pragma unroll
            for (int b = 0; b < 2; ++b)
#pragma unroll
                for (int m = 0; m < 4; ++m)
#pragma unroll
                    for (int n = 0; n < 2; ++n) acc[a][b][m][n] = (f32x4){0.f, 0.f, 0.f, 0.f}; }
        cur = nxt; cA = nA; cB = nB; ++ui;
        if constexpr (GATHER) { gc0[0] = gn0[0]; gc0[1] = gn0[1]; gc1[0] = gn1[0]; gc1[1] = gn1[1]; }
        if constexpr (ALIGN_EPI) { if (wr == 1) PG8_BAR; }
    }
    PG8_WAIT_V(0);
    if constexpr (!ALIGN_EPI) { if (wr == 0) PG8_BAR; }
    PG8_BAR;
    if constexpr (Epi::AFTER_DRAIN) { E.fused(acc, cur, wr, wc, fr, fq, lds, wid, lane); S.done(cur); }
#undef PG8_SA
#undef PG8_SB
#undef PG8_STAGE
#undef PG8_STAGE_A
#undef PG8_LDA
#undef PG8_LDB
#undef PG8_MMA
#undef PG8_V8
#undef PG8_WAIT_V
#undef PG8_WAIT_L
#undef PG8_BAR
#undef PG8_SCHED
}
}

#ifndef PG8_SP2
#define PG8_SP2 true
#endif
#ifndef PG8_ALIGN
#define PG8_ALIGN true
#endif
constexpr int NWAVES = 8;
#ifndef MK_N_LAUNCHES
#define MK_N_LAUNCHES 1
#endif
constexpr int N_PHASES = 14;
constexpr int N_LAUNCHES = MK_N_LAUNCHES;

constexpr int D = 2048, NB = 8, SEQ = 2048, M = NB * SEQ;
constexpr int RW = 1024, RNH = 16;
constexpr int RWKV_COLS = 3360, HG_BASE = 3584, GATE_BASE = 7680, NPROJ = 11776;
constexpr int IN_COLS = 11552;
constexpr int HNH = 8;
constexpr int NE = 32, DE = 2048, NASSIGN = M * 4;
constexpr int LORA_K = 384, LORA_N = 3072;
constexpr int MAXTILES = 288, MAXSLOTS = MAXTILES * 256;
constexpr float NORM_EPS = 1e-5f, GN_EPS = 64e-5f;

constexpr size_t MiB = 1u << 20;
constexpr size_t WS_CTL = 0, CTL_ZERO_BYTES = 32768;
constexpr size_t WS_MODP = 2 * MiB;
constexpr size_t WS_MOD = 8 * MiB;
constexpr size_t WS_RWP = 9 * MiB;
constexpr size_t WS_ROUTE = 10 * MiB;
constexpr size_t WS_WLORA = 14 * MiB;
constexpr size_t WS_WIN = 18 * MiB;
constexpr size_t WS_WPA = 64 * MiB, WS_WPB = 68 * MiB, WS_WOUT = 72 * MiB;
constexpr size_t WS_WGU = 80 * MiB;
constexpr size_t WS_WDN = 592 * MiB;
constexpr size_t WS_H = 848 * MiB;
constexpr size_t WS_PROJ = 912 * MiB;
constexpr size_t WS_LORA_A = 1280 * MiB;
constexpr size_t WS_LORA_O = 1292 * MiB;
constexpr size_t WS_YA = 1484 * MiB, WS_YB = 1516 * MiB;
constexpr size_t WS_OHG = 1548 * MiB;
constexpr size_t WS_T1 = 1612 * MiB;
constexpr size_t WS_MERGED = 1740 * MiB;
constexpr size_t WS_X1 = 1804 * MiB;
constexpr size_t WS_XG = 1932 * MiB;
constexpr size_t WS_ACT = 2220 * MiB;
constexpr size_t WS_YE = 2508 * MiB;
constexpr size_t WS_END = 2796 * MiB;
constexpr size_t RT_E = 0, RT_RANK = 262144, RT_GATE = 524288, RT_TOKSLOT = 786432, RT_SLOTW = 1048576, RT_TILEE = 1048576 + 524288, RT_SLOTTOK = 2097152;
constexpr int CW_TMO = 0, CW_CODE = 1;
constexpr int CW_CNT = 64;
constexpr int CW_BAR = 4096;
constexpr int LDS_BYTES = 147456;
constexpr int MISC_OFF = LDS_BYTES - 256;
constexpr int SCR_BYTES = MISC_OFF;

#define GAS __attribute__((address_space(1)))
#define LAS __attribute__((address_space(3)))
typedef unsigned short bf16;
typedef unsigned v4u __attribute__((ext_vector_type(4)));
typedef unsigned v2u __attribute__((ext_vector_type(2)));
typedef float f32x4 __attribute__((ext_vector_type(4)));
typedef float f32x2 __attribute__((ext_vector_type(2)));
typedef GAS unsigned gu32;
#define RLX_AGENT __ATOMIC_RELAXED, __HIP_MEMORY_SCOPE_AGENT
#define LDS_WAIT() asm volatile("s_waitcnt lgkmcnt(0)" ::: "memory")
#define VM_WAIT() asm volatile("s_waitcnt vmcnt(0)" ::: "memory")
typedef __bf16 bf16x2_hw __attribute__((ext_vector_type(2)));
__device__ __forceinline__ unsigned pk2(float lo, float hi) { const f32x2 v = {lo, hi}; const bf16x2_hw r = __builtin_convertvector(v, bf16x2_hw); return __builtin_bit_cast(unsigned, r); }
__device__ __forceinline__ unsigned f2bf(float f) { return pk2(f, f) & 0xffffu; }
__device__ __forceinline__ float bf2f(unsigned short h) { return __uint_as_float(((unsigned)h) << 16); }
__device__ __forceinline__ float bflo(unsigned w) { return __uint_as_float(w << 16); }
__device__ __forceinline__ float bfhi(unsigned w) { return __uint_as_float(w & 0xffff0000u); }
__device__ __forceinline__ float sigmoidf_(float x) { return __builtin_amdgcn_rcpf(1.0f + __expf(-x)); }

#define XB_TMO      128
#define XB_XCNT(j)  (256  + 64 * (j))
#define XB_XSUB(j)  (1280 + 64 * (j))
#define XB_XGEN(j)  (2304 + 64 * (j))
#define XB_TOP      3328
#define XB_TOPGEN   3392
#define XCD_BAR_WORDS 3456
#define XB_SPIN_CAP (1u << 18)
__device__ __forceinline__ unsigned xb_ld(unsigned* p)              { return __hip_atomic_load(p, __ATOMIC_RELAXED, __HIP_MEMORY_SCOPE_AGENT); }
__device__ __forceinline__ unsigned xb_add(unsigned* p, unsigned v) { return __hip_atomic_fetch_add(p, v, __ATOMIC_RELAXED, __HIP_MEMORY_SCOPE_AGENT); }
__device__ __forceinline__ unsigned xb_xcc_id() { return (unsigned)__builtin_amdgcn_s_getreg((3 << 11) | 20) & 0xFu; }
#define XB_SPIN(cond, bar) do { unsigned _sp = 0; while (cond) { __builtin_amdgcn_s_sleep(1); \
    if ((++_sp & 255u) == 0u) { if (xb_ld(&(bar)[XB_TMO])) break; if (_sp > XB_SPIN_CAP) { atomicAdd(&(bar)[XB_TMO], 1u); break; } } } } while (0)
struct XcdBarrier { unsigned* bar; unsigned x; volatile LAS unsigned* st; };
__device__ __forceinline__ XcdBarrier xcd_barrier_post(unsigned* bar, volatile LAS unsigned* st) {
    XcdBarrier b; b.bar = bar; b.x = xb_xcc_id(); b.st = st;
    if (threadIdx.x == 0) (void)xb_add(&bar[XB_XCNT(b.x)], 1u);
    return b;
}
__device__ __forceinline__ void xcd_barrier_complete(unsigned* bar, unsigned x, unsigned& nloc, unsigned& nx) {
    const unsigned G = gridDim.x * gridDim.y * gridDim.z;
    unsigned sum, cnt, mine, sp = 0u;
    for (;;) {
        sum = 0u; cnt = 0u; mine = 0u;
#pragma unroll
        for (unsigned j = 0; j < 16; ++j) { const unsigned c = xb_ld(&bar[XB_XCNT(j)]); sum += c; cnt += (c > 0u) ? 1u : 0u; mine = (j == x) ? c : mine; }
        if (sum == G) break;
        __builtin_amdgcn_s_sleep(1);
        if ((++sp & 255u) == 0u) { if (xb_ld(&bar[XB_TMO])) break; if (sp > XB_SPIN_CAP) { atomicAdd(&bar[XB_TMO], 1u); break; } }
    }
    nloc = mine > 0u ? mine : 1u; nx = cnt > 0u ? cnt : 1u;
}
__device__ __forceinline__ void xcd_barrier(const XcdBarrier& b) {
    asm volatile("s_waitcnt vmcnt(0)" ::: "memory");
    __syncthreads();
    if (threadIdx.x == 0) {
        unsigned* bar = b.bar;
        __builtin_amdgcn_s_waitcnt(0);
        unsigned nloc = b.st[0], nx = b.st[1];
        if (nloc == 0u) { xcd_barrier_complete(bar, b.x, nloc, nx); b.st[0] = nloc; b.st[1] = nx; }
        const unsigned old = xb_add(&bar[XB_XSUB(b.x)], 1u);
        const unsigned gen = old / nloc;
        if (old + 1u == (gen + 1u) * nloc) {
            __builtin_amdgcn_fence(__ATOMIC_RELEASE, "agent");
            asm volatile("s_waitcnt vmcnt(0)" ::: "memory");
            const unsigned og = xb_add(&bar[XB_TOP], 1u);
            const unsigned tg = og / nx;
            if (og + 1u == (tg + 1u) * nx) xb_add(&bar[XB_TOPGEN], 1u);
            else XB_SPIN(xb_ld(&bar[XB_TOPGEN]) == tg, bar);
            __builtin_amdgcn_fence(__ATOMIC_ACQUIRE, "agent");
            xb_add(&bar[XB_XGEN(b.x)], 1u);
            asm volatile("s_waitcnt vmcnt(0)" ::: "memory");
        } else {
            XB_SPIN(xb_ld(&bar[XB_XGEN(b.x)]) == gen, bar);
            __builtin_amdgcn_fence(__ATOMIC_ACQUIRE, "agent");
            asm volatile("s_waitcnt vmcnt(0)" ::: "memory");
        }
    }
    __syncthreads();
}

struct Args { const float* in[30]; float* out; unsigned char* ws; int ph_lo, ph_hi, li, pad; };
struct Frame {
    LAS unsigned char* lds;
    volatile LAS unsigned* MISC;
    gu32* ctl;
    unsigned char* ws;
    int tid, lane, wave;
    int vcu, G;
};
__device__ __forceinline__ float wave_sum(float v) {
#pragma unroll
    for (int o = 1; o < 64; o <<= 1) v += __shfl_xor(v, o);
    return v;
}
template <int CTRL> __device__ __forceinline__ float dpp_mov(float v) { return __builtin_bit_cast(float, __builtin_amdgcn_update_dpp(0, __builtin_bit_cast(int, v), CTRL, 0xf, 0xf, false)); }
__device__ __forceinline__ float red8(float v) {
    v += dpp_mov<0xB1>(v);
    v += dpp_mov<0x4E>(v);
    v += dpp_mov<0x141>(v);
    return v;
}

struct TItem { const float* src; bf16* dst; int N, Kd; };
constexpr int P0_I_IN = 32 * (IN_COLS / 32), P0_I_PA = 16 * 64, P0_I_OUT = 32 * 64;
constexpr int P0_NITEMS = P0_I_IN + 2 * P0_I_PA + P0_I_OUT;
__device__ __forceinline__ TItem p0_decode(const Args& args, unsigned char* ws, int it) {
    TItem t; int r = it;
    if (r < P0_I_IN) { const int nblk = IN_COLS / 32, kb = r / nblk, nb = r % nblk, n0 = nb * 32; const int dr = n0 + (n0 >= RWKV_COLS ? (HG_BASE - RWKV_COLS) : 0);
        t.src = args.in[6] + (size_t)(kb * 64) * IN_COLS + n0; t.N = IN_COLS; t.dst = (bf16*)(ws + WS_WIN) + (size_t)dr * D + kb * 64; t.Kd = D; return t; }
    r -= P0_I_IN;
    if (r < P0_I_PA) { const int kb = r / 64, nb = r % 64; t.src = args.in[20] + (size_t)(kb * 64) * D + nb * 32; t.N = D; t.dst = (bf16*)(ws + WS_WPA) + (size_t)(nb * 32) * RW + kb * 64; t.Kd = RW; return t; }
    r -= P0_I_PA;
    if (r < P0_I_PA) { const int kb = r / 64, nb = r % 64; t.src = args.in[21] + (size_t)(kb * 64) * D + nb * 32; t.N = D; t.dst = (bf16*)(ws + WS_WPB) + (size_t)(nb * 32) * RW + kb * 64; t.Kd = RW; return t; }
    r -= P0_I_PA;
    if (r < P0_I_OUT) { const int kb = r / 64, nb = r % 64; t.src = args.in[22] + (size_t)(kb * 64) * D + nb * 32; t.N = D; t.dst = (bf16*)(ws + WS_WOUT) + (size_t)(nb * 32) * D + kb * 64; t.Kd = D; return t; }
    t.src = nullptr; t.dst = nullptr; t.N = 0; t.Kd = 0; return t;
}
__device__ __forceinline__ void p0_issue(const TItem& t, f32x4 (&v)[8], int lane) {
    const GAS f32x4* src = (const GAS f32x4*)((const GAS float*)t.src + (size_t)(lane >> 3) * t.N + 4 * (lane & 7));
#pragma unroll
    for (int i = 0; i < 8; ++i) v[i] = __builtin_nontemporal_load(src + (size_t)(2 * i) * t.N);
}
__device__ __forceinline__ void p0_finish(const TItem& t, const f32x4 (&v)[8], LAS float* scr, int lane) {
#pragma unroll
    for (int i = 0; i < 8; ++i) *(LAS f32x4*)(scr + (8 * i + (lane >> 3)) * 32 + (((lane & 7) ^ i) << 2)) = v[i];
    LDS_WAIT(); asm volatile("" ::: "memory");
    const int c = lane & 7;
#pragma unroll
    for (int j = 0; j < 4; ++j) { const int n = (lane >> 3) + 8 * j; const LAS float* s = scr + (8 * c) * 32 + ((((n >> 2) ^ c) << 2) | (n & 3));
        v4u o; o.x = pk2(s[0 * 32], s[1 * 32]); o.y = pk2(s[2 * 32], s[3 * 32]); o.z = pk2(s[4 * 32], s[5 * 32]); o.w = pk2(s[6 * 32], s[7 * 32]);
        *(GAS v4u*)(t.dst + (size_t)n * t.Kd + 8 * c) = o; }
    LDS_WAIT(); asm volatile("" ::: "memory");
}

__device__ __forceinline__ void p0_convert(Frame& F, const Args& args, int lo, int hi, int gw, int NGW, int nlight) {
    LAS float* scr = (LAS float*)(F.lds + F.wave * 8448);
    unsigned char* ws = F.ws;
    const int nA = NGW > nlight ? NGW - nlight : 0, nit = hi - lo, itemsA = nA * 16 < nit ? nA * 16 : nit;
    auto item_of = [&](int idx) -> int {
        if (gw >= nlight && idx < 16) { const int a = (gw - nlight) + nA * idx; return a < itemsA ? lo + a : hi + 1000000; }
        const int j = (gw >= nlight) ? idx - 16 : idx; return lo + itemsA + gw + NGW * j; };
    int idx = 0;
    while (idx < 16 && item_of(idx) >= hi + 1000000) ++idx;
    if (item_of(idx) < hi) {
        f32x4 va[8], vb[8];
        TItem ca = p0_decode(args, ws, item_of(idx)), cb = ca; p0_issue(ca, va, F.lane);
        for (;;) {
            int nx = item_of(++idx); bool has = nx < hi;
            if (has) { cb = p0_decode(args, ws, nx); p0_issue(cb, vb, F.lane); }
            p0_finish(ca, va, scr, F.lane);
            if (!has) break;
            nx = item_of(++idx); has = nx < hi;
            if (has) { ca = p0_decode(args, ws, nx); p0_issue(ca, va, F.lane); }
            p0_finish(cb, vb, scr, F.lane);
            if (!has) break;
        }
    }
}
#ifndef P0_SPLIT_PCT
#define P0_SPLIT_PCT 44
#endif
#ifndef P0_TAIL_PCT
#define P0_TAIL_PCT 6
#endif
#ifndef P0_HG_PCT
#define P0_HG_PCT 18
#endif
#ifndef P8_E0
#define P8_E0 25
#endif
constexpr int P8_GU1 = 16 * 128, P8_DN1 = 16 * 64, P8_N = P8_E0 * (P8_GU1 + P8_DN1) + (NE - P8_E0) * P8_GU1, P8_Q = (NE - P8_E0) * P8_DN1;
constexpr int P8_SPLIT = (int)((long long)P8_N * (100 - P0_SPLIT_PCT) / 100);
constexpr int P8_SPLITA = P8_SPLIT - (int)((long long)P8_N * P0_TAIL_PCT / 100);
constexpr int P8_SPLITH = P8_SPLITA - (int)((long long)P8_N * P0_HG_PCT / 100);
#ifndef P0_RW_PCT
#define P0_RW_PCT 2
#endif
constexpr int P8_SPLITR = P8_SPLITH - (int)((long long)P8_N * P0_RW_PCT / 100);
#ifndef P0_DED_PCT
#define P0_DED_PCT 30
#endif
constexpr int P8_SPLITD = (P8_SPLITR - (int)((long long)P8_N * P0_DED_PCT / 100)) > 0 ? (P8_SPLITR - (int)((long long)P8_N * P0_DED_PCT / 100)) : 0;
#ifndef P2_GEMM_WGS
#define P2_GEMM_WGS 232
#endif
constexpr int P2_ROUNDS = ((M / 256) * (NPROJ / 256) + P2_GEMM_WGS - 1) / P2_GEMM_WGS, P2_NFULL = (M / 256) * (NPROJ / 256) - (P2_ROUNDS - 1) * P2_GEMM_WGS;
#ifndef P11_TAIL_ITEMS
#define P11_TAIL_ITEMS 48
#endif
constexpr float W8_SCALE = 64.0f, H8_SCALE = 8.0f, A8_SCALE = 4.0f, Y8_SCALE = 64.0f;
struct TItem8 { const float* src; unsigned char* dst; int N, Kd; };
__device__ __forceinline__ TItem8 p8_decode(const Args& args, unsigned char* ws, int it) {
    TItem8 t;
    if (it >= P8_N) { const int j = it - P8_N; it = (P8_E0 + j / P8_DN1) * (P8_GU1 + P8_DN1) + P8_GU1 + j % P8_DN1; }
    else if (it >= P8_E0 * (P8_GU1 + P8_DN1)) { const int r = it - P8_E0 * (P8_GU1 + P8_DN1); it = (P8_E0 + r / P8_GU1) * (P8_GU1 + P8_DN1) + r % P8_GU1; }
    const int e = it / (P8_GU1 + P8_DN1), q = it % (P8_GU1 + P8_DN1);
    if (q < P8_GU1) { const int kb = q / 128, nb = q % 128, n0 = nb * 32;
        const int dr = (n0 < DE) ? (256 * (n0 / 128) + (n0 % 128)) : (256 * ((n0 - DE) / 128) + 128 + ((n0 - DE) % 128));
        t.src = args.in[25] + (size_t)e * D * 2 * DE + (size_t)(kb * 128) * (2 * DE) + n0; t.N = 2 * DE; t.dst = ws + WS_WGU + (size_t)e * 2 * DE * D + (size_t)dr * D + kb * 128; t.Kd = D; }
    else { const int q2 = q - P8_GU1, kb = q2 / 64, nb = q2 % 64;
        t.src = args.in[27] + (size_t)e * DE * D + (size_t)(kb * 128) * D + nb * 32; t.N = D; t.dst = ws + WS_WDN + (size_t)e * D * DE + (size_t)(nb * 32) * DE + kb * 128; t.Kd = DE; }
    return t;
}
__device__ __forceinline__ void p8_issue(const TItem8& t, f32x4 (&v)[16], int lane) {
    const GAS f32x4* src = (const GAS f32x4*)((const GAS float*)t.src + (size_t)(lane >> 3) * t.N + 4 * (lane & 7));
#pragma unroll
    for (int i = 0; i < 16; ++i) v[i] = __builtin_nontemporal_load(src + (size_t)(2 * i) * t.N);
}
__device__ __forceinline__ void p8_finish(const TItem8& t, const f32x4 (&v)[16], LAS float* scr, int lane) {
#pragma unroll
    for (int i = 0; i < 16; ++i) *(LAS f32x4*)(scr + (8 * i + (lane >> 3)) * 32 + (((lane & 7) ^ (i & 7)) << 2)) = v[i] * W8_SCALE;
    LDS_WAIT(); asm volatile("" ::: "memory");
    const int c = lane & 7;
#pragma unroll
    for (int j = 0; j < 4; ++j) { const int n = (lane >> 3) + 8 * j; float x[16];
#pragma unroll
        for (int i = 0; i < 16; ++i) { const int k = 16 * c + i; x[i] = scr[k * 32 + ((((n >> 2) ^ ((k >> 3) & 7)) << 2) | (n & 3))]; }
        int w[4];
#pragma unroll
        for (int g = 0; g < 4; ++g) { int q = 0; q = __builtin_amdgcn_cvt_pk_fp8_f32(fminf(fmaxf(x[4 * g], -448.f), 448.f), fminf(fmaxf(x[4 * g + 1], -448.f), 448.f), q, false);
            q = __builtin_amdgcn_cvt_pk_fp8_f32(fminf(fmaxf(x[4 * g + 2], -448.f), 448.f), fminf(fmaxf(x[4 * g + 3], -448.f), 448.f), q, true); w[g] = q; }
        v4u o; o.x = (unsigned)w[0]; o.y = (unsigned)w[1]; o.z = (unsigned)w[2]; o.w = (unsigned)w[3];
        __builtin_nontemporal_store(o, (GAS v4u*)(t.dst + (size_t)n * t.Kd + 16 * c)); }
    LDS_WAIT(); asm volatile("" ::: "memory");
}
__device__ __forceinline__ void p8_convert(Frame& F, const Args& args, int lo, int hi, int gw, int NGW, int nlight) {
    LAS float* scr = (LAS float*)(F.lds + F.wave * 16384);
    unsigned char* ws = F.ws;
    const int nA = NGW > nlight ? NGW - nlight : 0, nit = hi - lo, itemsA = (nlight > 0) ? (nA * 8 < nit ? nA * 8 : nit) : 0;
    auto item_of = [&](int idx) -> int {
        if (nlight > 0) { if (gw >= nlight && idx < 8) { const int a = (gw - nlight) + nA * idx; return a < itemsA ? lo + a : hi + 1000000; }
            const int j = (gw >= nlight) ? idx - 8 : idx; return lo + itemsA + gw + NGW * j; }
        return lo + gw + NGW * idx; };
    int idx = 0;
    while (nlight > 0 && idx < 8 && item_of(idx) >= hi + 1000000) ++idx;
    if (item_of(idx) < hi) {
        f32x4 va[16], vb[16];
        TItem8 ca = p8_decode(args, ws, item_of(idx)), cb = ca; p8_issue(ca, va, F.lane);
        for (;;) {
            int nx = item_of(++idx); bool has = nx < hi;
            if (has) { cb = p8_decode(args, ws, nx); p8_issue(cb, vb, F.lane); }
            p8_finish(ca, va, scr, F.lane);
            if (!has) break;
            nx = item_of(++idx); has = nx < hi;
            if (has) { ca = p8_decode(args, ws, nx); p8_issue(ca, va, F.lane); }
            p8_finish(cb, vb, scr, F.lane);
            if (!has) break;
        }
    }
}
__device__ __forceinline__ void p0_prologue(Frame& F, const Args& args) {
    const int gw = F.vcu * NWAVES + F.wave, NGW = F.G * NWAVES, gt = F.vcu * 512 + F.tid, NGT = F.G * 512;
    unsigned char* ws = F.ws;
    LAS float* sc = (LAS float*)(F.lds + 67584);
    for (int i = F.tid; i < NB * D; i += 512) { const int b = i / D, k = i % D; const float cv = args.in[1][i]; sc[k * 8 + b] = cv * sigmoidf_(cv); }
    __syncthreads();
    {
        float* modp = (float*)(ws + WS_MODP);
        for (int it = gw; it < 16 * 48; it += NGW) {
            const int kc = it / 48, jc = it % 48, j0 = jc * 256 + 4 * F.lane;
            f32x4 acc[8];
#pragma unroll
            for (int b = 0; b < 8; ++b) acc[b] = (f32x4){0.f, 0.f, 0.f, 0.f};
            const GAS f32x4* wp = (const GAS f32x4*)(args.in[2] + (size_t)(kc * 128) * 12288 + j0);
            const LAS f32x4* sp = (const LAS f32x4*)(sc + kc * 128 * 8);
#pragma unroll 8
            for (int kk = 0; kk < 128; ++kk) {
                const f32x4 w = wp[(size_t)kk * 3072]; const f32x4 s0 = sp[2 * kk], s1 = sp[2 * kk + 1];
                acc[0] += s0[0] * w; acc[1] += s0[1] * w; acc[2] += s0[2] * w; acc[3] += s0[3] * w;
                acc[4] += s1[0] * w; acc[5] += s1[1] * w; acc[6] += s1[2] * w; acc[7] += s1[3] * w;
            }
#pragma unroll
            for (int b = 0; b < 8; ++b) *(GAS f32x4*)(modp + (size_t)(kc * 8 + b) * 12288 + j0) = acc[b];
        }
    }
    {
        bf16* rwh = (bf16*)(ws + WS_RWP); bf16* rwl = rwh + NE * D;
        for (int o = gt; o < D * NE; o += NGT) { const int k = o & (D - 1), e = o >> 11; const float w = args.in[23][k * NE + e]; const unsigned hi = f2bf(w); rwh[o] = (bf16)hi; rwl[o] = (bf16)f2bf(w - bf2f((unsigned short)hi)); }
    }
    {
        bf16* wl = (bf16*)(ws + WS_WLORA);
        for (int o = gt; o < LORA_N * LORA_K; o += NGT) {
            const int n = o / LORA_K, k = o % LORA_K; float v = 0.f;
            if (n < 1024) { if (k < 64) v = args.in[9][k * 1024 + n]; }
            else if (n < 2048) { if (k >= 64 && k < 128) v = args.in[11][(k - 64) * 1024 + (n - 1024)]; }
            else { if (k >= 128 && k < 288) v = args.in[12][(k - 128) * 1024 + (n - 2048)]; }
            wl[o] = (bf16)f2bf(v);
        }
    }
    {
        GAS v4u* z = (GAS v4u*)(ws + WS_WIN + (size_t)RWKV_COLS * D * 2);
        for (int o = gt; o < (HG_BASE - RWKV_COLS) * D * 2 / 16; o += NGT) z[o] = (v4u){0u, 0u, 0u, 0u};
    }
    p0_convert(F, args, 0, P0_NITEMS, gw, NGW, 0);
    __syncthreads();
    if (P8_SPLITD > 0) p8_convert(F, args, 0, P8_SPLITD, gw, NGW, 768);
}

__device__ __forceinline__ void p1_norm1(Frame& F, const Args& args) {
    const float* modp = (const float*)(F.ws + WS_MODP); float* mod = (float*)(F.ws + WS_MOD); bf16* H = (bf16*)(F.ws + WS_H);
    LAS float* ml = (LAS float*)F.lds;
    for (int rg = F.vcu; rg < M / 64; rg += F.G) {
        const int b = rg / (SEQ / 64);
        __syncthreads();
        for (int j = F.tid; j < 2 * D; j += 512) { float s = args.in[3][j];
#pragma unroll
            for (int kc = 0; kc < 16; ++kc) s += modp[(size_t)(kc * 8 + b) * 12288 + j];
            ml[j] = s; }
        for (int idx = rg * 384 + F.tid; idx < (rg + 1) * 384 && F.tid < 384; idx += 512) { const int bb = idx / 12288, j = idx % 12288; float s = args.in[3][j];
#pragma unroll
            for (int kc = 0; kc < 16; ++kc) s += modp[(size_t)(kc * 8 + bb) * 12288 + j];
            mod[idx] = s; }
        __syncthreads();
        f32x4 g1q[8];
#pragma unroll
        for (int j = 0; j < 8; ++j) g1q[j] = *(const GAS f32x4*)(args.in[4] + 256 * j + 4 * F.lane);
        f32x4 vn[8];
        { const GAS f32x4* xr0 = (const GAS f32x4*)(args.in[0] + (size_t)(rg * 64 + F.wave * 8) * D) + F.lane;
#pragma unroll
          for (int j = 0; j < 8; ++j) vn[j] = xr0[64 * j]; }
        for (int i = 0; i < 8; ++i) {
            const int m = rg * 64 + F.wave * 8 + i;
            f32x4 v[8]; float ss = 0.f;
#pragma unroll
            for (int j = 0; j < 8; ++j) { v[j] = vn[j]; ss += (v[j].x * v[j].x + v[j].y * v[j].y) + (v[j].z * v[j].z + v[j].w * v[j].w); }
            if (i < 7) { const GAS f32x4* xr1 = (const GAS f32x4*)(args.in[0] + (size_t)(m + 1) * D) + F.lane;
#pragma unroll
                for (int j = 0; j < 8; ++j) vn[j] = xr1[64 * j]; }
            const float rstd = 1.0f / sqrtf(wave_sum(ss) * (1.0f / D) + NORM_EPS);
            GAS v2u* o8 = (GAS v2u*)(H + (size_t)m * D) + F.lane;
#pragma unroll
            for (int j = 0; j < 8; ++j) { const int c = 256 * j + 4 * F.lane;
                const f32x4 g = g1q[j], sh = *(const LAS f32x4*)(ml + c), scl = *(const LAS f32x4*)(ml + D + c);
                const f32x4 hv = v[j] * rstd * g * (scl + 1.0f) + sh;
                v2u w; w.x = pk2(hv.x, hv.y); w.y = pk2(hv.z, hv.w); o8[64 * j] = w; }
        }
    }
}

__device__ __forceinline__ void p3_lora_a(Frame& F, const Args& args) {
    const bf16* P = (const bf16*)(F.ws + WS_PROJ); bf16* A = (bf16*)(F.ws + WS_LORA_A);
    const int gw = F.vcu * NWAVES + F.wave, NGW = F.G * NWAVES;
    float muv[5];
#pragma unroll
    for (int jj = 0; jj < 5; ++jj) { const int c = F.lane + 64 * jj; muv[jj] = (c < 288) ? args.in[7][3072 + c] : 0.f; }
    for (int rg = gw; rg < M / 8; rg += NGW) {
        const int m0 = rg * 8; unsigned short raw[9][5];
#pragma unroll
        for (int r = 0; r < 9; ++r)
#pragma unroll
            for (int jj = 0; jj < 5; ++jj) { const int c = F.lane + 64 * jj; const bool first = (r == 0) && (m0 % SEQ) == 0; const int m = first ? m0 : m0 + r - 1;
                const unsigned short q = ((const GAS bf16*)P)[(size_t)m * NPROJ + 3072 + (c < 288 ? c : 287)]; raw[r][jj] = (c < 288 && !first) ? q : (unsigned short)0; }
#pragma unroll
        for (int r = 1; r < 9; ++r) { const int m = m0 + r - 1;
#pragma unroll
            for (int jj = 0; jj < 6; ++jj) { const int c = F.lane + 64 * jj; float o = 0.f;
                if (jj < 5 && c < 288) { const float p = bf2f(raw[r][jj < 5 ? jj : 0]), pp = bf2f(raw[r - 1][jj < 5 ? jj : 0]); const float s = p + (pp - p) * muv[jj < 5 ? jj : 0];
                    o = (c < 64) ? (2.0f * sigmoidf_(2.0f * s) - 1.0f) : ((c < 128) ? s : sigmoidf_(s)); }
                A[(size_t)m * LORA_K + c] = (bf16)f2bf(o); } }
    }
}

__device__ __forceinline__ float wave_sum_u(float v) {
    v += dpp_mov<0xB1>(v); v += dpp_mov<0x4E>(v); v += dpp_mov<0x141>(v); v += dpp_mov<0x140>(v);
    v += __builtin_bit_cast(float, __builtin_amdgcn_update_dpp(0, __builtin_bit_cast(int, v), 0x142, 0xa, 0xf, false));
    v += __builtin_bit_cast(float, __builtin_amdgcn_update_dpp(0, __builtin_bit_cast(int, v), 0x143, 0xc, 0xf, false));
    return __builtin_bit_cast(float, __builtin_amdgcn_readlane(__builtin_bit_cast(int, v), 63));
}
#define LO2(v) __builtin_shufflevector(v, v, 0, 1)
#define HI2(v) __builtin_shufflevector(v, v, 2, 3)
__device__ __forceinline__ float fma_s(float a, float b, float c) { float d; asm("v_fma_f32 %0, %1, %2, %3" : "=v"(d) : "v"(a), "v"(b), "v"(c)); return d; }
__device__ __forceinline__ float mul_s(float a, float b) { float d; asm("v_mul_f32 %0, %1, %2" : "=v"(d) : "v"(a), "v"(b)); return d; }
__device__ __forceinline__ float sub_s(float a, float b) { float d; asm("v_sub_f32 %0, %1, %2" : "=v"(d) : "v"(a), "v"(b)); return d; }
__device__ __forceinline__ float add_s(float a, float b) { float d; asm("v_add_f32 %0, %1, %2" : "=v"(d) : "v"(a), "v"(b)); return d; }
struct RStep { f32x4 kk0, kk1, w0, w1, nb0, nb1, k0, k1, r0, r1; float v; };
__device__ __forceinline__ void rwkv_scan(Frame& F, const Args& args, int bh) {
    constexpr int TT = 32, ARR = TT * 64, BUF = 8 * ARR + 64;
    const int b = bh >> 4, h = bh & 15, lane = F.lane, wave = F.wave;
    const bf16* P = (const bf16*)(F.ws + WS_PROJ); const bf16* LO = (const bf16*)(F.ws + WS_LORA_O); bf16* YA = (bf16*)(F.ws + WS_YA);
    LAS float* L = (LAS float*)F.lds;
    const int c = h * 64 + lane;
    const float mu_r = args.in[7][c], mu_k = args.in[7][1024 + c], mu_v = args.in[7][2048 + c], w0 = args.in[8][c], a0 = args.in[10][c], kkc = args.in[13][c], kac = args.in[14][c], rkc = args.in[15][c], gng = args.in[16][c], gnb = args.in[17][c];
    unsigned short rr[4], rk[4], rv[4], pr[4], pk[4], pv[4], rwl[4], ral[4], rg[4];
    auto load_raw = [&](int t0) {
#pragma unroll
        for (int i = 0; i < 4; ++i) { const int t = t0 + wave + 8 * i; const size_t m = (size_t)b * SEQ + t; const GAS bf16* pm = (const GAS bf16*)P + m * NPROJ + c;
            rr[i] = pm[0]; rk[i] = pm[1024]; rv[i] = pm[2048];
            if (t > 0) { pr[i] = pm[-NPROJ]; pk[i] = pm[1024 - NPROJ]; pv[i] = pm[2048 - NPROJ]; } else { pr[i] = 0; pk[i] = 0; pv[i] = 0; }
            const GAS bf16* lm = (const GAS bf16*)LO + m * LORA_N + c; rwl[i] = lm[0]; ral[i] = lm[1024]; rg[i] = lm[2048]; }
    };
    auto derive = [&](LAS float* B) {
#pragma unroll
        for (int i = 0; i < 4; ++i) { const int tl = wave + 8 * i;
            const float r0 = bf2f(rr[i]), k0 = bf2f(rk[i]), v0 = bf2f(rv[i]);
            const float r = r0 + (bf2f(pr[i]) - r0) * mu_r, k = k0 + (bf2f(pk[i]) - k0) * mu_k, v = v0 + (bf2f(pv[i]) - v0) * mu_v;
            const float decay = __expf(-0.6065306597126334f * sigmoidf_(w0 + bf2f(rwl[i])));
            const float a = sigmoidf_(a0 + bf2f(ral[i]));
            const float kkv = k * kkc; const float n2 = wave_sum_u(kkv * kkv); const float kk = kkv / fmaxf(sqrtf(n2), 1e-12f);
            const float k2 = k * (1.0f + (a - 1.0f) * kac);
            const float bon = wave_sum_u(r * k2 * rkc);
            B[0 * ARR + tl * 64 + lane] = kk; B[1 * ARR + tl * 64 + lane] = decay; B[2 * ARR + tl * 64 + lane] = -kk * a; B[3 * ARR + tl * 64 + lane] = k2;
            B[4 * ARR + tl * 64 + lane] = r; B[5 * ARR + tl * 64 + lane] = v; B[6 * ARR + tl * 64 + lane] = bf2f(rg[i]);
            if (lane == 0) B[8 * ARR + tl] = bon; }
    };
    const int rv8 = lane >> 3, kg = lane & 7, row = 8 * wave + rv8;
    float S[8];
#pragma unroll
    for (int i = 0; i < 8; ++i) S[i] = 0.f;
    auto ldstep = [&](const LAS float* B, int tl) -> RStep {
        const LAS f32x4* q = (const LAS f32x4*)(B + tl * 64 + 8 * kg); RStep s;
        s.kk0 = q[0]; s.kk1 = q[1]; s.w0 = q[ARR / 4]; s.w1 = q[ARR / 4 + 1]; s.nb0 = q[2 * ARR / 4]; s.nb1 = q[2 * ARR / 4 + 1];
        s.k0 = q[3 * ARR / 4]; s.k1 = q[3 * ARR / 4 + 1]; s.r0 = q[4 * ARR / 4]; s.r1 = q[4 * ARR / 4 + 1]; s.v = B[5 * ARR + tl * 64 + row]; return s;
    };
    float yacc = 0.f;
    auto step = [&](LAS float* B, const RStep& s, int tl) {
        float p0 = mul_s(S[0], s.kk0[0]), p1 = mul_s(S[1], s.kk0[1]);
        p0 = fma_s(S[2], s.kk0[2], p0); p1 = fma_s(S[3], s.kk0[3], p1); p0 = fma_s(S[4], s.kk1[0], p0); p1 = fma_s(S[5], s.kk1[1], p1); p0 = fma_s(S[6], s.kk1[2], p0); p1 = fma_s(S[7], s.kk1[3], p1);
        const float sa = red8(add_s(p0, p1));
#pragma unroll
        for (int i = 0; i < 4; ++i) { S[i] = fma_s(S[i], s.w0[i], fma_s(sa, s.nb0[i], mul_s(s.v, s.k0[i]))); S[4 + i] = fma_s(S[4 + i], s.w1[i], fma_s(sa, s.nb1[i], mul_s(s.v, s.k1[i]))); }
        float y0 = mul_s(S[0], s.r0[0]), y1 = mul_s(S[1], s.r0[1]);
        y0 = fma_s(S[2], s.r0[2], y0); y1 = fma_s(S[3], s.r0[3], y1); y0 = fma_s(S[4], s.r1[0], y0); y1 = fma_s(S[5], s.r1[1], y1); y0 = fma_s(S[6], s.r1[2], y0); y1 = fma_s(S[7], s.r1[3], y1);
        const float y = red8(add_s(y0, y1));
        yacc = ((tl & 7) == kg) ? y : yacc;
        if ((tl & 7) == 7) B[7 * ARR + ((tl & ~7) + kg) * 64 + row] = yacc;
    };
    __syncthreads();
    load_raw(0); derive(L);
    __syncthreads();
    for (int tile = 0; tile < SEQ / TT; ++tile) {
        LAS float* B = L + (tile & 1) * BUF; LAS float* Bn = L + ((tile + 1) & 1) * BUF;
        const bool more = (tile + 1) < SEQ / TT;
        if (more) load_raw((tile + 1) * TT);
        {
            RStep sa_ = ldstep(B, 0), sb_;
#pragma unroll
            for (int tl = 0; tl < TT; tl += 2) {
                sb_ = ldstep(B, tl + 1); __builtin_amdgcn_sched_barrier(0); step(B, sa_, tl); __builtin_amdgcn_sched_barrier(0);
                if (tl + 2 < TT) sa_ = ldstep(B, tl + 2);
                __builtin_amdgcn_sched_barrier(0); step(B, sb_, tl + 1); __builtin_amdgcn_sched_barrier(0);
            }
        }
        __syncthreads();
#pragma unroll
        for (int i = 0; i < 4; ++i) { const int tl = wave + 8 * i; const size_t m = (size_t)b * SEQ + tile * TT + tl;
            const float y = B[7 * ARR + tl * 64 + lane]; const float mean = wave_sum_u(y) * (1.0f / 64.0f); const float d = y - mean; const float var = wave_sum_u(d * d) * (1.0f / 64.0f);
            const float yn = d * (1.0f / sqrtf(var + GN_EPS)) * gng + gnb;
            const float o = (yn + B[8 * ARR + tl] * B[5 * ARR + tl * 64 + lane]) * B[6 * ARR + tl * 64 + lane];
            YA[m * RW + c] = (bf16)f2bf(o); }
        if (more) derive(Bn);
        __syncthreads();
    }
}

struct HStep { f32x4 f[4], q[4]; float v; };
__device__ __forceinline__ void hgrn_scan(Frame& F, const Args& args, int u) {
    constexpr int TT = 32, KP = 160, BUF = TT * (KP + KP + 64 + 64);
    const int half = u & 1, bh = u >> 1, b = bh >> 3, h = bh & 7, lane = F.lane, wave = F.wave, tid = F.tid;
    const bf16* P = (const bf16*)(F.ws + WS_PROJ); float* OH = (float*)(F.ws + WS_OHG);
    LAS float* L = (LAS float*)F.lds;
    const int j = tid & 127, ts = tid >> 7, jp = (j >> 4) * 20 + (j & 15);
    const float lb = 1.0f / (1.0f + __expf(args.in[18][1024 + h * 128 + j] - args.in[18][h * 128 + j]));
    unsigned short rq[8], rf[8], rvv[8];
    auto load_raw = [&](int t0) {
#pragma unroll
        for (int i = 0; i < 8; ++i) { const size_t m = (size_t)b * SEQ + t0 + ts + 4 * i; const GAS bf16* pm = (const GAS bf16*)P + m * NPROJ + HG_BASE + h * 128 + j;
            rq[i] = pm[0]; rf[i] = pm[1024]; rvv[i] = (j < 64) ? pm[2048 + half * 64] : (unsigned short)0; }
    };
    auto derive = [&](LAS float* B) {
#pragma unroll
        for (int i = 0; i < 8; ++i) { const int tl = ts + 4 * i; const float q = bf2f(rq[i]); const float f = lb + (1.0f - lb) * sigmoidf_(bf2f(rf[i]));
            B[tl * KP + jp] = f; B[TT * KP + tl * KP + jp] = q * sigmoidf_(q); if (j < 64) B[TT * 2 * KP + tl * 64 + j] = bf2f(rvv[i]); }
    };
    const int cv = lane >> 3, kg = lane & 7, col = 8 * wave + cv;
    float S[16];
#pragma unroll
    for (int i = 0; i < 16; ++i) S[i] = 0.f;
    auto ldstep = [&](const LAS float* B, int tl) -> HStep {
        const LAS f32x4* fp = (const LAS f32x4*)(B + tl * KP + 20 * kg); const LAS f32x4* qp = (const LAS f32x4*)(B + TT * KP + tl * KP + 20 * kg); HStep s; s.v = B[TT * 2 * KP + tl * 64 + col];
#pragma unroll
        for (int g4 = 0; g4 < 4; ++g4) { s.f[g4] = fp[g4]; s.q[g4] = qp[g4]; }
        return s;
    };
    float oacc = 0.f;
    auto step = [&](LAS float* B, const HStep& s, int tl) {
        float o0 = 0.f, o1 = 0.f;
#pragma unroll
        for (int g4 = 0; g4 < 4; ++g4) {
#pragma unroll
            for (int i = 0; i < 4; ++i) { S[4 * g4 + i] = fma_s(s.f[g4][i], sub_s(S[4 * g4 + i], s.v), s.v); }
            if (g4 == 0) { o0 = mul_s(s.q[0][0], S[0]); o1 = mul_s(s.q[0][1], S[1]); } else { o0 = fma_s(s.q[g4][0], S[4 * g4], o0); o1 = fma_s(s.q[g4][1], S[4 * g4 + 1], o1); }
            o0 = fma_s(s.q[g4][2], S[4 * g4 + 2], o0); o1 = fma_s(s.q[g4][3], S[4 * g4 + 3], o1); }
        const float o = red8(add_s(o0, o1));
        oacc = ((tl & 7) == kg) ? o : oacc;
        if ((tl & 7) == 7) B[TT * (2 * KP + 64) + ((tl & ~7) + kg) * 64 + col] = oacc;
    };
    __syncthreads();
    load_raw(0); derive(L);
    __syncthreads();
    for (int tile = 0; tile < SEQ / TT; ++tile) {
        LAS float* B = L + (tile & 1) * BUF; LAS float* Bn = L + ((tile + 1) & 1) * BUF;
        const bool more = (tile + 1) < SEQ / TT;
        if (more) load_raw((tile + 1) * TT);
        {
            HStep sa_ = ldstep(B, 0), sb_;
#pragma unroll
            for (int tl = 0; tl < TT; tl += 2) {
                sb_ = ldstep(B, tl + 1); __builtin_amdgcn_sched_barrier(0); step(B, sa_, tl); __builtin_amdgcn_sched_barrier(0);
                if (tl + 2 < TT) sa_ = ldstep(B, tl + 2);
                __builtin_amdgcn_sched_barrier(0); step(B, sb_, tl + 1); __builtin_amdgcn_sched_barrier(0);
            }
        }
        __syncthreads();
        {
            const int jj = tid & 63, t8 = tid >> 6;
#pragma unroll
            for (int i = 0; i < 4; ++i) { const int tl = t8 + 8 * i; const size_t m = (size_t)b * SEQ + tile * TT + tl; OH[m * 1024 + h * 128 + half * 64 + jj] = B[TT * (2 * KP + 64) + tl * 64 + jj]; }
        }
        if (more) derive(Bn);
        __syncthreads();
    }
}


typedef short bf16x8_t __attribute__((ext_vector_type(8)));
template <int KS> __device__ __forceinline__ f32x4 mm16(const LAS bf16* A, int lda, const LAS bf16* Bt, int ldb, f32x4 acc, int lane) {
    const LAS bf16* ap = A + (lane & 15) * lda + 8 * (lane >> 4); const LAS bf16* bp = Bt + (lane & 15) * ldb + 8 * (lane >> 4);
#pragma unroll
    for (int ks = 0; ks < KS; ++ks) { const bf16x8_t a = *(const LAS bf16x8_t*)(ap + 32 * ks), b = *(const LAS bf16x8_t*)(bp + 32 * ks); acc = __builtin_amdgcn_mfma_f32_16x16x32_bf16(a, b, acc, 0, 0, 0); }
    return acc;
}
__device__ __forceinline__ v2u pack4(f32x4 v) { v2u w; w.x = pk2(v[0], v[1]); w.y = pk2(v[2], v[3]); return w; }
__device__ __forceinline__ float row16_sum(float v) {
    v += dpp_mov<0xB1>(v); v += dpp_mov<0x4E>(v); v += dpp_mov<0x141>(v); v += dpp_mov<0x140>(v); return v;
}

__device__ __forceinline__ void hgrn_chunk_scan(Frame& F, const Args& args, int bh) {
    constexpr int CL = 32, PQ = 136, PS = 40, PO = 132;
    const int b = bh >> 3, h = bh & 7, lane_ = F.lane, wave = F.wave, tid_ = F.tid;
    const bf16* P = (const bf16*)(F.ws + WS_PROJ); bf16* YB = (bf16*)(F.ws + WS_YB);
    LAS bf16* QD = (LAS bf16*)F.lds;
    LAS bf16* KD = QD + 32 * PQ;
    LAS bf16* VT = KD + 32 * PQ;
    LAS bf16* KET = VT + 128 * PS;
    LAS bf16* ST = KET + 128 * PS;
    LAS bf16* AT = ST + 128 * PQ;
    LAS float* OB = (LAS float*)(AT + 32 * PS);
    LAS float* DEND = OB + 32 * PO;
    LAS float* TOT = DEND + 128;
    const float lb = 1.0f / (1.0f + __expf(args.in[18][1024 + h * 128 + (tid_ & 127)] - args.in[18][h * 128 + (tid_ & 127)]));
    unsigned short rq[8], rf[8], rvv[8];
    auto load_raw = [&](int t0) {
#pragma unroll
        for (int i = 0; i < 8; ++i) { const size_t m = (size_t)b * SEQ + t0 + 8 * (tid_ >> 7) + i; const GAS bf16* pm = (const GAS bf16*)P + m * NPROJ + HG_BASE + h * 128 + (tid_ & 127);
            rq[i] = pm[0]; rf[i] = pm[1024]; rvv[i] = pm[2048]; }
    };
    f32x4 Sacc[8];
#pragma unroll
    for (int vt = 0; vt < 8; ++vt) Sacc[vt] = (f32x4){0.f, 0.f, 0.f, 0.f};
    for (int i = tid_; i < 128 * PQ / 2; i += 512) ((LAS unsigned*)ST)[i] = 0u;
    const float gng0 = args.in[19][8 * (tid_ & 15)], gng1 = args.in[19][8 * (tid_ & 15) + 1], gng2 = args.in[19][8 * (tid_ & 15) + 2], gng3 = args.in[19][8 * (tid_ & 15) + 3],
                gng4 = args.in[19][8 * (tid_ & 15) + 4], gng5 = args.in[19][8 * (tid_ & 15) + 5], gng6 = args.in[19][8 * (tid_ & 15) + 6], gng7 = args.in[19][8 * (tid_ & 15) + 7];
    load_raw(0);
    const GAS bf16* ogp = (const GAS bf16*)P + ((size_t)b * SEQ + (tid_ >> 4)) * NPROJ + HG_BASE + 3072 + h * 128 + 8 * (tid_ & 15);
    v4u ogc = *(const GAS v4u*)ogp, ogn = ogc;
    __syncthreads();
    for (int ch = 0; ch < SEQ / CL; ++ch) {
        int lane = lane_, tid = tid_; asm volatile("" : "+v"(lane), "+v"(tid));
        const int j = tid & 127, tq = tid >> 7, q4 = lane >> 4, r16 = lane & 15;
        float fv[8], cs[8]; float run = 0.f;
#pragma unroll
        for (int i = 0; i < 8; ++i) { fv[i] = lb + (1.0f - lb) * sigmoidf_(bf2f(rf[i])); run += __logf(fv[i]); cs[i] = run; }
        TOT[tq * 128 + j] = run;
        {
            v4u w; w.x = (unsigned)rvv[0] | ((unsigned)rvv[1] << 16); w.y = (unsigned)rvv[2] | ((unsigned)rvv[3] << 16); w.z = (unsigned)rvv[4] | ((unsigned)rvv[5] << 16); w.w = (unsigned)rvv[6] | ((unsigned)rvv[7] << 16);
            *(LAS v4u*)(VT + j * PS + 8 * tq) = w; }
        __syncthreads();
        {
            const float t0 = TOT[j], t1 = TOT[128 + j], t2 = TOT[256 + j], t3 = TOT[384 + j];
            const float off = (tq > 0 ? t0 : 0.f) + (tq > 1 ? t1 : 0.f) + (tq > 2 ? t2 : 0.f); const float bl = ((t0 + t1) + t2) + t3; const float ebl = __expf(bl);
            if (tq == 0) DEND[j] = ebl;
            float ke[8];
#pragma unroll
            for (int i = 0; i < 8; ++i) { const float bb = off + cs[i]; const float eb = __expf(bb), enb = __builtin_amdgcn_rcpf(eb); const float qv = bf2f(rq[i]); const float kd = (1.0f - fv[i]) * enb;
                QD[(8 * tq + i) * PQ + j] = (bf16)f2bf(qv * sigmoidf_(qv) * eb); KD[(8 * tq + i) * PQ + j] = (bf16)f2bf(kd); ke[i] = kd * ebl; }
            v4u w; w.x = pk2(ke[0], ke[1]); w.y = pk2(ke[2], ke[3]); w.z = pk2(ke[4], ke[5]); w.w = pk2(ke[6], ke[7]);
            *(LAS v4u*)(KET + j * PS + 8 * tq) = w;
        }
        const bool more = (ch + 1) < SEQ / CL;
        if (more) { load_raw((ch + 1) * CL); ogn = *(const GAS v4u*)(ogp + (size_t)(ch + 1) * CL * NPROJ); }
        __syncthreads();
        if (wave < 4) { const int tt = wave >> 1, st = wave & 1;
            f32x4 a = mm16<4>(KD + 16 * st * PQ, PQ, QD + 16 * tt * PQ, PQ, (f32x4){0.f, 0.f, 0.f, 0.f}, lane);
            const int t = 16 * tt + r16, s0 = 16 * st + 4 * q4;
#pragma unroll
            for (int i = 0; i < 4; ++i) a[i] = (s0 + i <= t) ? a[i] : 0.f;
            *(LAS v2u*)(AT + t * PS + s0) = pack4(a); }
        const int ott = wave & 1, ovt0 = 2 * (wave >> 1);
        f32x4 o0 = mm16<4>(QD + 16 * ott * PQ, PQ, ST + 16 * ovt0 * PQ, PQ, (f32x4){0.f, 0.f, 0.f, 0.f}, lane);
        f32x4 o1 = mm16<4>(QD + 16 * ott * PQ, PQ, ST + 16 * (ovt0 + 1) * PQ, PQ, (f32x4){0.f, 0.f, 0.f, 0.f}, lane);
        __syncthreads();
        o0 = mm16<1>(AT + 16 * ott * PS, PS, VT + 16 * ovt0 * PS, PS, o0, lane);
        o1 = mm16<1>(AT + 16 * ott * PS, PS, VT + 16 * (ovt0 + 1) * PS, PS, o1, lane);
#pragma unroll
        for (int i = 0; i < 4; ++i) { OB[(16 * ott + 4 * q4 + i) * PO + 16 * ovt0 + r16] = o0[i]; OB[(16 * ott + 4 * q4 + i) * PO + 16 * (ovt0 + 1) + r16] = o1[i]; }
        {
            const f32x4 de = *(const LAS f32x4*)(DEND + 16 * wave + 4 * q4);
#pragma unroll
            for (int vt = 0; vt < 8; ++vt) { Sacc[vt] = Sacc[vt] * de; Sacc[vt] = mm16<1>(KET + 16 * wave * PS, PS, VT + 16 * vt * PS, PS, Sacc[vt], lane);
                *(LAS v2u*)(ST + (16 * vt + r16) * PQ + 16 * wave + 4 * q4) = pack4(Sacc[vt]); }
        }
        __syncthreads();
        {
            const int t = tid >> 4, vg = tid & 15; const size_t m = (size_t)b * SEQ + ch * CL + t;
            const f32x4 x0 = *(const LAS f32x4*)(OB + t * PO + 8 * vg), x1 = *(const LAS f32x4*)(OB + t * PO + 8 * vg + 4);
            float ss = (x0[0] * x0[0] + x0[1] * x0[1]) + (x0[2] * x0[2] + x0[3] * x0[3]) + ((x1[0] * x1[0] + x1[1] * x1[1]) + (x1[2] * x1[2] + x1[3] * x1[3]));
            ss = row16_sum(ss);
            const float rs = __builtin_amdgcn_rsqf(ss * (1.0f / 128.0f) + NORM_EPS);
            const v4u og = ogc; ogc = ogn;
            const float z0 = bflo(og.x), z1 = bfhi(og.x), z2 = bflo(og.y), z3 = bfhi(og.y), z4 = bflo(og.z), z5 = bfhi(og.z), z6 = bflo(og.w), z7 = bfhi(og.w);
            v4u w; w.x = pk2(x0[0] * rs * gng0 * (z0 * sigmoidf_(z0)), x0[1] * rs * gng1 * (z1 * sigmoidf_(z1))); w.y = pk2(x0[2] * rs * gng2 * (z2 * sigmoidf_(z2)), x0[3] * rs * gng3 * (z3 * sigmoidf_(z3)));
            w.z = pk2(x1[0] * rs * gng4 * (z4 * sigmoidf_(z4)), x1[1] * rs * gng5 * (z5 * sigmoidf_(z5))); w.w = pk2(x1[2] * rs * gng6 * (z6 * sigmoidf_(z6)), x1[3] * rs * gng7 * (z7 * sigmoidf_(z7)));
            *(GAS v4u*)(YB + m * 1024 + h * 128 + 8 * vg) = w;
        }
    }
}

__device__ __forceinline__ void rwkv_chunk_scan(Frame& F, const Args& args, int bh) {
    constexpr int CL = 32, P72 = 72, P40 = 40, PN = 36, PY = 68;
    const int b = bh >> 4, h = bh & 15, lane_ = F.lane, wave = F.wave, tid_ = F.tid;
    const bf16* P = (const bf16*)(F.ws + WS_PROJ); const bf16* LO = (const bf16*)(F.ws + WS_LORA_O); bf16* YA = (bf16*)(F.ws + WS_YA);
    LAS bf16* X1 = (LAS bf16*)F.lds;
    LAS bf16* X2 = X1 + 64 * P72;
    LAS bf16* BKT = X2 + 64 * P72;
    LAS bf16* VT = BKT + 64 * P72;
    LAS bf16* KKT = VT + 64 * P40;
    LAS bf16* MVT = KKT + 64 * P40;
    LAS bf16* UT = MVT + 64 * P40;
    LAS bf16* MAK = UT + 64 * P40;
    LAS bf16* TT = MAK + 32 * P40;
    LAS bf16* AR = TT + 32 * P40;
    LAS bf16* PM = AR + 32 * P72;
    LAS bf16* T11T = PM + 32 * P72;
    LAS bf16* WTm = T11T + 16 * P40;
    LAS bf16* N21B = WTm + 16 * P40;
    LAS bf16* T22B = N21B + 16 * P40;
    LAS bf16* ZT = T22B + 16 * P40;
    LAS float* NM = (LAS float*)(ZT + 2 * 64 * P72);
    LAS float* YBf = NM + 32 * PN;
    LAS float* WLv = YBf + 32 * PY;
    LAS float* CT = WLv + 64;
    LAS float* VGB = CT + 8 * 64;
    constexpr int VGB_SZ = 2 * 32 * 64 + 32;
    const int c = h * 64 + lane_;
    const float mu_r = args.in[7][c], mu_k = args.in[7][1024 + c], mu_v = args.in[7][2048 + c], w0 = args.in[8][c], a0 = args.in[10][c], kkc = args.in[13][c], kac = args.in[14][c], rkc = args.in[15][c], gng = args.in[16][c], gnb = args.in[17][c];
    unsigned short rr[5], rk[5], rv[5], rwl[4], ral[4], rg[4];
    auto load_raw = [&](int t0) {
#pragma unroll
        for (int i = 0; i < 5; ++i) { const int t = t0 + 4 * wave + i - 1;
            if (t >= 0) { const GAS bf16* pm = (const GAS bf16*)P + ((size_t)b * SEQ + t) * NPROJ + c; rr[i] = pm[0]; rk[i] = pm[1024]; rv[i] = pm[2048]; } else { rr[i] = 0; rk[i] = 0; rv[i] = 0; }
            if (i > 0) { const GAS bf16* lm = (const GAS bf16*)LO + ((size_t)b * SEQ + t) * LORA_N + c; rwl[i - 1] = lm[0]; ral[i - 1] = lm[1024]; rg[i - 1] = lm[2048]; } }
    };
    for (int i = tid_; i < (2 * 64 * P72) / 2; i += 512) ((LAS unsigned*)ZT)[i] = 0u;
    for (int i = tid_; i < (4 * 16 * P40) / 2; i += 512) ((LAS unsigned*)T11T)[i] = 0u;
    for (int i = tid_; i < (32 * P40) / 2; i += 512) ((LAS unsigned*)TT)[i] = 0u;
    f32x4 zacc[2] = {(f32x4){0.f, 0.f, 0.f, 0.f}, (f32x4){0.f, 0.f, 0.f, 0.f}};
    load_raw(0);
    __syncthreads();
    for (int ch = 0; ch < SEQ / CL; ++ch) {
        int lane = lane_; asm volatile("" : "+v"(lane));
        const int q4 = lane >> 4, r16 = lane & 15;
        LAS bf16* ZTc = ZT + (ch & 1) * 64 * P72; LAS bf16* ZTn = ZT + ((ch + 1) & 1) * 64 * P72;
        LAS float* VB = VGB + (ch & 1) * VGB_SZ; LAS float* GB = VB + 32 * 64; LAS float* BON = GB + 32 * 64;
        float er[4], ek2[4], ev[4], ekk[4], eb[4], elw[4], ecw[4]; float run = 0.f;
#pragma unroll
        for (int i = 0; i < 4; ++i) {
            const float r0 = bf2f(rr[i + 1]), k0 = bf2f(rk[i + 1]), v0 = bf2f(rv[i + 1]);
            const float r = r0 + (bf2f(rr[i]) - r0) * mu_r, k = k0 + (bf2f(rk[i]) - k0) * mu_k, v = v0 + (bf2f(rv[i]) - v0) * mu_v;
            const float lw = -0.6065306597126334f * sigmoidf_(w0 + bf2f(rwl[i]));
            const float a = sigmoidf_(a0 + bf2f(ral[i]));
            const float kkv = k * kkc; const float n2 = wave_sum_u(kkv * kkv); const float kk = kkv * __builtin_amdgcn_rsqf(fmaxf(n2, 1e-24f));
            const float k2 = k * (1.0f + (a - 1.0f) * kac);
            const float bon = wave_sum_u(r * k2 * rkc);
            run += lw; er[i] = r; ek2[i] = k2; ev[i] = v; ekk[i] = kk; eb[i] = kk * a; elw[i] = lw; ecw[i] = run;
            const int t = 4 * wave + i;
            VB[t * 64 + lane] = v; GB[t * 64 + lane] = bf2f(rg[i]); if (lane == 0) BON[t] = bon;
        }
        CT[wave * 64 + lane] = run;
        __syncthreads();
        {
            float off = 0.f, tot = 0.f;
#pragma unroll
            for (int w = 0; w < 8; ++w) { const float cv = CT[w * 64 + lane]; off += (w < wave) ? cv : 0.f; tot += cv; }
            const float etot = __expf(tot);
            if (wave == 0) WLv[lane] = etot;
            float fb[4], fk[4], fkk[4];
#pragma unroll
            for (int i = 0; i < 4; ++i) { const int t = 4 * wave + i; const float cw = off + ecw[i]; const float e1 = __expf(cw), e2 = __expf(cw - elw[i]), e3 = __builtin_amdgcn_rcpf(e1), e4 = etot * e3;
                fkk[i] = ekk[i] * e2; fb[i] = eb[i] * e4; fk[i] = ek2[i] * e4;
                X1[t * P72 + lane] = (bf16)f2bf(fkk[i]); X1[(32 + t) * P72 + lane] = (bf16)f2bf(er[i] * e1);
                X2[t * P72 + lane] = (bf16)f2bf(eb[i] * e3); X2[(32 + t) * P72 + lane] = (bf16)f2bf(ek2[i] * e3); }
            v2u w; w.x = pk2(fb[0], fb[1]); w.y = pk2(fb[2], fb[3]); *(LAS v2u*)(BKT + lane * P72 + 4 * wave) = w;
            w.x = pk2(fk[0], fk[1]); w.y = pk2(fk[2], fk[3]); *(LAS v2u*)(BKT + lane * P72 + 32 + 4 * wave) = w;
            w.x = pk2(fkk[0], fkk[1]); w.y = pk2(fkk[2], fkk[3]); *(LAS v2u*)(KKT + lane * P40 + 4 * wave) = w;
            w.x = pk2(ev[0], ev[1]); w.y = pk2(ev[2], ev[3]); *(LAS v2u*)(VT + lane * P40 + 4 * wave) = w;
        }
        const bool more = (ch + 1) < SEQ / CL;
        if (more) load_raw((ch + 1) * CL);
        __syncthreads();
#pragma unroll
        for (int u = 0; u < 2; ++u) { const int idx = 2 * wave + u, rt = idx >> 2, ct = idx & 3;
            if (rt == 0 && ct == 1) continue;
            f32x4 m = mm16<2>(X2 + 16 * ct * P72, P72, X1 + 16 * rt * P72, P72, (f32x4){0.f, 0.f, 0.f, 0.f}, lane);
            const int t = 16 * (rt & 1) + r16, s0 = 16 * (ct & 1) + 4 * q4;
            if (rt < 2) {
#pragma unroll
                for (int i = 0; i < 4; ++i) m[i] = (s0 + i < t) ? m[i] : 0.f;
                if (ct < 2) { *(LAS f32x4*)(NM + t * PN + s0) = m; if (rt == 1 && ct == 0) *(LAS v2u*)(N21B + r16 * P40 + 4 * q4) = pack4(m); }
                else *(LAS v2u*)(MAK + t * P40 + s0) = pack4(m);
            } else {
#pragma unroll
                for (int i = 0; i < 4; ++i) m[i] = (s0 + i <= t) ? m[i] : 0.f;
                *(LAS v2u*)(AR + t * P72 + (ct >= 2 ? 32 : 0) + s0) = pack4(m);
            }
        }
        __syncthreads();
        if (wave == 0) {
            const int blk = q4 & 1, jc = r16; float Tc[16];
            const LAS float* nrow = NM + (16 * blk) * PN + 16 * blk;
#pragma unroll
            for (int t = 0; t < 16; ++t) { float acc = (t == jc) ? 1.0f : 0.0f;
                if (t > 0) {
                    f32x4 nv[4];
#pragma unroll
                    for (int g = 0; g < 4; ++g) if (4 * g < t) nv[g] = *(const LAS f32x4*)(nrow + t * PN + 4 * g);
#pragma unroll
                    for (int s = 0; s < t; ++s) acc -= nv[s >> 2][s & 3] * Tc[s];
                }
                Tc[t] = acc; }
            if (lane < 32) {
#pragma unroll
                for (int s = 0; s < 16; ++s) TT[(16 * blk + s) * P40 + 16 * blk + jc] = (bf16)f2bf(Tc[s]);
                if (blk == 0) { v4u w0v, w1v; w0v.x = pk2(Tc[0], Tc[1]); w0v.y = pk2(Tc[2], Tc[3]); w0v.z = pk2(Tc[4], Tc[5]); w0v.w = pk2(Tc[6], Tc[7]); w1v.x = pk2(Tc[8], Tc[9]); w1v.y = pk2(Tc[10], Tc[11]); w1v.z = pk2(Tc[12], Tc[13]); w1v.w = pk2(Tc[14], Tc[15]);
                    *(LAS v4u*)(T11T + jc * P40) = w0v; *(LAS v4u*)(T11T + jc * P40 + 8) = w1v; }
                else {
#pragma unroll
                    for (int s = 0; s < 16; ++s) T22B[s * P40 + jc] = (bf16)f2bf(Tc[s]); }
            }
            LDS_WAIT();
            f32x4 wv = mm16<1>(N21B, P40, T11T, P40, (f32x4){0.f, 0.f, 0.f, 0.f}, lane);
            *(LAS v2u*)(WTm + r16 * P40 + 4 * q4) = pack4(wv);
            LDS_WAIT();
            f32x4 t21 = mm16<1>(WTm, P40, T22B, P40, (f32x4){0.f, 0.f, 0.f, 0.f}, lane);
            *(LAS v2u*)(TT + (16 + r16) * P40 + 4 * q4) = pack4(-t21);
        } else {
#pragma unroll
            for (int u = 0; u < 2; ++u) { const int tile = (wave - 1) + 7 * u; if (tile < 8) { const int tt = tile & 1, vt = tile >> 1;
                f32x4 mv = mm16<1>(MAK + 16 * tt * P40, P40, VT + 16 * vt * P40, P40, (f32x4){0.f, 0.f, 0.f, 0.f}, lane);
                *(LAS v2u*)(MVT + (16 * vt + r16) * P40 + 16 * tt + 4 * q4) = pack4(mv); } }
        }
        __syncthreads();
        const int ptt = wave & 1, pct = wave >> 1;
        {
            f32x4 pv = mm16<1>(KKT + 16 * pct * P40, P40, TT + 16 * ptt * P40, P40, (f32x4){0.f, 0.f, 0.f, 0.f}, lane);
            *(LAS v2u*)(PM + (16 * ptt + r16) * P72 + 16 * pct + 4 * q4) = pack4(-pv);
        }
        f32x4 uacc = -mm16<1>(TT + 16 * ptt * P40, P40, MVT + 16 * pct * P40, P40, (f32x4){0.f, 0.f, 0.f, 0.f}, lane);
        __syncthreads();
        uacc = mm16<2>(PM + 16 * ptt * P72, P72, ZTc + 16 * pct * P72, P72, uacc, lane);
        *(LAS v2u*)(UT + (16 * pct + r16) * P40 + 16 * ptt + 4 * q4) = pack4(uacc);
        __syncthreads();
        {
            f32x4 y = mm16<2>(X1 + (32 + 16 * ptt) * P72, P72, ZTc + 16 * pct * P72, P72, (f32x4){0.f, 0.f, 0.f, 0.f}, lane);
            y = mm16<1>(AR + 16 * ptt * P72, P72, UT + 16 * pct * P40, P40, y, lane);
            y = mm16<1>(AR + 16 * ptt * P72 + 32, P72, VT + 16 * pct * P40, P40, y, lane);
#pragma unroll
            for (int i = 0; i < 4; ++i) YBf[(16 * ptt + 4 * q4 + i) * PY + 16 * pct + r16] = y[i];
            const int kt = wave >> 1; const f32x4 wl = *(const LAS f32x4*)(WLv + 16 * kt + 4 * q4);
#pragma unroll
            for (int jv = 0; jv < 2; ++jv) { const int vt = 2 * (wave & 1) + jv;
                zacc[jv] = zacc[jv] * wl;
                zacc[jv] = mm16<1>(BKT + 16 * kt * P72, P72, UT + 16 * vt * P40, P40, zacc[jv], lane);
                zacc[jv] = mm16<1>(BKT + 16 * kt * P72 + 32, P72, VT + 16 * vt * P40, P40, zacc[jv], lane);
                *(LAS v2u*)(ZTn + (16 * vt + r16) * P72 + 16 * kt + 4 * q4) = pack4(zacc[jv]); }
        }
        __syncthreads();
#pragma unroll
        for (int i = 0; i < 4; ++i) { const int tl = wave + 8 * i; const size_t m = (size_t)b * SEQ + ch * CL + tl;
            const float y = YBf[tl * PY + lane]; const float mean = wave_sum_u(y) * (1.0f / 64.0f); const float d = y - mean; const float var = wave_sum_u(d * d) * (1.0f / 64.0f);
            const float yn = d * __builtin_amdgcn_rsqf(var + GN_EPS) * gng + gnb;
            const float o = (yn + BON[tl] * VB[tl * 64 + lane]) * GB[tl * 64 + lane];
            YA[m * RW + c] = (bf16)f2bf(o); }
    }
}

__device__ __forceinline__ void p6_hgrn_post(Frame& F, const Args& args) {
    const bf16* P = (const bf16*)(F.ws + WS_PROJ); const float* OH = (const float*)(F.ws + WS_OHG); bf16* YB = (bf16*)(F.ws + WS_YB);
    const int gw = F.vcu * NWAVES + F.wave, NGW = F.G * NWAVES;
    const float g0 = args.in[19][F.lane], g1 = args.in[19][64 + F.lane];
    for (int p = gw; p < M * HNH; p += NGW) { const int m = p >> 3, h = p & 7;
        const float o0 = OH[(size_t)m * 1024 + h * 128 + F.lane], o1 = OH[(size_t)m * 1024 + h * 128 + 64 + F.lane];
        const float rs = 1.0f / sqrtf(wave_sum(o0 * o0 + o1 * o1) * (1.0f / 128.0f) + NORM_EPS);
        const bf16* og = P + (size_t)m * NPROJ + HG_BASE + 3072 + h * 128 + F.lane; const float z0 = bf2f(og[0]), z1 = bf2f(og[64]);
        YB[(size_t)m * 1024 + h * 128 + F.lane] = (bf16)f2bf(o0 * rs * g0 * (z0 * sigmoidf_(z0)));
        YB[(size_t)m * 1024 + h * 128 + 64 + F.lane] = (bf16)f2bf(o1 * rs * g1 * (z1 * sigmoidf_(z1))); }
}

typedef float f32x4_ __attribute__((ext_vector_type(4)));
__device__ __forceinline__ void p9_norm2_router(Frame& F, const Args& args) {
    const bf16* X1 = (const bf16*)(F.ws + WS_X1); const float* mod = (const float*)(F.ws + WS_MOD); unsigned char* H8 = F.ws + WS_XG; const bf16* rwh = (const bf16*)(F.ws + WS_RWP); const bf16* rwl = rwh + NE * D;
    int* tk_e = (int*)(F.ws + WS_ROUTE + RT_E); int* tk_rank = (int*)(F.ws + WS_ROUTE + RT_RANK); float* tk_gate = (float*)(F.ws + WS_ROUTE + RT_GATE);
    constexpr int CP = 264;
    LAS bf16* hsh = (LAS bf16*)F.lds;
    LAS bf16* hsl = hsh + 64 * CP;
    LAS bf16* bsh = hsl + 64 * CP;
    LAS bf16* bsl = bsh + 32 * CP;
    LAS float* rstd_l = (LAS float*)(bsl + 32 * CP);
    LAS float* lg = rstd_l + 64;
    LAS int* lcnt = (LAS int*)(lg + 64 * 32);
    LAS int* lbase = lcnt + 32;
    LAS int* res_e = lbase + 32;
    LAS int* res_r = res_e + 256;
    LAS float* res_g = (LAS float*)(res_r + 256);
    const int lane = F.lane, wave = F.wave, tid = F.tid;
    for (int rg = F.vcu; rg < M / 64; rg += F.G) {
        const int b = rg / (SEQ / 64), m0 = rg * 64;
        const float* sh2 = mod + (size_t)b * 12288 + 3 * D; const float* sc2 = mod + (size_t)b * 12288 + 4 * D;
        __syncthreads();
        if (tid < 32) lcnt[tid] = 0;
        { float pq[8];
#pragma unroll
          for (int i = 0; i < 8; ++i) pq[i] = (lane < 32) ? ((const GAS float*)(F.ws + WS_MODP))[(size_t)(m0 + wave * 8 + i) * 32 + lane] : 0.f;
#pragma unroll
          for (int i = 0; i < 8; ++i) { const float rs = 1.0f / sqrtf(wave_sum(pq[i]) * (1.0f / D) + NORM_EPS); if (lane == 0) rstd_l[wave * 8 + i] = rs; } }
        __syncthreads();
        const int rt = wave >> 1, nt = wave & 1;
        f32x4 acc = (f32x4){0.f, 0.f, 0.f, 0.f};
        v2u xq[8];
#pragma unroll
        for (int p = 0; p < 8; ++p) xq[p] = *(const GAS v2u*)(X1 + (size_t)(m0 + p * 8 + (tid >> 6)) * D + 4 * (tid & 63));
        f32x4 gq = *(const GAS f32x4*)(args.in[5] + 4 * (tid & 63)), shq = *(const GAS f32x4*)(sh2 + 4 * (tid & 63)), scq = *(const GAS f32x4*)(sc2 + 4 * (tid & 63));
        v4u bq[4];
#pragma unroll
        for (int i = 0; i < 4; ++i) { const int idx = tid + 512 * i, e = (idx & 1023) >> 5, k16 = idx & 31; bq[i] = *(const GAS v4u*)(((idx >> 10) ? rwl : rwh) + (size_t)e * D + 8 * k16); }
        for (int ch = 0; ch < 8; ++ch) {
#pragma unroll
            for (int i = 0; i < 4; ++i) { const int idx = tid + 512 * i, e = (idx & 1023) >> 5, k16 = idx & 31; *(LAS v4u*)(((idx >> 10) ? bsl : bsh) + e * CP + 8 * k16) = bq[i]; }
#pragma unroll
            for (int p = 0; p < 8; ++p) { const int rl = p * 8 + (tid >> 6), c = ch * 256 + 4 * (tid & 63);
                const v2u xv = xq[p]; const f32x4 v = (f32x4){bflo(xv.x), bfhi(xv.x), bflo(xv.y), bfhi(xv.y)};
                const f32x4 hv = v * rstd_l[rl] * gq * (scq + 1.0f) + shq;
                { v2u wh, wl; wh.x = pk2(hv.x, hv.y); wh.y = pk2(hv.z, hv.w);
                  wl.x = pk2(hv.x - bflo(wh.x), hv.y - bfhi(wh.x)); wl.y = pk2(hv.z - bflo(wh.y), hv.w - bfhi(wh.y));
                  *(LAS v2u*)(hsh + rl * CP + 4 * (tid & 63)) = wh; *(LAS v2u*)(hsl + rl * CP + 4 * (tid & 63)) = wl; }
                int q8 = 0; q8 = __builtin_amdgcn_cvt_pk_fp8_f32(fminf(fmaxf(hv.x * H8_SCALE, -448.f), 448.f), fminf(fmaxf(hv.y * H8_SCALE, -448.f), 448.f), q8, false);
                q8 = __builtin_amdgcn_cvt_pk_fp8_f32(fminf(fmaxf(hv.z * H8_SCALE, -448.f), 448.f), fminf(fmaxf(hv.w * H8_SCALE, -448.f), 448.f), q8, true);
                *(GAS int*)(H8 + (size_t)(m0 + rl) * D + c) = q8; }
            if (ch < 7) { const int cn = (ch + 1) * 256 + 4 * (tid & 63);
#pragma unroll
                for (int p = 0; p < 8; ++p) xq[p] = *(const GAS v2u*)(X1 + (size_t)(m0 + p * 8 + (tid >> 6)) * D + cn);
                gq = *(const GAS f32x4*)(args.in[5] + cn); shq = *(const GAS f32x4*)(sh2 + cn); scq = *(const GAS f32x4*)(sc2 + cn);
#pragma unroll
                for (int i = 0; i < 4; ++i) { const int idx = tid + 512 * i, e = (idx & 1023) >> 5, k16 = idx & 31; bq[i] = *(const GAS v4u*)(((idx >> 10) ? rwl : rwh) + (size_t)e * D + (ch + 1) * 256 + 8 * k16); } }
            __syncthreads();
#pragma unroll
            for (int ks = 0; ks < 8; ++ks) {
                const int ao = (16 * rt + (lane & 15)) * CP + 32 * ks + 8 * (lane >> 4);
                const int bo = (16 * nt + (lane & 15)) * CP + 32 * ks + 8 * (lane >> 4);
                const bf16x8_t ah = *(const LAS bf16x8_t*)(hsh + ao), al = *(const LAS bf16x8_t*)(hsl + ao), bh = *(const LAS bf16x8_t*)(bsh + bo), bl = *(const LAS bf16x8_t*)(bsl + bo);
                acc = __builtin_amdgcn_mfma_f32_16x16x32_bf16(ah, bh, acc, 0, 0, 0); acc = __builtin_amdgcn_mfma_f32_16x16x32_bf16(ah, bl, acc, 0, 0, 0); acc = __builtin_amdgcn_mfma_f32_16x16x32_bf16(al, bh, acc, 0, 0, 0);
            }
            __syncthreads();
        }
#pragma unroll
        for (int i = 0; i < 4; ++i) lg[(16 * rt + 4 * (lane >> 4) + i) * 32 + 16 * nt + (lane & 15)] = acc[i] + args.in[24][16 * nt + (lane & 15)];
        __syncthreads();
        if (tid < 64) {
            float v[32];
#pragma unroll
            for (int e = 0; e < 32; ++e) v[e] = lg[tid * 32 + e];
            float tv[4]; int ti[4];
#pragma unroll
            for (int k = 0; k < 4; ++k) { float best = -3.0e38f; int bi = 0;
#pragma unroll
                for (int e = 0; e < 32; ++e) { const bool gt = v[e] > best; best = gt ? v[e] : best; bi = gt ? e : bi; }
                tv[k] = best; ti[k] = bi;
#pragma unroll
                for (int e = 0; e < 32; ++e) v[e] = (e == bi) ? -3.0e38f : v[e]; }
            const float e1 = __expf(tv[1] - tv[0]), e2 = __expf(tv[2] - tv[0]), e3 = __expf(tv[3] - tv[0]); const float inv = 1.0f / (1.0f + e1 + e2 + e3);
            const float gt4[4] = {inv, e1 * inv, e2 * inv, e3 * inv};
#pragma unroll
            for (int k = 0; k < 4; ++k) { res_e[tid * 4 + k] = ti[k]; res_g[tid * 4 + k] = gt4[k]; res_r[tid * 4 + k] = atomicAdd((int*)&lcnt[ti[k]], 1); }
        }
        __syncthreads();
        if (tid < 32) lbase[tid] = (int)__hip_atomic_fetch_add((unsigned*)(F.ctl + CW_CNT) + tid, (unsigned)lcnt[tid], RLX_AGENT);
        __syncthreads();
        if (tid < 256) { const int e = res_e[tid]; const size_t p = (size_t)m0 * 4 + tid; tk_e[p] = e; tk_rank[p] = lbase[e] + res_r[tid]; tk_gate[p] = res_g[tid]; }
    }
}

__device__ __forceinline__ void p10_dispatch(Frame& F, const Args& args) {
    const int* tk_e = (const int*)(F.ws + WS_ROUTE + RT_E); const int* tk_rank = (const int*)(F.ws + WS_ROUTE + RT_RANK); const float* tk_gate = (const float*)(F.ws + WS_ROUTE + RT_GATE);
    int* tok_slot = (int*)(F.ws + WS_ROUTE + RT_TOKSLOT); float* slot_w = (float*)(F.ws + WS_ROUTE + RT_SLOTW); int* tile_e = (int*)(F.ws + WS_ROUTE + RT_TILEE); int* slot_tok = (int*)(F.ws + WS_ROUTE + RT_SLOTTOK);
    LAS int* tstart = (LAS int*)F.lds;
    __syncthreads();
    if (F.tid < NE) tstart[40 + F.tid] = (int)__hip_atomic_load((unsigned*)(F.ctl + CW_CNT) + F.tid, RLX_AGENT);
    __syncthreads();
    if (F.tid == 0) { int s = 0; for (int e = 0; e < NE; ++e) { tstart[e] = s; s += (tstart[40 + e] + 255) >> 8; } tstart[NE] = s; }
    __syncthreads();
    if (blockIdx.x == 0) { const int nt = tstart[NE]; for (int t = F.tid; t <= MAXTILES; t += 512) { int e = -1; if (t < nt) { e = 0; while (tstart[e + 1] <= t) ++e; } if (t < MAXTILES) tile_e[t] = (e < 0) ? 0 : e; else tile_e[MAXTILES] = nt; } }
    for (int e = F.vcu; e < NE; e += F.G) { const int cn = tstart[40 + e], base = 256 * tstart[e], pe = ((cn + 255) >> 8) << 8; for (int s = cn + F.tid; s < pe; s += 512) slot_tok[base + s] = 0; }
    const int gt = F.vcu * 512 + F.tid, NGT = F.G * 512;
    for (int p = gt; p < NASSIGN; p += NGT) { const int e = tk_e[p], slot = 256 * tstart[e] + tk_rank[p]; tok_slot[p] = slot; slot_w[slot] = tk_gate[p]; slot_tok[slot] = p >> 2; }
}

__device__ __forceinline__ void p13_final(Frame& F, const Args& args) {
    const bf16* X1 = (const bf16*)(F.ws + WS_X1); const float* mod = (const float*)(F.ws + WS_MOD); const unsigned char* YE = F.ws + WS_YE; const int* tok_slot = (const int*)(F.ws + WS_ROUTE + RT_TOKSLOT);
    const int gw = F.vcu * NWAVES + F.wave, NGW = F.G * NWAVES;
    typedef int i32x4 __attribute__((ext_vector_type(4)));
    f32x4 fg[8];
#pragma unroll
    for (int j = 0; j < 4; ++j)
#pragma unroll
        for (int hh = 0; hh < 2; ++hh) fg[2 * j + hh] = *(const GAS f32x4*)(args.in[29] + 512 * j + 8 * F.lane + 4 * hh);
    i32x4 sl = *(const GAS i32x4*)(tok_slot + 4 * (gw < M ? gw : 0));
    for (int m = gw; m < M; m += NGW) {
        const int b = m / SEQ; const float* g2 = mod + (size_t)b * 12288 + 5 * D;
        const int s0 = sl.x, s1 = sl.y, s2 = sl.z, s3 = sl.w;
        { const int mn = (m + NGW < M) ? m + NGW : m; sl = *(const GAS i32x4*)(tok_slot + 4 * mn); }
        const GAS v4u* xr = (const GAS v4u*)(X1 + (size_t)m * D) + F.lane;
        f32x4 v[8]; float ss = 0.f;
#pragma unroll
        for (int j = 0; j < 4; ++j) { const int c = 512 * j + 8 * F.lane;
            const v2u y0 = *(const GAS v2u*)(YE + (size_t)s0 * D + c), y1 = *(const GAS v2u*)(YE + (size_t)s1 * D + c), y2 = *(const GAS v2u*)(YE + (size_t)s2 * D + c), y3 = *(const GAS v2u*)(YE + (size_t)s3 * D + c);
            const v4u xv = xr[64 * j];
            const unsigned q0[2] = {y0.x, y0.y}, q1[2] = {y1.x, y1.y}, q2[2] = {y2.x, y2.y}, q3[2] = {y3.x, y3.y}; const unsigned xw[4] = {xv.x, xv.y, xv.z, xv.w};
#pragma unroll
            for (int hh = 0; hh < 2; ++hh) {
                const f32x2 a0 = __builtin_amdgcn_cvt_pk_f32_fp8((int)q0[hh], false), a1 = __builtin_amdgcn_cvt_pk_f32_fp8((int)q0[hh], true), b0 = __builtin_amdgcn_cvt_pk_f32_fp8((int)q1[hh], false), b1 = __builtin_amdgcn_cvt_pk_f32_fp8((int)q1[hh], true);
                const f32x2 c0 = __builtin_amdgcn_cvt_pk_f32_fp8((int)q2[hh], false), c1 = __builtin_amdgcn_cvt_pk_f32_fp8((int)q2[hh], true), d0 = __builtin_amdgcn_cvt_pk_f32_fp8((int)q3[hh], false), d1 = __builtin_amdgcn_cvt_pk_f32_fp8((int)q3[hh], true);
                const f32x2 lo = ((a0 + b0) + c0) + d0, hi = ((a1 + b1) + c1) + d1;
                const f32x4 f = (f32x4){lo.x, lo.y, hi.x, hi.y} * (1.0f / Y8_SCALE);
                const f32x4 x4 = (f32x4){bflo(xw[2 * hh]), bfhi(xw[2 * hh]), bflo(xw[2 * hh + 1]), bfhi(xw[2 * hh + 1])};
                v[2 * j + hh] = x4 + *(const GAS f32x4*)(g2 + c + 4 * hh) * f;
                ss += (v[2 * j + hh].x * v[2 * j + hh].x + v[2 * j + hh].y * v[2 * j + hh].y) + (v[2 * j + hh].z * v[2 * j + hh].z + v[2 * j + hh].w * v[2 * j + hh].w); } }
        const float rstd = 1.0f / sqrtf(wave_sum(ss) * (1.0f / D) + NORM_EPS);
        float* orow = args.out + (size_t)m * D;
#pragma unroll
        for (int j = 0; j < 4; ++j)
#pragma unroll
            for (int hh = 0; hh < 2; ++hh) { const int c = 512 * j + 8 * F.lane + 4 * hh; *(GAS f32x4*)(orow + c) = v[2 * j + hh] * rstd * fg[2 * j + hh]; }
    }
}

__global__ void __launch_bounds__(NWAVES * 64, 2) mk_fwd(Args args) {
    extern __shared__ __attribute__((aligned(16))) unsigned char lds[];
    Frame F;
    F.lds = (LAS unsigned char*)lds;
    F.MISC = (volatile LAS unsigned*)(F.lds + MISC_OFF);
    F.tid = threadIdx.x; F.lane = F.tid & 63; F.wave = __builtin_amdgcn_readfirstlane(F.tid >> 6);
    F.G = gridDim.x; { const int bx = blockIdx.x; F.vcu = (F.G % 8 == 0) ? (bx % 8) * (F.G / 8) + bx / 8 : bx; }
    F.ws = args.ws; F.ctl = (gu32*)(args.ws + WS_CTL);
    for (int u = F.tid; u < 64; u += NWAVES * 64) ((LAS unsigned*)(F.lds + MISC_OFF))[u] = 0u;
    __syncthreads();
    XcdBarrier bar; bar.bar = (unsigned*)(F.ctl + CW_BAR); bar.x = 0; bar.st = nullptr;
    if (N_LAUNCHES == 1) bar = xcd_barrier_post((unsigned*)(F.ctl + CW_BAR), F.MISC + 8);
#define GRID_BAR() do { if (N_LAUNCHES == 1) { xcd_barrier(bar); } } while (0)
    const int lo = args.ph_lo, hi = args.ph_hi;
#ifndef PROBE_REPEAT
#define PROBE_REPEAT 0
#endif
#define REP(k) for (int rep_ = 0; rep_ < (((PROBE_REPEAT) >> (k)) & 1) + 1; ++rep_)
#define IN(k) (lo <= (k) && (k) < hi)
#define BOTH(k) (IN(k) && IN((k) + 1))
    unsigned char* ws = args.ws;
    pg8::bf16_t* const Hb = (pg8::bf16_t*)(ws + WS_H); pg8::bf16_t* const PROJ = (pg8::bf16_t*)(ws + WS_PROJ);

    if (IN(0)) REP(0) { p0_prologue(F, args); if (BOTH(0)) GRID_BAR(); }
    if (IN(1)) REP(1) { p1_norm1(F, args); if (BOTH(1)) GRID_BAR(); }
    if (IN(2)) REP(2) {
        const int bx = (int)blockIdx.x; const bool ded = (F.G == 256) && bx >= P2_GEMM_WGS;
        pg8::Gemm g{Hb, (const pg8::bf16_t*)(ws + WS_WIN), M, NPROJ, D, 0}; pg8::StaticOrder S; S.init(M, NPROJ, (F.G == 256) ? P2_GEMM_WGS : F.G, bx);
        pg8::EpiBf16<0> E{PROJ, NPROJ, nullptr, 0, 0, 1.f};
        if (!ded) pg8::gemm_phase<pg8::EpiBf16<0>, pg8::StaticOrder, PG8_ALIGN, PG8_SP2>(F.lds, g, S, E);
        if (F.G == 256) {
            if (ded) p8_convert(F, args, P8_SPLITD, P8_SPLITR, (bx - P2_GEMM_WGS) * NWAVES + F.wave, (256 - P2_GEMM_WGS) * NWAVES, 0);
            else if (bx >= P2_NFULL) p8_convert(F, args, P8_SPLITA, P8_SPLIT, (bx - P2_NFULL) * NWAVES + F.wave, (P2_GEMM_WGS - P2_NFULL) * NWAVES, 0); }
        else { p8_convert(F, args, P8_SPLITD, P8_SPLITR, F.vcu * NWAVES + F.wave, F.G * NWAVES, 0); p8_convert(F, args, P8_SPLITA, P8_SPLIT, F.vcu * NWAVES + F.wave, F.G * NWAVES, 0); }
        if (BOTH(2)) GRID_BAR();
    }
    if (IN(3)) REP(3) { p3_lora_a(F, args); if (BOTH(3)) GRID_BAR(); }
    if (IN(4)) REP(4) {
        pg8::Gemm g{(const pg8::bf16_t*)(ws + WS_LORA_A), (const pg8::bf16_t*)(ws + WS_WLORA), M, LORA_N, LORA_K, 0}; pg8::StaticOrder S; S.init(M, LORA_N, F.G, (int)blockIdx.x);
        pg8::EpiBf16<0> E{(pg8::bf16_t*)(ws + WS_LORA_O), LORA_N, nullptr, 0, 0, 1.f};
        pg8::gemm_phase<pg8::EpiBf16<0>, pg8::StaticOrder, PG8_ALIGN, PG8_SP2>(F.lds, g, S, E);
        if (BOTH(4)) GRID_BAR();
    }
    if (IN(5)) REP(5) {
        if (F.G == 256) { const int bx = (int)blockIdx.x;
            if (bx < 128) { rwkv_chunk_scan(F, args, bx); __syncthreads(); p8_convert(F, args, P8_SPLITR, P8_SPLITH, bx * NWAVES + F.wave, 128 * NWAVES, 0); } else if (bx < 192) { hgrn_chunk_scan(F, args, bx - 128); __syncthreads(); p8_convert(F, args, P8_SPLITH, P8_SPLITA, (bx - 128) * NWAVES + F.wave, 64 * NWAVES, 0); } else p8_convert(F, args, P8_SPLIT, P8_N, (bx - 192) * NWAVES + F.wave, 64 * NWAVES, 0); }
        else { for (int u = F.vcu; u < 192; u += F.G) { if (u < 128) rwkv_chunk_scan(F, args, u); else hgrn_chunk_scan(F, args, u - 128); } __syncthreads(); p8_convert(F, args, P8_SPLITR, P8_SPLITA, F.vcu * NWAVES + F.wave, F.G * NWAVES, 0); p8_convert(F, args, P8_SPLIT, P8_N, F.vcu * NWAVES + F.wave, F.G * NWAVES, 0); }
        if (BOTH(5)) GRID_BAR();
        if ((PROBE_REPEAT >> 14) & 1) { for (int u = F.vcu; u < 192; u += F.G) { if (u < 128) rwkv_chunk_scan(F, args, u); } GRID_BAR(); }
        if ((PROBE_REPEAT >> 15) & 1) { for (int u = F.vcu; u < 192; u += F.G) { if (u >= 128) hgrn_chunk_scan(F, args, u - 128); } GRID_BAR(); }
    }
    if (IN(6)) {   }
    if (IN(7)) REP(7) {
        pg8::Gemm g{(const pg8::bf16_t*)(ws + WS_YA), (const pg8::bf16_t*)(ws + WS_WPA), M, D, RW, 0, nullptr, (const pg8::bf16_t*)(ws + WS_YB), (const pg8::bf16_t*)(ws + WS_WPB)}; pg8::PairOrder S; S.init(M, D, F.G, (int)blockIdx.x);
        pg8::EpiMerge E{PROJ + GATE_BASE, NPROJ, D, (pg8::bf16_t*)(ws + WS_MERGED), D};
        pg8::gemm_phase<pg8::EpiMerge, pg8::PairOrder, PG8_ALIGN, PG8_SP2>(F.lds, g, S, E);
        if (BOTH(7)) GRID_BAR();
    }
    if (IN(8)) REP(8) {
        pg8::Gemm g{(const pg8::bf16_t*)(ws + WS_MERGED), (const pg8::bf16_t*)(ws + WS_WOUT), M, D, D, 0}; pg8::StaticOrder S; S.init(M, D, F.G, (int)blockIdx.x);
        pg8::EpiRes E{args.in[0], (pg8::bf16_t*)(ws + WS_X1), D, (const float*)(ws + WS_MOD) + 2 * D, 12288, SEQ, (float*)(ws + WS_MODP)};
        pg8::gemm_phase<pg8::EpiRes, pg8::StaticOrder, PG8_ALIGN, PG8_SP2>(F.lds, g, S, E);
        if (BOTH(8)) GRID_BAR();
    }
    if ((PROBE_REPEAT >> 16) & 1) { if (IN(8)) {
        pg8::Gemm g{(const pg8::bf16_t*)(ws + WS_MERGED), (const pg8::bf16_t*)(ws + WS_WOUT), M, D, D, 0}; pg8::StaticOrder S; S.init(M, D, F.G, (int)blockIdx.x);
        pg8::EpiNull E{(float*)(ws + WS_T1)};
        pg8::gemm_phase<pg8::EpiNull, pg8::StaticOrder, PG8_ALIGN, PG8_SP2>(F.lds, g, S, E);
        GRID_BAR();
        if ((PROBE_REPEAT >> 17) & 1) { pg8::gemm_phase<pg8::EpiNull, pg8::StaticOrder, PG8_ALIGN, PG8_SP2>(F.lds, g, S, E); GRID_BAR(); } } }
    if (IN(9)) REP(9) { p9_norm2_router(F, args); if (BOTH(9)) GRID_BAR(); }
    if (IN(10)) REP(10) { p10_dispatch(F, args); if (BOTH(10)) GRID_BAR(); }
    if (IN(11)) REP(11) {
        const int* tile_e = (const int*)(ws + WS_ROUTE + RT_TILEE); const int nt = tile_e[MAXTILES];
        pg8::Gemm g{(const pg8::bf16_t*)(ws + WS_XG), (const pg8::bf16_t*)(ws + WS_WGU), nt * 256, 2 * DE, D / 2, (size_t)2 * DE * D, (const int*)(ws + WS_ROUTE + RT_SLOTTOK)};     pg8::GroupedOrder S; S.init(nt * 256, 2 * DE, F.G, (int)blockIdx.x); S.tile_e = tile_e;
        pg8::EpiSwigluF8 E{ws + WS_ACT, DE, args.in[26], DE, 1.0f / (W8_SCALE * H8_SCALE), A8_SCALE};
        pg8::gemm_phase<pg8::EpiSwigluF8, pg8::GroupedOrder, PG8_ALIGN, PG8_SP2, true, true>(F.lds, g, S, E);
        {
            const int nwg = nt * ((2 * DE) / 256), R = (nwg + F.G - 1) / F.G, nfull = nwg - F.G * (R - 1), s = F.G - nfull, bx = (int)blockIdx.x;
            const int capA = (P11_TAIL_ITEMS * s < P8_Q) ? P11_TAIL_ITEMS * s : P8_Q;
            if (s > 0 && bx >= nfull) p8_convert(F, args, P8_N, P8_N + capA, (bx - nfull) * NWAVES + F.wave, s * NWAVES, 0);
            if (capA < P8_Q) p8_convert(F, args, P8_N + capA, P8_N + P8_Q, F.vcu * NWAVES + F.wave, F.G * NWAVES, 0);
        }
        if (BOTH(11)) GRID_BAR();
    }
    if (IN(12)) REP(12) {
        const int* tile_e = (const int*)(ws + WS_ROUTE + RT_TILEE); const int nt = tile_e[MAXTILES];
        pg8::Gemm g{(const pg8::bf16_t*)(ws + WS_ACT), (const pg8::bf16_t*)(ws + WS_WDN), nt * 256, D, DE / 2, (size_t)D * DE, nullptr}; pg8::GroupedOrder S; S.init(nt * 256, D, F.G, (int)blockIdx.x); S.tile_e = tile_e;
        pg8::EpiDown E{ws + WS_YE, D, args.in[28], (const float*)(ws + WS_ROUTE + RT_SLOTW), 1.0f / (W8_SCALE * A8_SCALE), Y8_SCALE};
        pg8::gemm_phase<pg8::EpiDown, pg8::GroupedOrder, PG8_ALIGN, PG8_SP2, false, true>(F.lds, g, S, E);
        if (BOTH(12)) GRID_BAR();
    }
    if (IN(13)) REP(13) { p13_final(F, args); }
#undef IN
#undef BOTH
}

extern "C" void kernel_launch(void* const* d_in, const int* in_sizes, int n_in, void* d_out, int out_size, void* d_ws, size_t ws_size, hipStream_t stream) {
    static int grid = 0;
    if (grid == 0) {
        if (n_in != 30 || out_size != M * D || ws_size < WS_END) { fprintf(stderr, "kernel_launch: unexpected shapes (n_in %d, out %d, ws %zu)\n", n_in, out_size, ws_size); grid = -1; return; }
        int dev = 0, cus = 0, per_cu = 0;
        if (hipGetDevice(&dev) != hipSuccess || hipDeviceGetAttribute(&cus, hipDeviceAttributeMultiprocessorCount, dev) != hipSuccess) { grid = -1; return; }
        if (hipFuncSetAttribute((const void*)mk_fwd, hipFuncAttributeMaxDynamicSharedMemorySize, LDS_BYTES) != hipSuccess) { fprintf(stderr, "kernel_launch: hipFuncSetAttribute failed\n"); grid = -1; return; }
        if (hipOccupancyMaxActiveBlocksPerMultiprocessor(&per_cu, (const void*)mk_fwd, NWAVES * 64, LDS_BYTES) != hipSuccess || per_cu < 1) fprintf(stderr, "kernel_launch: occupancy query reports %d\n", per_cu);
        (void)hipGetLastError();
        grid = cus;
    }
    if (grid < 0) return;
    (void)in_sizes;
    if (hipMemsetAsync((char*)d_ws + WS_CTL, 0, CTL_ZERO_BYTES, stream) != hipSuccess) return;
    Args a{};
    for (int i = 0; i < 30; ++i) a.in[i] = (const float*)d_in[i];
    a.out = (float*)d_out; a.ws = (unsigned char*)d_ws;
    for (int li = 0; li < N_LAUNCHES; ++li) {
        a.ph_lo = (N_LAUNCHES == 1) ? 0 : li; a.ph_hi = (N_LAUNCHES == 1) ? N_PHASES : li + 1; a.li = li; a.pad = 0;
        hipLaunchKernelGGL(mk_fwd, dim3(grid), dim3(NWAVES * 64), LDS_BYTES, stream, a);
        const hipError_t le = hipPeekAtLastError();
        if (le != hipSuccess) { fprintf(stderr, "kernel_launch: launch %d failed: %s\n", li, hipGetErrorName(le)); break; }
    }
}
```

```cpp
#include <hip/hip_runtime.h>
#include <cstdio>
#include <cstdint>
namespace pg8 {
#define PG8_LAS __attribute__((address_space(3)))
typedef unsigned short bf16_t;
typedef short bf16x8 __attribute__((ext_vector_type(8)));
typedef float f32x4 __attribute__((ext_vector_type(4)));
typedef unsigned u32x4 __attribute__((ext_vector_type(4)));
typedef int i32x4_t __attribute__((ext_vector_type(4)));
constexpr int BM = 256, BK = 64, HALF = 128, HTB = HALF * BK * 2  , STAGE_BYTES = 8 * HTB, NXCD = 8, WGM = 8;

__host__ __device__ __forceinline__ int lds_byte(int r, int c) { const int st = (r >> 4) * 2 + (c >> 5), rr = r & 15, cc = c & 31, ob = rr * 64 + cc * 2; return st * 1024 + (ob ^ (((ob >> 9) & 1) << 5)); }
__host__ __device__ __forceinline__ void stage_rc(int b, int& R, int& C) { const int st = b / 1024, sb = b % 1024, swz = sb ^ (((sb >> 9) & 1) << 5); R = (st >> 1) * 16 + swz / 64; C = (st & 1) * 32 + (swz % 64) / 2; }
__host__ __device__ __forceinline__ int perm32(int rho) { const int n = rho >> 4, i = rho & 15; return 8 * (i >> 2) + 4 * n + (i & 3); }

struct Unit { int pm, pn, e, kh; };
struct Gemm { const bf16_t* A; const bf16_t* Bt; int M, N, K; size_t bgs; const int* gather; const bf16_t* A2; const bf16_t* Bt2; };

struct StaticOrder {
    static constexpr bool PAIRS = false;
    int nM, nN, nwg, G, c;
    __host__ __device__ void init(int M, int N, int G_, int c_) { nM = M / BM; nN = N / BM; nwg = nM * nN; G = G_; c = c_; }
    __host__ __device__ bool next(int i, Unit& u) const {
        const long L = (long)i * G + c; if (L >= nwg) return false;
        int wgid = (int)L; { const int q = nwg / NXCD, r = nwg % NXCD, xcd = wgid % NXCD, off = wgid / NXCD; wgid = (xcd < r ? xcd * (q + 1) : r * (q + 1) + (xcd - r) * q) + off; }
        const int nig = WGM * nN, gid = wgid / nig, fm = gid * WGM, gsz = (nM - fm) < WGM ? (nM - fm) : WGM;
        u.pm = fm + ((wgid % nig) % gsz); u.pn = (wgid % nig) / gsz; u.e = 0; u.kh = 0; return true;
    }
    __device__ __forceinline__ void a_ready(const Unit&) const {}
    __device__ __forceinline__ void done(const Unit&) const {}
};

__device__ __forceinline__ unsigned cvt_pk_bf16(float lo, float hi) { unsigned r; asm volatile("v_cvt_pk_bf16_f32 %0, %1, %2" : "=v"(r) : "v"(lo), "v"(hi)); return r; }
typedef float f32x2 __attribute__((ext_vector_type(2)));
__device__ __forceinline__ f32x2 gelu_pk(f32x2 v) {
    const f32x2 av = __builtin_elementwise_abs(v), d = av * 0.2316418882f + 1.0f;
    f32x2 t; t.x = __builtin_amdgcn_rcpf(d.x); t.y = __builtin_amdgcn_rcpf(d.y);
    f32x2 q = t * 0.5307027145f + (-0.7265760135f); q = q * t + 0.7107068705f; q = q * t + (-0.142248368f); q = q * t + 0.127414796f; q = q * t;
    const f32x2 s = (v * v) * (-0.72134752044f);
    f32x2 e; e.x = __builtin_amdgcn_exp2f(s.x); e.y = __builtin_amdgcn_exp2f(s.y);
    const f32x2 m = v * (q * e), r = v - m;
    f32x2 o; o.x = v.x < 0.f ? m.x : r.x; o.y = v.y < 0.f ? m.y : r.y; return o;
}

template <int ACT  > struct EpiBf16 {
    static constexpr bool PERM = true, AFTER_DRAIN = false, MID = false; static_assert(ACT == 0 || ACT == 1, "EpiBf16: ACT is 0 (none) or 1 (gelu_pk)");
    bf16_t* O; int ldc; const float* bias; int split_cols; size_t split_stride; float scale0;
    __device__ __forceinline__ void operator()(const f32x4 (&acc)[2][2][4][2], const Unit& u, int wr, int wc, int fr, int fq) const {
        const int row0 = u.pm * BM + wr * 64 + fr; int colt = u.pn * BM; bf16_t* base = O;
        float sc = 1.f; if (split_cols) { const int t = colt / split_cols; base += (size_t)t * split_stride; colt -= t * split_cols; if (t == 0) sc = scale0; }
        const int col0 = colt + wc * 32 + 8 * fq, bcol0 = u.pn * BM + wc * 32 + 8 * fq;
        f32x4 bv[2][2];
#pragma unroll
        for (int bj = 0; bj < 2; ++bj)
#pragma unroll
            for (int n = 0; n < 2; ++n) bv[bj][n] = bias ? *(const f32x4*)(bias + bcol0 + bj * HALF + 4 * n) : (f32x4){0.f, 0.f, 0.f, 0.f};
#pragma unroll
        for (int ai = 0; ai < 2; ++ai)
#pragma unroll
            for (int m = 0; m < 4; ++m) { bf16_t* rowp = base + (size_t)(row0 + ai * HALF + m * 16) * ldc + col0;
#pragma unroll
                for (int bj = 0; bj < 2; ++bj) { f32x4 v0 = acc[ai][bj][m][0] + bv[bj][0], v1 = acc[ai][bj][m][1] + bv[bj][1];
                    if (ACT == 1) { f32x2 a = gelu_pk((f32x2){v0[0], v0[1]}), b = gelu_pk((f32x2){v0[2], v0[3]}), c = gelu_pk((f32x2){v1[0], v1[1]}), d = gelu_pk((f32x2){v1[2], v1[3]});
                        v0 = (f32x4){a.x, a.y, b.x, b.y}; v1 = (f32x4){c.x, c.y, d.x, d.y}; }
                    v0 = v0 * sc; v1 = v1 * sc; u32x4 w; w.x = cvt_pk_bf16(v0[0], v0[1]); w.y = cvt_pk_bf16(v0[2], v0[3]); w.z = cvt_pk_bf16(v1[0], v1[1]); w.w = cvt_pk_bf16(v1[2], v1[3]);
                    *(u32x4*)(rowp + bj * HALF) = w; } }
    }
};


__device__ __forceinline__ float bf_lo(unsigned w) { return __uint_as_float(w << 16); }
__device__ __forceinline__ float bf_hi(unsigned w) { return __uint_as_float(w & 0xffff0000u); }
__device__ __forceinline__ float sigm(float x) { return __builtin_amdgcn_rcpf(1.0f + __expf(-x)); }
typedef unsigned u32x2 __attribute__((ext_vector_type(2)));

struct EpiF32 {
    static constexpr bool PERM = false, AFTER_DRAIN = false, MID = false;
    float* C; int ldc;
    __device__ __forceinline__ void operator()(const f32x4 (&acc)[2][2][4][2], const Unit& u, int wr, int wc, int fr, int fq) const {
        const int row0 = u.pm * BM + wr * 64 + fr, col0 = u.pn * BM + wc * 32 + 4 * fq;
#pragma unroll
        for (int ai = 0; ai < 2; ++ai)
#pragma unroll
            for (int m = 0; m < 4; ++m) { float* rowp = C + (size_t)(row0 + ai * HALF + m * 16) * ldc + col0;
#pragma unroll
                for (int bj = 0; bj < 2; ++bj)
#pragma unroll
                    for (int n = 0; n < 2; ++n) *(f32x4*)(rowp + bj * HALF + n * 16) = acc[ai][bj][m][n]; }
    }
};
template <int PASS> struct EpiGate {
    static constexpr bool PERM = false, AFTER_DRAIN = false, MID = false;
    const bf16_t* gate; int ldg; bf16_t* T1; bf16_t* O; int ldc;
    __device__ __forceinline__ void operator()(const f32x4 (&acc)[2][2][4][2], const Unit& u, int wr, int wc, int fr, int fq) const {
        const int row0 = u.pm * BM + wr * 64 + fr, col0 = u.pn * BM + wc * 32 + 4 * fq;
#pragma unroll
        for (int ai = 0; ai < 2; ++ai) {
            u32x2 gv[4][2][2];
#pragma unroll
            for (int m = 0; m < 4; ++m) { const size_t r = (size_t)(row0 + ai * HALF + m * 16);
#pragma unroll
                for (int bj = 0; bj < 2; ++bj)
#pragma unroll
                    for (int n = 0; n < 2; ++n) gv[m][bj][n] = *(const u32x2*)(gate + r * ldg + col0 + bj * HALF + n * 16); }
#pragma unroll
            for (int mh = 0; mh < 2; ++mh) {
                u32x2 tv[2][2][2];
                if (PASS == 1) {
#pragma unroll
                    for (int m2 = 0; m2 < 2; ++m2) { const size_t r = (size_t)(row0 + ai * HALF + (2 * mh + m2) * 16);
#pragma unroll
                        for (int bj = 0; bj < 2; ++bj)
#pragma unroll
                            for (int n = 0; n < 2; ++n) tv[m2][bj][n] = *(const u32x2*)(T1 + r * ldc + col0 + bj * HALF + n * 16); } }
#pragma unroll
                for (int m2 = 0; m2 < 2; ++m2) { const int m = 2 * mh + m2; const size_t r = (size_t)(row0 + ai * HALF + m * 16);
#pragma unroll
                    for (int bj = 0; bj < 2; ++bj)
#pragma unroll
                        for (int n = 0; n < 2; ++n) { const int c = col0 + bj * HALF + n * 16; const u32x2 g2 = gv[m][bj][n];
                            f32x4 s; s[0] = sigm(bf_lo(g2.x)); s[1] = sigm(bf_hi(g2.x)); s[2] = sigm(bf_lo(g2.y)); s[3] = sigm(bf_hi(g2.y));
                            f32x4 v = acc[ai][bj][m][n] * s;
                            if (PASS == 0) { u32x2 w; w.x = cvt_pk_bf16(v[0], v[1]); w.y = cvt_pk_bf16(v[2], v[3]); *(u32x2*)(T1 + r * ldc + c) = w; }
                            else { const u32x2 t2 = tv[m2][bj][n]; v[0] += bf_lo(t2.x); v[1] += bf_hi(t2.x); v[2] += bf_lo(t2.y); v[3] += bf_hi(t2.y); u32x2 w; w.x = cvt_pk_bf16(v[0], v[1]); w.y = cvt_pk_bf16(v[2], v[3]); *(u32x2*)(O + r * ldc + c) = w; } } }
                asm volatile("" ::: "memory"); }
        }
    }
};
struct EpiMerge {
    static constexpr bool PERM = true, AFTER_DRAIN = false, MID = true;
    const bf16_t* gate; int ldg; int gboff; bf16_t* O; int ldc;
    __device__ __forceinline__ void mid(f32x4 (&acc)[2][2][4][2], const Unit& u, int wr, int wc, int fr, int fq) const {
        const int row0 = u.pm * BM + wr * 64 + fr, col0 = u.pn * BM + wc * 32 + 8 * fq;
#pragma unroll
        for (int ai = 0; ai < 2; ++ai) {
            u32x4 ga[4][2], gb[4][2];
#pragma unroll
            for (int m = 0; m < 4; ++m) { const bf16_t* gp = gate + (size_t)(row0 + ai * HALF + m * 16) * ldg + col0;
#pragma unroll
                for (int bj = 0; bj < 2; ++bj) { ga[m][bj] = *(const u32x4*)(gp + bj * HALF); gb[m][bj] = *(const u32x4*)(gp + gboff + bj * HALF); } }
#pragma unroll
            for (int m = 0; m < 4; ++m)
#pragma unroll
                for (int bj = 0; bj < 2; ++bj) { const u32x4 a = ga[m][bj], b = gb[m][bj]; f32x4 s0, s1;
                    s0[0] = sigm(bf_lo(a.x)) * (1.0f + __expf(-bf_lo(b.x))); s0[1] = sigm(bf_hi(a.x)) * (1.0f + __expf(-bf_hi(b.x)));
                    s0[2] = sigm(bf_lo(a.y)) * (1.0f + __expf(-bf_lo(b.y))); s0[3] = sigm(bf_hi(a.y)) * (1.0f + __expf(-bf_hi(b.y)));
                    s1[0] = sigm(bf_lo(a.z)) * (1.0f + __expf(-bf_lo(b.z))); s1[1] = sigm(bf_hi(a.z)) * (1.0f + __expf(-bf_hi(b.z)));
                    s1[2] = sigm(bf_lo(a.w)) * (1.0f + __expf(-bf_lo(b.w))); s1[3] = sigm(bf_hi(a.w)) * (1.0f + __expf(-bf_hi(b.w)));
                    acc[ai][bj][m][0] = acc[ai][bj][m][0] * s0; acc[ai][bj][m][1] = acc[ai][bj][m][1] * s1; }
            asm volatile("" ::: "memory"); }
    }
    __device__ __forceinline__ void operator()(const f32x4 (&acc)[2][2][4][2], const Unit& u, int wr, int wc, int fr, int fq) const {
        const int row0 = u.pm * BM + wr * 64 + fr, col0 = u.pn * BM + wc * 32 + 8 * fq;
#pragma unroll
        for (int ai = 0; ai < 2; ++ai) {
            u32x4 gb[4][2];
#pragma unroll
            for (int m = 0; m < 4; ++m) { const bf16_t* gp = gate + (size_t)(row0 + ai * HALF + m * 16) * ldg + col0 + gboff;
#pragma unroll
                for (int bj = 0; bj < 2; ++bj) gb[m][bj] = *(const u32x4*)(gp + bj * HALF); }
#pragma unroll
            for (int m = 0; m < 4; ++m) { bf16_t* op = O + (size_t)(row0 + ai * HALF + m * 16) * ldc + col0;
#pragma unroll
                for (int bj = 0; bj < 2; ++bj) { const u32x4 b = gb[m][bj]; const f32x4 a0 = acc[ai][bj][m][0], a1 = acc[ai][bj][m][1];
                    u32x4 w; w.x = cvt_pk_bf16(a0[0] * sigm(bf_lo(b.x)), a0[1] * sigm(bf_hi(b.x))); w.y = cvt_pk_bf16(a0[2] * sigm(bf_lo(b.y)), a0[3] * sigm(bf_hi(b.y)));
                    w.z = cvt_pk_bf16(a1[0] * sigm(bf_lo(b.z)), a1[1] * sigm(bf_hi(b.z))); w.w = cvt_pk_bf16(a1[2] * sigm(bf_lo(b.w)), a1[3] * sigm(bf_hi(b.w)));
                    *(u32x4*)(op + bj * HALF) = w; } }
            asm volatile("" ::: "memory"); }
    }
};
struct EpiRes {
    static constexpr bool PERM = true, AFTER_DRAIN = false, MID = false;
    const float* base; bf16_t* out; int ldc; const float* gvec; int bpitch; int rows_per_batch; float* ssq;
    __device__ __forceinline__ void operator()(const f32x4 (&acc)[2][2][4][2], const Unit& u, int wr, int wc, int fr, int fq) const {
        const int row0 = u.pm * BM + wr * 64 + fr, col0 = u.pn * BM + wc * 32 + 8 * fq;
        const float* gb = gvec + (size_t)((u.pm * BM) / rows_per_batch) * bpitch + col0;
        f32x4 gv[2][2];
#pragma unroll
        for (int bj = 0; bj < 2; ++bj)
#pragma unroll
            for (int n = 0; n < 2; ++n) gv[bj][n] = *(const f32x4*)(gb + bj * HALF + n * 4);
#pragma unroll
        for (int ai = 0; ai < 2; ++ai) {
            f32x4 bs[4][2][2];
#pragma unroll
            for (int m = 0; m < 4; ++m) { const size_t off = (size_t)(row0 + ai * HALF + m * 16) * ldc + col0;
#pragma unroll
                for (int bj = 0; bj < 2; ++bj)
#pragma unroll
                    for (int n = 0; n < 2; ++n) bs[m][bj][n] = *(const f32x4*)(base + off + bj * HALF + n * 4); }
#pragma unroll
            for (int m = 0; m < 4; ++m) { const size_t off = (size_t)(row0 + ai * HALF + m * 16) * ldc + col0; float sq = 0.f;
#pragma unroll
                for (int bj = 0; bj < 2; ++bj) { const f32x4 o0 = bs[m][bj][0] + gv[bj][0] * acc[ai][bj][m][0], o1 = bs[m][bj][1] + gv[bj][1] * acc[ai][bj][m][1];
                    u32x4 w; w.x = cvt_pk_bf16(o0[0], o0[1]); w.y = cvt_pk_bf16(o0[2], o0[3]); w.z = cvt_pk_bf16(o1[0], o1[1]); w.w = cvt_pk_bf16(o1[2], o1[3]);
                    *(u32x4*)(out + off + bj * HALF) = w;
                    sq += ((o0[0] * o0[0] + o0[1] * o0[1]) + (o0[2] * o0[2] + o0[3] * o0[3])) + ((o1[0] * o1[0] + o1[1] * o1[1]) + (o1[2] * o1[2] + o1[3] * o1[3])); }
                sq += __shfl_xor(sq, 16); sq += __shfl_xor(sq, 32);
                if (fq == 0) ssq[(size_t)(row0 + ai * HALF + m * 16) * 32 + 4 * u.pn + wc] = sq; }
            asm volatile("" ::: "memory"); }
    }
};
struct EpiSwiglu {
    static constexpr bool PERM = true, AFTER_DRAIN = false, MID = false;
    bf16_t* O; int ldc; const float* bias; int de;
    __device__ __forceinline__ void operator()(const f32x4 (&acc)[2][2][4][2], const Unit& u, int wr, int wc, int fr, int fq) const {
        const int row0 = u.pm * BM + wr * 64 + fr, cl = u.pn * HALF + wc * 32 + 8 * fq;
        const float* bb = bias + (size_t)u.e * 2 * de + cl;
        f32x4 bg[2], bl[2];
#pragma unroll
        for (int n = 0; n < 2; ++n) { bg[n] = *(const f32x4*)(bb + 4 * n); bl[n] = *(const f32x4*)(bb + de + 4 * n); }
#pragma unroll
        for (int ai = 0; ai < 2; ++ai)
#pragma unroll
            for (int m = 0; m < 4; ++m) { bf16_t* rowp = O + (size_t)(row0 + ai * HALF + m * 16) * ldc + cl;
                f32x4 a[2];
#pragma unroll
                for (int n = 0; n < 2; ++n) { const f32x4 g = acc[ai][0][m][n] + bg[n], l = acc[ai][1][m][n] + bl[n];
#pragma unroll
                    for (int j = 0; j < 4; ++j) { const float gg = fminf(g[j], 7.0f), ll = fminf(fmaxf(l[j], -7.0f), 7.0f); a[n][j] = gg * sigm(1.702f * gg) * (ll + 1.0f); } }
                u32x4 w; w.x = cvt_pk_bf16(a[0][0], a[0][1]); w.y = cvt_pk_bf16(a[0][2], a[0][3]); w.z = cvt_pk_bf16(a[1][0], a[1][1]); w.w = cvt_pk_bf16(a[1][2], a[1][3]);
                *(u32x4*)rowp = w; }
    }
};
__device__ __forceinline__ float clamp448(float v) { return fminf(fmaxf(v, -448.0f), 448.0f); }
struct EpiSwigluF8 {
    static constexpr bool PERM = true, AFTER_DRAIN = false, MID = false;
    unsigned char* O; int ldc; const float* bias; int de; float ascale, oscale;
    __device__ __forceinline__ void operator()(const f32x4 (&acc)[2][2][4][2], const Unit& u, int wr, int wc, int fr, int fq) const {
        const int row0 = u.pm * BM + wr * 64 + fr, cl = u.pn * HALF + wc * 32 + 8 * fq;
        const float* bb = bias + (size_t)u.e * 2 * de + cl;
        f32x4 bg[2], bl[2];
#pragma unroll
        for (int n = 0; n < 2; ++n) { bg[n] = *(const f32x4*)(bb + 4 * n); bl[n] = *(const f32x4*)(bb + de + 4 * n); }
#pragma unroll
        for (int ai = 0; ai < 2; ++ai)
#pragma unroll
            for (int m = 0; m < 4; ++m) { unsigned char* rowp = O + (size_t)(row0 + ai * HALF + m * 16) * ldc + cl;
                f32x4 a[2];
#pragma unroll
                for (int n = 0; n < 2; ++n) { const f32x4 g = acc[ai][0][m][n] * ascale + bg[n], l = acc[ai][1][m][n] * ascale + bl[n];
                    f32x4 gg, ll, ex, rc;
#pragma unroll
                    for (int j = 0; j < 4; ++j) { gg[j] = fminf(g[j], 7.0f); ll[j] = __builtin_amdgcn_fmed3f(l[j], -7.0f, 7.0f); }
                    const f32x4 t = gg * (-1.702f * 1.44269504089f);
#pragma unroll
                    for (int j = 0; j < 4; ++j) ex[j] = __builtin_amdgcn_exp2f(t[j]);
                    const f32x4 d = ex + 1.0f;
#pragma unroll
                    for (int j = 0; j < 4; ++j) rc[j] = __builtin_amdgcn_rcpf(d[j]);
                    a[n] = (gg * rc) * (ll * oscale + oscale); }
                int w0 = 0, w1 = 0;
                w0 = __builtin_amdgcn_cvt_pk_fp8_f32(a[0][0], a[0][1], w0, false); w0 = __builtin_amdgcn_cvt_pk_fp8_f32(a[0][2], a[0][3], w0, true);
                w1 = __builtin_amdgcn_cvt_pk_fp8_f32(a[1][0], a[1][1], w1, false); w1 = __builtin_amdgcn_cvt_pk_fp8_f32(a[1][2], a[1][3], w1, true);
                u32x2 w; w.x = (unsigned)w0; w.y = (unsigned)w1; *(u32x2*)rowp = w; }
    }
};
struct EpiDown {
    static constexpr bool PERM = true, AFTER_DRAIN = false, MID = false;
    unsigned char* O; int ldc; const float* bias; const float* sw; float ascale, oscale;
    __device__ __forceinline__ void operator()(const f32x4 (&acc)[2][2][4][2], const Unit& u, int wr, int wc, int fr, int fq) const {
        const int row0 = u.pm * BM + wr * 64 + fr, col0 = u.pn * BM + wc * 32 + 8 * fq;
        const float* bb = bias + (size_t)u.e * ldc + col0;
        f32x4 bv[2][2];
#pragma unroll
        for (int bj = 0; bj < 2; ++bj)
#pragma unroll
            for (int n = 0; n < 2; ++n) bv[bj][n] = *(const f32x4*)(bb + bj * HALF + 4 * n);
        float wq[2][4];
#pragma unroll
        for (int ai = 0; ai < 2; ++ai)
#pragma unroll
            for (int m = 0; m < 4; ++m) wq[ai][m] = sw[row0 + ai * HALF + m * 16];
        asm volatile("s_waitcnt vmcnt(0)" ::: "memory");
#pragma unroll
        for (int ai = 0; ai < 2; ++ai)
#pragma unroll
            for (int m = 0; m < 4; ++m) { const int r = row0 + ai * HALF + m * 16; const float w8 = wq[ai][m] * oscale; unsigned char* rowp = O + (size_t)r * ldc + col0;
#pragma unroll
                for (int bj = 0; bj < 2; ++bj) { f32x4 v0 = (acc[ai][bj][m][0] * ascale + bv[bj][0]) * w8, v1 = (acc[ai][bj][m][1] * ascale + bv[bj][1]) * w8;
#pragma unroll
                    for (int j = 0; j < 4; ++j) { v0[j] = __builtin_amdgcn_fmed3f(v0[j], -448.0f, 448.0f); v1[j] = __builtin_amdgcn_fmed3f(v1[j], -448.0f, 448.0f); }
                    int w0 = 0, w1 = 0;
                    w0 = __builtin_amdgcn_cvt_pk_fp8_f32(v0[0], v0[1], w0, false); w0 = __builtin_amdgcn_cvt_pk_fp8_f32(v0[2], v0[3], w0, true);
                    w1 = __builtin_amdgcn_cvt_pk_fp8_f32(v1[0], v1[1], w1, false); w1 = __builtin_amdgcn_cvt_pk_fp8_f32(v1[2], v1[3], w1, true);
                    u32x2 w; w.x = (unsigned)w0; w.y = (unsigned)w1; *(u32x2*)(rowp + bj * HALF) = w; } }
    }
};
struct EpiNull {
    static constexpr bool PERM = false, AFTER_DRAIN = false, MID = false;
    float* dummy;
    __device__ __forceinline__ void operator()(const f32x4 (&acc)[2][2][4][2], const Unit& u, int wr, int wc, int fr, int fq) const {
        f32x4 s = (f32x4){0.f, 0.f, 0.f, 0.f};
#pragma unroll
        for (int ai = 0; ai < 2; ++ai)
#pragma unroll
            for (int bj = 0; bj < 2; ++bj)
#pragma unroll
                for (int m = 0; m < 4; ++m)
#pragma unroll
                    for (int n = 0; n < 2; ++n) s = s + acc[ai][bj][m][n];
        const float t = (s[0] + s[1]) + (s[2] + s[3]);
        if (t == 123456.789f) dummy[u.pm * 64 + u.pn] = t;
    }
};
struct PairOrder : StaticOrder {
    static constexpr bool PAIRS = true;
    __device__ bool next(int i, Unit& u) const { if (!StaticOrder::next(i >> 1, u)) return false; u.kh = i & 1; return true; }
};
struct FixedOrder : StaticOrder {
    static constexpr bool PAIRS = false;
    __device__ bool next(int i, Unit& u) const { if (i >= 2) return false; u.pm = 0; u.pn = 0; u.e = 0; u.kh = 0; return true; }
};
struct GroupedOrder : StaticOrder {
    static constexpr bool PAIRS = false;
    const int* tile_e;
    __device__ bool next(int i, Unit& u) const { if (!StaticOrder::next(i, u)) return false; u.e = tile_e[u.pm]; return true; }
};
template <class Epi, class Sched, bool ALIGN_EPI = false, bool SP2 = false, bool GATHER = false, bool F8 = false>
__device__ __forceinline__ void gemm_phase(PG8_LAS unsigned char* lds, const Gemm g, const Sched& S, const Epi& E) {
    const int tid = threadIdx.x, wid = __builtin_amdgcn_readfirstlane(tid >> 6), lane = tid & 63, wr = wid >> 2, wc = wid & 3, fr = lane & 15, fq = lane >> 4;
    const int K = g.K, nt = K / BK;
    unsigned voffA[2], voffB[2];
#pragma unroll
    for (int i = 0; i < 2; ++i) { int R, C; stage_rc(tid * 16 + i * 8192, R, C); const int Rb = Epi::PERM ? ((R & ~31) + perm32(R & 31)) : R;
        voffA[i] = (unsigned)(R * K + C) * 2u; voffB[i] = (unsigned)(Rb * K + C) * 2u; }
    static_assert(SP2 || !GATHER, "the gathered-A path is written for the SP2 loop only");
    unsigned gc0[2] = {0u, 0u}, gc1[2] = {0u, 0u}, gn0[2] = {0u, 0u}, gn1[2] = {0u, 0u};
    auto load_gather = [&](const Unit& u, unsigned (&o0)[2], unsigned (&o1)[2]) {
#pragma unroll
        for (int i = 0; i < 2; ++i) { int R, C; stage_rc(tid * 16 + i * 8192, R, C); const int t0 = g.gather[u.pm * BM + R], t1 = g.gather[u.pm * BM + HALF + R];
            o0[i] = (unsigned)(t0 * K + C) * 2u; o1[i] = (unsigned)(t1 * K + C) * 2u; } };
    const size_t kstep = (size_t)(BK * 2);
    const size_t hstep = (size_t)HALF * K * 2;
    const size_t tstep = 2 * hstep;
    const unsigned ldsw = (unsigned)wid * 1024u;
    const int aoff = lds_byte(wr * 64 + fr, F8 ? fq * 16 : fq * 8), boff = lds_byte(wc * 32 + fr, F8 ? fq * 16 : fq * 8);
    const int sc1 = 0x7f7f7f7f;
    constexpr int KFR = F8 ? 16 : 1024;
#define PG8_SA(b, h) (((b) * 2 + (h)) * HTB)
#define PG8_SB(b, h) ((4 + (b) * 2 + (h)) * HTB)
#define PG8_STAGE(bufoff, gbase, voff) do { _Pragma("unroll") for (int _i = 0; _i < 2; ++_i) \
        __builtin_amdgcn_global_load_lds((const unsigned*)((const char*)(gbase) + (voff)[_i]), (PG8_LAS unsigned*)(lds + (bufoff) + ldsw + _i * 8192), 16, 0, 0); } while (0)
#define PG8_STAGE_A(bufoff, gbase, hh, nx) do { if constexpr (GATHER) { _Pragma("unroll") for (int _i = 0; _i < 2; ++_i) { const unsigned _o = (nx) ? ((hh) ? gn1[_i] : gn0[_i]) : ((hh) ? gc1[_i] : gc0[_i]); \
        __builtin_amdgcn_global_load_lds((const unsigned*)((const char*)(gbase) + _o), (PG8_LAS unsigned*)(lds + (bufoff) + ldsw + _i * 8192), 16, 0, 0); } } \
        else { PG8_STAGE(bufoff, (gbase) + ((hh) ? hstep : 0), voffA); } } while (0)
#define PG8_LDA(dst, b, h) do { _Pragma("unroll") for (int m = 0; m < 4; ++m) _Pragma("unroll") for (int k = 0; k < 2; ++k) dst[m][k] = *(const PG8_LAS bf16x8*)(lds + PG8_SA(b, h) + aoff + m * 2048 + k * KFR); } while (0)
#define PG8_LDB(dst, b, h) do { _Pragma("unroll") for (int n = 0; n < 2; ++n) _Pragma("unroll") for (int k = 0; k < 2; ++k) dst[n][k] = *(const PG8_LAS bf16x8*)(lds + PG8_SB(b, h) + boff + n * 2048 + k * KFR); } while (0)
#define PG8_V8(x) __builtin_shufflevector(__builtin_bit_cast(i32x4_t, (x)[0]), __builtin_bit_cast(i32x4_t, (x)[1]), 0, 1, 2, 3, 4, 5, 6, 7)
#define PG8_MMA(ai, bj, At, Bt) do { __builtin_amdgcn_s_setprio(1); if constexpr (F8) { _Pragma("unroll") for (int m = 0; m < 4; ++m) _Pragma("unroll") for (int n = 0; n < 2; ++n) \
        asm volatile("v_mfma_scale_f32_16x16x128_f8f6f4 %0, %1, %2, %0, %3, %3 op_sel_hi:[0,0,0]" : "+v"(acc[ai][bj][m][n]) : "v"(PG8_V8(Bt[n])), "v"(PG8_V8(At[m])), "v"(sc1)); } else { \
        _Pragma("unroll") for (int m = 0; m < 4; ++m) _Pragma("unroll") for (int n = 0; n < 2; ++n) _Pragma("unroll") for (int k = 0; k < 2; ++k) \
        acc[ai][bj][m][n] = __builtin_amdgcn_mfma_f32_16x16x32_bf16(Bt[n][k], At[m][k], acc[ai][bj][m][n], 0, 0, 0); } __builtin_amdgcn_s_setprio(0); } while (0)
#define PG8_WAIT_V(n) asm volatile("s_waitcnt vmcnt(" #n ")" ::: "memory")
#define PG8_WAIT_L(n) asm volatile("s_waitcnt lgkmcnt(" #n ")" ::: "memory")
#define PG8_BAR __builtin_amdgcn_s_barrier()
#define PG8_SCHED __builtin_amdgcn_sched_barrier(0)
    Unit cur, nxt; int ui = 0;
    if (!S.next(0, cur)) return;
    f32x4 acc[2][2][4][2];
#pragma unroll
    for (int a = 0; a < 2; ++a)
#pragma unroll
        for (int b = 0; b < 2; ++b)
#pragma unroll
            for (int m = 0; m < 4; ++m)
#pragma unroll
                for (int n = 0; n < 2; ++n) acc[a][b][m][n] = (f32x4){0.f, 0.f, 0.f, 0.f};
    bf16x8 At[4][2], B0[2][2], B1[2][2];
    const char* cA = (const char*)((Sched::PAIRS && cur.kh) ? g.A2 : g.A) + (GATHER ? (size_t)0 : (size_t)cur.pm * tstep); const char* cB = (const char*)((Sched::PAIRS && cur.kh) ? g.Bt2 : g.Bt) + (size_t)cur.e * g.bgs + (size_t)cur.pn * tstep;
    S.a_ready(cur);
    if constexpr (GATHER) load_gather(cur, gc0, gc1);
    if constexpr (SP2) {
        PG8_STAGE(PG8_SB(0, 0), cB, voffB); PG8_STAGE(PG8_SB(0, 1), cB + hstep, voffB); PG8_STAGE_A(PG8_SA(0, 0), cA, 0, false); PG8_STAGE_A(PG8_SA(0, 1), cA, 1, false);
        if (wr == 1) PG8_BAR;
        PG8_WAIT_V(2); PG8_BAR;
        PG8_STAGE(PG8_SB(1, 0), cB + kstep, voffB); PG8_STAGE_A(PG8_SA(1, 0), cA + kstep, 0, false); PG8_STAGE(PG8_SB(1, 1), cB + hstep + kstep, voffB);
        PG8_WAIT_V(6); PG8_BAR;
    } else {
        PG8_STAGE(PG8_SB(0, 0), cB, voffB); PG8_STAGE(PG8_SA(0, 0), cA, voffA); PG8_STAGE(PG8_SB(0, 1), cB + hstep, voffB); PG8_STAGE(PG8_SA(0, 1), cA + hstep, voffA);
        if (wr == 1) PG8_BAR;
        PG8_WAIT_V(4); PG8_BAR;
        PG8_STAGE(PG8_SB(1, 0), cB + kstep, voffB); PG8_STAGE(PG8_SA(1, 0), cA + kstep, voffA); PG8_STAGE(PG8_SB(1, 1), cB + hstep + kstep, voffB);
        PG8_WAIT_V(6); PG8_BAR;
    }
    for (;;) {
        const bool has_next = S.next(ui + 1, nxt);
        const char* nA = has_next ? (const char*)((Sched::PAIRS && nxt.kh) ? g.A2 : g.A) + (GATHER ? (size_t)0 : (size_t)nxt.pm * tstep) : cA;
        if constexpr (GATHER) { if (has_next) load_gather(nxt, gn0, gn1); else { gn0[0] = gc0[0]; gn0[1] = gc0[1]; gn1[0] = gc1[0]; gn1[1] = gc1[1]; } } const char* nB = has_next ? (const char*)((Sched::PAIRS && nxt.kh) ? g.Bt2 : g.Bt) + (size_t)nxt.e * g.bgs + (size_t)nxt.pn * tstep : cB;
        for (int t = 0; t < nt; t += 2) {
            const bool last = (t == nt - 2);
            const char* a1 = cA + (size_t)(t + 1) * kstep;
            const char* a2 = last ? nA : cA + (size_t)(t + 2) * kstep; const char* b2 = last ? nB : cB + (size_t)(t + 2) * kstep;
            const char* a3 = a2 + kstep; const char* b3 = b2 + kstep;
            if (last && has_next) S.a_ready(nxt);
            if constexpr (SP2) {
            PG8_LDB(B0, 0, 0); PG8_LDB(B1, 0, 1); PG8_SCHED; PG8_LDA(At, 0, 0); PG8_STAGE_A(PG8_SA(1, 1), a1, 1, false);
            PG8_WAIT_V(8); PG8_WAIT_L(0); PG8_BAR; PG8_MMA(0, 0, At, B0); PG8_MMA(0, 1, At, B1); PG8_BAR; PG8_SCHED;
            PG8_LDA(At, 0, 1); PG8_STAGE(PG8_SB(0, 0), b2, voffB); PG8_STAGE(PG8_SB(0, 1), b2 + hstep, voffB); PG8_STAGE_A(PG8_SA(0, 0), a2, 0, last);
            PG8_WAIT_V(8); PG8_WAIT_L(0); PG8_BAR; PG8_MMA(1, 0, At, B0); PG8_MMA(1, 1, At, B1); PG8_BAR; PG8_SCHED;
            PG8_LDB(B0, 1, 0); PG8_LDB(B1, 1, 1); PG8_SCHED; PG8_LDA(At, 1, 0); PG8_STAGE_A(PG8_SA(0, 1), a2, 1, last);
            PG8_WAIT_V(8); PG8_WAIT_L(0); PG8_BAR; PG8_MMA(0, 0, At, B0); PG8_MMA(0, 1, At, B1); PG8_BAR; PG8_SCHED;
            PG8_LDA(At, 1, 1); PG8_STAGE(PG8_SB(1, 0), b3, voffB); PG8_STAGE(PG8_SB(1, 1), b3 + hstep, voffB); PG8_STAGE_A(PG8_SA(1, 0), a3, 0, last);
            PG8_WAIT_V(8); PG8_WAIT_L(0); PG8_BAR; PG8_MMA(1, 0, At, B0); PG8_MMA(1, 1, At, B1); PG8_BAR; PG8_SCHED;
            } else {
            PG8_LDB(B0, 0, 0); PG8_SCHED; PG8_LDA(At, 0, 0); PG8_STAGE(PG8_SA(1, 1), a1 + hstep, voffA);
            PG8_WAIT_L(8); PG8_BAR; PG8_WAIT_L(0); PG8_MMA(0, 0, At, B0); PG8_BAR; PG8_SCHED;
            PG8_LDB(B1, 0, 1); PG8_STAGE(PG8_SB(0, 0), b2, voffB);
            PG8_BAR; PG8_WAIT_L(0); PG8_MMA(0, 1, At, B1); PG8_BAR;
            PG8_LDA(At, 0, 1); PG8_STAGE(PG8_SA(0, 0), a2, voffA);
            PG8_BAR; PG8_WAIT_L(0); PG8_MMA(1, 0, At, B0); PG8_BAR; PG8_SCHED;
            PG8_STAGE(PG8_SB(0, 1), b2 + hstep, voffB);
            PG8_WAIT_V(6); PG8_BAR; PG8_MMA(1, 1, At, B1); PG8_BAR;
            PG8_LDB(B0, 1, 0); PG8_SCHED; PG8_LDA(At, 1, 0); PG8_STAGE(PG8_SA(0, 1), a2 + hstep, voffA);
            PG8_WAIT_L(8); PG8_BAR; PG8_WAIT_L(0); PG8_MMA(0, 0, At, B0); PG8_BAR; PG8_SCHED;
            PG8_LDB(B1, 1, 1); PG8_STAGE(PG8_SB(1, 0), b3, voffB);
            PG8_BAR; PG8_WAIT_L(0); PG8_MMA(0, 1, At, B1); PG8_BAR;
            PG8_LDA(At, 1, 1); PG8_STAGE(PG8_SA(1, 0), a3, voffA);
            PG8_BAR; PG8_WAIT_L(0); PG8_MMA(1, 0, At, B0); PG8_BAR; PG8_SCHED;
            PG8_STAGE(PG8_SB(1, 1), b3 + hstep, voffB);
            PG8_WAIT_V(6); PG8_BAR; PG8_MMA(1, 1, At, B1); PG8_BAR;
            }
        }
        if constexpr (ALIGN_EPI) { if (wr == 0) PG8_BAR; }
        if constexpr (!Epi::AFTER_DRAIN) { if constexpr (Epi::MID) { if (cur.kh == 0) E.mid(acc, cur, wr, wc, fr, fq); else E(acc, cur, wr, wc, fr, fq); } else E(acc, cur, wr, wc, fr, fq); S.done(cur); }
        if (!has_next) break;
        if (!(Epi::MID && cur.kh == 0)) {
#pragma unroll
        for (int a = 0; a < 2; ++a)
#pragma unroll
            for (int b = 0; b < 2; ++b)
#pragma unroll
                for (int m = 0; m < 4; ++m)
#pragma unroll
                    for (int n = 0; n < 2; ++n) acc[a][b][m][n] = (f32x4){0.f, 0.f, 0.f, 0.f}; }
        cur = nxt; cA = nA; cB = nB; ++ui;
        if constexpr (GATHER) { gc0[0] = gn0[0]; gc0[1] = gn0[1]; gc1[0] = gn1[0]; gc1[1] = gn1[1]; }
        if constexpr (ALIGN_EPI) { if (wr == 1) PG8_BAR; }
    }
    PG8_WAIT_V(0);
    if constexpr (!ALIGN_EPI) { if (wr == 0) PG8_BAR; }
    PG8_BAR;
    if constexpr (Epi::AFTER_DRAIN) { E.fused(acc, cur, wr, wc, fr, fq, lds, wid, lane); S.done(cur); }
#undef PG8_SA
#undef PG8_SB
#undef PG8_STAGE
#undef PG8_STAGE_A
#undef PG8_LDA
#undef PG8_LDB
#undef PG8_MMA
#undef PG8_V8
#undef PG8_WAIT_V
#undef PG8_WAIT_L
#undef PG8_BAR
#undef PG8_SCHED
}
}

#ifndef PG8_SP2
#define PG8_SP2 true
#endif
#ifndef PG8_ALIGN
#define PG8_ALIGN true
#endif
constexpr int NWAVES = 8;
#ifndef MK_N_LAUNCHES
#define MK_N_LAUNCHES 1
#endif
constexpr int N_PHASES = 14;
constexpr int N_LAUNCHES = MK_N_LAUNCHES;

constexpr int D = 2048, NB = 8, SEQ = 2048, M = NB * SEQ;
constexpr int RW = 1024, RNH = 16;
constexpr int RWKV_COLS = 3360, HG_BASE = 3584, GATE_BASE = 7680, NPROJ = 11776;
constexpr int IN_COLS = 11552;
constexpr int HNH = 8;
constexpr int NE = 32, DE = 2048, NASSIGN = M * 4;
constexpr int LORA_K = 384, LORA_N = 3072;
constexpr int MAXTILES = 288, MAXSLOTS = MAXTILES * 256;
constexpr float NORM_EPS = 1e-5f, GN_EPS = 64e-5f;

constexpr size_t MiB = 1u << 20;
constexpr size_t WS_CTL = 0, CTL_ZERO_BYTES = 32768;
constexpr size_t WS_MODP = 2 * MiB;
constexpr size_t WS_MOD = 8 * MiB;
constexpr size_t WS_RWP = 9 * MiB;
constexpr size_t WS_ROUTE = 10 * MiB;
constexpr size_t WS_WLORA = 14 * MiB;
constexpr size_t WS_WIN = 18 * MiB;
constexpr size_t WS_WPA = 64 * MiB, WS_WPB = 68 * MiB, WS_WOUT = 72 * MiB;
constexpr size_t WS_WGU = 80 * MiB;
constexpr size_t WS_WDN = 592 * MiB;
constexpr size_t WS_H = 848 * MiB;
constexpr size_t WS_PROJ = 912 * MiB;
constexpr size_t WS_LORA_A = 1280 * MiB;
constexpr size_t WS_LORA_O = 1292 * MiB;
constexpr size_t WS_YA = 1484 * MiB, WS_YB = 1516 * MiB;
constexpr size_t WS_OHG = 1548 * MiB;
constexpr size_t WS_T1 = 1612 * MiB;
constexpr size_t WS_MERGED = 1740 * MiB;
constexpr size_t WS_X1 = 1804 * MiB;
constexpr size_t WS_XG = 1932 * MiB;
constexpr size_t WS_ACT = 2220 * MiB;
constexpr size_t WS_YE = 2508 * MiB;
constexpr size_t WS_END = 2796 * MiB;
constexpr size_t RT_E = 0, RT_RANK = 262144, RT_GATE = 524288, RT_TOKSLOT = 786432, RT_SLOTW = 1048576, RT_TILEE = 1048576 + 524288, RT_SLOTTOK = 2097152;
constexpr int CW_TMO = 0, CW_CODE = 1;
constexpr int CW_CNT = 64;
constexpr int CW_BAR = 4096;
constexpr int LDS_BYTES = 147456;
constexpr int MISC_OFF = LDS_BYTES - 256;
constexpr int SCR_BYTES = MISC_OFF;

#define GAS __attribute__((address_space(1)))
#define LAS __attribute__((address_space(3)))
typedef unsigned short bf16;
typedef unsigned v4u __attribute__((ext_vector_type(4)));
typedef unsigned v2u __attribute__((ext_vector_type(2)));
typedef float f32x4 __attribute__((ext_vector_type(4)));
typedef float f32x2 __attribute__((ext_vector_type(2)));
typedef GAS unsigned gu32;
#define RLX_AGENT __ATOMIC_RELAXED, __HIP_MEMORY_SCOPE_AGENT
#define LDS_WAIT() asm volatile("s_waitcnt lgkmcnt(0)" ::: "memory")
#define VM_WAIT() asm volatile("s_waitcnt vmcnt(0)" ::: "memory")
typedef __bf16 bf16x2_hw __attribute__((ext_vector_type(2)));
__device__ __forceinline__ unsigned pk2(float lo, float hi) { const f32x2 v = {lo, hi}; const bf16x2_hw r = __builtin_convertvector(v, bf16x2_hw); return __builtin_bit_cast(unsigned, r); }
__device__ __forceinline__ unsigned f2bf(float f) { return pk2(f, f) & 0xffffu; }
__device__ __forceinline__ float bf2f(unsigned short h) { return __uint_as_float(((unsigned)h) << 16); }
__device__ __forceinline__ float bflo(unsigned w) { return __uint_as_float(w << 16); }
__device__ __forceinline__ float bfhi(unsigned w) { return __uint_as_float(w & 0xffff0000u); }
__device__ __forceinline__ float sigmoidf_(float x) { return __builtin_amdgcn_rcpf(1.0f + __expf(-x)); }

#define XB_TMO      128
#define XB_XCNT(j)  (256  + 64 * (j))
#define XB_XSUB(j)  (1280 + 64 * (j))
#define XB_XGEN(j)  (2304 + 64 * (j))
#define XB_TOP      3328
#define XB_TOPGEN   3392
#define XCD_BAR_WORDS 3456
#define XB_SPIN_CAP (1u << 18)
__device__ __forceinline__ unsigned xb_ld(unsigned* p)              { return __hip_atomic_load(p, __ATOMIC_RELAXED, __HIP_MEMORY_SCOPE_AGENT); }
__device__ __forceinline__ unsigned xb_add(unsigned* p, unsigned v) { return __hip_atomic_fetch_add(p, v, __ATOMIC_RELAXED, __HIP_MEMORY_SCOPE_AGENT); }
__device__ __forceinline__ unsigned xb_xcc_id() { return (unsigned)__builtin_amdgcn_s_getreg((3 << 11) | 20) & 0xFu; }
#define XB_SPIN(cond, bar) do { unsigned _sp = 0; while (cond) { __builtin_amdgcn_s_sleep(1); \
    if ((++_sp & 255u) == 0u) { if (xb_ld(&(bar)[XB_TMO])) break; if (_sp > XB_SPIN_CAP) { atomicAdd(&(bar)[XB_TMO], 1u); break; } } } } while (0)
struct XcdBarrier { unsigned* bar; unsigned x; volatile LAS unsigned* st; };
__device__ __forceinline__ XcdBarrier xcd_barrier_post(unsigned* bar, volatile LAS unsigned* st) {
    XcdBarrier b; b.bar = bar; b.x = xb_xcc_id(); b.st = st;
    if (threadIdx.x == 0) (void)xb_add(&bar[XB_XCNT(b.x)], 1u);
    return b;
}
__device__ __forceinline__ void xcd_barrier_complete(unsigned* bar, unsigned x, unsigned& nloc, unsigned& nx) {
    const unsigned G = gridDim.x * gridDim.y * gridDim.z;
    unsigned sum, cnt, mine, sp = 0u;
    for (;;) {
        sum = 0u; cnt = 0u; mine = 0u;
#pragma unroll
        for (unsigned j = 0; j < 16; ++j) { const unsigned c = xb_ld(&bar[XB_XCNT(j)]); sum += c; cnt += (c > 0u) ? 1u : 0u; mine = (j == x) ? c : mine; }
        if (sum == G) break;
        __builtin_amdgcn_s_sleep(1);
        if ((++sp & 255u) == 0u) { if (xb_ld(&bar[XB_TMO])) break; if (sp > XB_SPIN_CAP) { atomicAdd(&bar[XB_TMO], 1u); break; } }
    }
    nloc = mine > 0u ? mine : 1u; nx = cnt > 0u ? cnt : 1u;
}
__device__ __forceinline__ void xcd_barrier(const XcdBarrier& b) {
    asm volatile("s_waitcnt vmcnt(0)" ::: "memory");
    __syncthreads();
    if (threadIdx.x == 0) {
        unsigned* bar = b.bar;
        __builtin_amdgcn_s_waitcnt(0);
        unsigned nloc = b.st[0], nx = b.st[1];
        if (nloc == 0u) { xcd_barrier_complete(bar, b.x, nloc, nx); b.st[0] = nloc; b.st[1] = nx; }
        const unsigned old = xb_add(&bar[XB_XSUB(b.x)], 1u);
        const unsigned gen = old / nloc;
        if (old + 1u == (gen + 1u) * nloc) {
            __builtin_amdgcn_fence(__ATOMIC_RELEASE, "agent");
            asm volatile("s_waitcnt vmcnt(0)" ::: "memory");
            const unsigned og = xb_add(&bar[XB_TOP], 1u);
            const unsigned tg = og / nx;
            if (og + 1u == (tg + 1u) * nx) xb_add(&bar[XB_TOPGEN], 1u);
            else XB_SPIN(xb_ld(&bar[XB_TOPGEN]) == tg, bar);
            __builtin_amdgcn_fence(__ATOMIC_ACQUIRE, "agent");
            xb_add(&bar[XB_XGEN(b.x)], 1u);
            asm volatile("s_waitcnt vmcnt(0)" ::: "memory");
        } else {
            XB_SPIN(xb_ld(&bar[XB_XGEN(b.x)]) == gen, bar);
            __builtin_amdgcn_fence(__ATOMIC_ACQUIRE, "agent");
            asm volatile("s_waitcnt vmcnt(0)" ::: "memory");
        }
    }
    __syncthreads();
}

struct Args { const float* in[30]; float* out; unsigned char* ws; int ph_lo, ph_hi, li, pad; };
struct Frame {
    LAS unsigned char* lds;
    volatile LAS unsigned* MISC;
    gu32* ctl;
    unsigned char* ws;
    int tid, lane, wave;
    int vcu, G;
};
__device__ __forceinline__ float wave_sum(float v) {
#pragma unroll
    for (int o = 1; o < 64; o <<= 1) v += __shfl_xor(v, o);
    return v;
}
template <int CTRL> __device__ __forceinline__ float dpp_mov(float v) { return __builtin_bit_cast(float, __builtin_amdgcn_update_dpp(0, __builtin_bit_cast(int, v), CTRL, 0xf, 0xf, false)); }
__device__ __forceinline__ float red8(float v) {
    v += dpp_mov<0xB1>(v);
    v += dpp_mov<0x4E>(v);
    v += dpp_mov<0x141>(v);
    return v;
}

struct TItem { const float* src; bf16* dst; int N, Kd; };
constexpr int P0_I_IN = 32 * (IN_COLS / 32), P0_I_PA = 16 * 64, P0_I_OUT = 32 * 64;
constexpr int P0_NITEMS = P0_I_IN + 2 * P0_I_PA + P0_I_OUT;
__device__ __forceinline__ TItem p0_decode(const Args& args, unsigned char* ws, int it) {
    TItem t; int r = it;
    if (r < P0_I_IN) { const int nblk = IN_COLS / 32, kb = r / nblk, nb = r % nblk, n0 = nb * 32; const int dr = n0 + (n0 >= RWKV_COLS ? (HG_BASE - RWKV_COLS) : 0);
        t.src = args.in[6] + (size_t)(kb * 64) * IN_COLS + n0; t.N = IN_COLS; t.dst = (bf16*)(ws + WS_WIN) + (size_t)dr * D + kb * 64; t.Kd = D; return t; }
    r -= P0_I_IN;
    if (r < P0_I_PA) { const int kb = r / 64, nb = r % 64; t.src = args.in[20] + (size_t)(kb * 64) * D + nb * 32; t.N = D; t.dst = (bf16*)(ws + WS_WPA) + (size_t)(nb * 32) * RW + kb * 64; t.Kd = RW; return t; }
    r -= P0_I_PA;
    if (r < P0_I_PA) { const int kb = r / 64, nb = r % 64; t.src = args.in[21] + (size_t)(kb * 64) * D + nb * 32; t.N = D; t.dst = (bf16*)(ws + WS_WPB) + (size_t)(nb * 32) * RW + kb * 64; t.Kd = RW; return t; }
    r -= P0_I_PA;
    if (r < P0_I_OUT) { const int kb = r / 64, nb = r % 64; t.src = args.in[22] + (size_t)(kb * 64) * D + nb * 32; t.N = D; t.dst = (bf16*)(ws + WS_WOUT) + (size_t)(nb * 32) * D + kb * 64; t.Kd = D; return t; }
    t.src = nullptr; t.dst = nullptr; t.N = 0; t.Kd = 0; return t;
}
__device__ __forceinline__ void p0_issue(const TItem& t, f32x4 (&v)[8], int lane) {
    const GAS f32x4* src = (const GAS f32x4*)((const GAS float*)t.src + (size_t)(lane >> 3) * t.N + 4 * (lane & 7));
#pragma unroll
    for (int i = 0; i < 8; ++i) v[i] = __builtin_nontemporal_load(src + (size_t)(2 * i) * t.N);
}
__device__ __forceinline__ void p0_finish(const TItem& t, const f32x4 (&v)[8], LAS float* scr, int lane) {
#pragma unroll
    for (int i = 0; i < 8; ++i) *(LAS f32x4*)(scr + (8 * i + (lane >> 3)) * 32 + (((lane & 7) ^ i) << 2)) = v[i];
    LDS_WAIT(); asm volatile("" ::: "memory");
    const int c = lane & 7;
#pragma unroll
    for (int j = 0; j < 4; ++j) { const int n = (lane >> 3) + 8 * j; const LAS float* s = scr + (8 * c) * 32 + ((((n >> 2) ^ c) << 2) | (n & 3));
        v4u o; o.x = pk2(s[0 * 32], s[1 * 32]); o.y = pk2(s[2 * 32], s[3 * 32]); o.z = pk2(s[4 * 32], s[5 * 32]); o.w = pk2(s[6 * 32], s[7 * 32]);
        *(GAS v4u*)(t.dst + (size_t)n * t.Kd + 8 * c) = o; }
    LDS_WAIT(); asm volatile("" ::: "memory");
}

__device__ __forceinline__ void p0_convert(Frame& F, const Args& args, int lo, int hi, int gw, int NGW, int nlight) {
    LAS float* scr = (LAS float*)(F.lds + F.wave * 8448);
    unsigned char* ws = F.ws;
    const int nA = NGW > nlight ? NGW - nlight : 0, nit = hi - lo, itemsA = nA * 16 < nit ? nA * 16 : nit;
    auto item_of = [&](int idx) -> int {
        if (gw >= nlight && idx < 16) { const int a = (gw - nlight) + nA * idx; return a < itemsA ? lo + a : hi + 1000000; }
        const int j = (gw >= nlight) ? idx - 16 : idx; return lo + itemsA + gw + NGW * j; };
    int idx = 0;
    while (idx < 16 && item_of(idx) >= hi + 1000000) ++idx;
    if (item_of(idx) < hi) {
        f32x4 va[8], vb[8];
        TItem ca = p0_decode(args, ws, item_of(idx)), cb = ca; p0_issue(ca, va, F.lane);
        for (;;) {
            int nx = item_of(++idx); bool has = nx < hi;
            if (has) { cb = p0_decode(args, ws, nx); p0_issue(cb, vb, F.lane); }
            p0_finish(ca, va, scr, F.lane);
            if (!has) break;
            nx = item_of(++idx); has = nx < hi;
            if (has) { ca = p0_decode(args, ws, nx); p0_issue(ca, va, F.lane); }
            p0_finish(cb, vb, scr, F.lane);
            if (!has) break;
        }
    }
}
#ifndef P0_SPLIT_PCT
#define P0_SPLIT_PCT 44
#endif
#ifndef P0_TAIL_PCT
#define P0_TAIL_PCT 6
#endif
#ifndef P0_HG_PCT
#define P0_HG_PCT 20
#endif
#ifndef P8_E0
#define P8_E0 25
#endif
constexpr int P8_GU1 = 16 * 128, P8_DN1 = 16 * 64, P8_N = P8_E0 * (P8_GU1 + P8_DN1) + (NE - P8_E0) * P8_GU1, P8_Q = (NE - P8_E0) * P8_DN1;
constexpr int P8_SPLIT = (int)((long long)P8_N * (100 - P0_SPLIT_PCT) / 100);
constexpr int P8_SPLITA = P8_SPLIT - (int)((long long)P8_N * P0_TAIL_PCT / 100);
constexpr int P8_SPLITH = P8_SPLITA - (int)((long long)P8_N * P0_HG_PCT / 100);
#ifndef P0_RW_PCT
#define P0_RW_PCT 0
#endif
constexpr int P8_SPLITR = P8_SPLITH - (int)((long long)P8_N * P0_RW_PCT / 100);
#ifndef P0_DED_PCT
#define P0_DED_PCT 30
#endif
constexpr int P8_SPLITD = (P8_SPLITR - (int)((long long)P8_N * P0_DED_PCT / 100)) > 0 ? (P8_SPLITR - (int)((long long)P8_N * P0_DED_PCT / 100)) : 0;
#ifndef P2_GEMM_WGS
#define P2_GEMM_WGS 232
#endif
constexpr int P2_ROUNDS = ((M / 256) * (NPROJ / 256) + P2_GEMM_WGS - 1) / P2_GEMM_WGS, P2_NFULL = (M / 256) * (NPROJ / 256) - (P2_ROUNDS - 1) * P2_GEMM_WGS;
#ifndef P11_TAIL_ITEMS
#define P11_TAIL_ITEMS 48
#endif
constexpr float W8_SCALE = 64.0f, H8_SCALE = 8.0f, A8_SCALE = 4.0f, Y8_SCALE = 64.0f;
struct TItem8 { const float* src; unsigned char* dst; int N, Kd; };
__device__ __forceinline__ TItem8 p8_decode(const Args& args, unsigned char* ws, int it) {
    TItem8 t;
    if (it >= P8_N) { const int j = it - P8_N; it = (P8_E0 + j / P8_DN1) * (P8_GU1 + P8_DN1) + P8_GU1 + j % P8_DN1; }
    else if (it >= P8_E0 * (P8_GU1 + P8_DN1)) { const int r = it - P8_E0 * (P8_GU1 + P8_DN1); it = (P8_E0 + r / P8_GU1) * (P8_GU1 + P8_DN1) + r % P8_GU1; }
    const int e = it / (P8_GU1 + P8_DN1), q = it % (P8_GU1 + P8_DN1);
    if (q < P8_GU1) { const int kb = q / 128, nb = q % 128, n0 = nb * 32;
        const int dr = (n0 < DE) ? (256 * (n0 / 128) + (n0 % 128)) : (256 * ((n0 - DE) / 128) + 128 + ((n0 - DE) % 128));
        t.src = args.in[25] + (size_t)e * D * 2 * DE + (size_t)(kb * 128) * (2 * DE) + n0; t.N = 2 * DE; t.dst = ws + WS_WGU + (size_t)e * 2 * DE * D + (size_t)dr * D + kb * 128; t.Kd = D; }
    else { const int q2 = q - P8_GU1, kb = q2 / 64, nb = q2 % 64;
        t.src = args.in[27] + (size_t)e * DE * D + (size_t)(kb * 128) * D + nb * 32; t.N = D; t.dst = ws + WS_WDN + (size_t)e * D * DE + (size_t)(nb * 32) * DE + kb * 128; t.Kd = DE; }
    return t;
}
__device__ __forceinline__ void p8_issue(const TItem8& t, f32x4 (&v)[16], int lane) {
    const GAS f32x4* src = (const GAS f32x4*)((const GAS float*)t.src + (size_t)(lane >> 3) * t.N + 4 * (lane & 7));
#pragma unroll
    for (int i = 0; i < 16; ++i) v[i] = __builtin_nontemporal_load(src + (size_t)(2 * i) * t.N);
}
__device__ __forceinline__ void p8_finish(const TItem8& t, const f32x4 (&v)[16], LAS float* scr, int lane) {
#pragma unroll
    for (int i = 0; i < 16; ++i) *(LAS f32x4*)(scr + (8 * i + (lane >> 3)) * 32 + (((lane & 7) ^ (i & 7)) << 2)) = v[i] * W8_SCALE;
    LDS_WAIT(); asm volatile("" ::: "memory");
    const int c = lane & 7;
#pragma unroll
    for (int j = 0; j < 4; ++j) { const int n = (lane >> 3) + 8 * j; float x[16];
#pragma unroll
        for (int i = 0; i < 16; ++i) { const int k = 16 * c + i; x[i] = scr[k * 32 + ((((n >> 2) ^ ((k >> 3) & 7)) << 2) | (n & 3))]; }
        int w[4];
#pragma unroll
        for (int g = 0; g < 4; ++g) { int q = 0; q = __builtin_amdgcn_cvt_pk_fp8_f32(fminf(fmaxf(x[4 * g], -448.f), 448.f), fminf(fmaxf(x[4 * g + 1], -448.f), 448.f), q, false);
            q = __builtin_amdgcn_cvt_pk_fp8_f32(fminf(fmaxf(x[4 * g + 2], -448.f), 448.f), fminf(fmaxf(x[4 * g + 3], -448.f), 448.f), q, true); w[g] = q; }
        v4u o; o.x = (unsigned)w[0]; o.y = (unsigned)w[1]; o.z = (unsigned)w[2]; o.w = (unsigned)w[3];
        __builtin_nontemporal_store(o, (GAS v4u*)(t.dst + (size_t)n * t.Kd + 16 * c)); }
    LDS_WAIT(); asm volatile("" ::: "memory");
}
__device__ __forceinline__ void p8_convert(Frame& F, const Args& args, int lo, int hi, int gw, int NGW, int nlight) {
    LAS float* scr = (LAS float*)(F.lds + F.wave * 16384);
    unsigned char* ws = F.ws;
    const int nA = NGW > nlight ? NGW - nlight : 0, nit = hi - lo, itemsA = (nlight > 0) ? (nA * 8 < nit ? nA * 8 : nit) : 0;
    auto item_of = [&](int idx) -> int {
        if (nlight > 0) { if (gw >= nlight && idx < 8) { const int a = (gw - nlight) + nA * idx; return a < itemsA ? lo + a : hi + 1000000; }
            const int j = (gw >= nlight) ? idx - 8 : idx; return lo + itemsA + gw + NGW * j; }
        return lo + gw + NGW * idx; };
    int idx = 0;
    while (nlight > 0 && idx < 8 && item_of(idx) >= hi + 1000000) ++idx;
    if (item_of(idx) < hi) {
        f32x4 va[16], vb[16];
        TItem8 ca = p8_decode(args, ws, item_of(idx)), cb = ca; p8_issue(ca, va, F.lane);
        for (;;) {
            int nx = item_of(++idx); bool has = nx < hi;
            if (has) { cb = p8_decode(args, ws, nx); p8_issue(cb, vb, F.lane); }
            p8_finish(ca, va, scr, F.lane);
            if (!has) break;
            nx = item_of(++idx); has = nx < hi;
            if (has) { ca = p8_decode(args, ws, nx); p8_issue(ca, va, F.lane); }
            p8_finish(cb, vb, scr, F.lane);
            if (!has) break;
        }
    }
}
__device__ __forceinline__ void p0_prologue(Frame& F, const Args& args) {
    const int gw = F.vcu * NWAVES + F.wave, NGW = F.G * NWAVES, gt = F.vcu * 512 + F.tid, NGT = F.G * 512;
    unsigned char* ws = F.ws;
    LAS float* sc = (LAS float*)(F.lds + 67584);
    for (int i = F.tid; i < NB * D; i += 512) { const int b = i / D, k = i % D; const float cv = args.in[1][i]; sc[k * 8 + b] = cv * sigmoidf_(cv); }
    __syncthreads();
    {
        float* modp = (float*)(ws + WS_MODP);
        for (int it = gw; it < 16 * 48; it += NGW) {
            const int kc = it / 48, jc = it % 48, j0 = jc * 256 + 4 * F.lane;
            f32x4 acc[8];
#pragma unroll
            for (int b = 0; b < 8; ++b) acc[b] = (f32x4){0.f, 0.f, 0.f, 0.f};
            const GAS f32x4* wp = (const GAS f32x4*)(args.in[2] + (size_t)(kc * 128) * 12288 + j0);
            const LAS f32x4* sp = (const LAS f32x4*)(sc + kc * 128 * 8);
#pragma unroll 8
            for (int kk = 0; kk < 128; ++kk) {
                const f32x4 w = wp[(size_t)kk * 3072]; const f32x4 s0 = sp[2 * kk], s1 = sp[2 * kk + 1];
                acc[0] += s0[0] * w; acc[1] += s0[1] * w; acc[2] += s0[2] * w; acc[3] += s0[3] * w;
                acc[4] += s1[0] * w; acc[5] += s1[1] * w; acc[6] += s1[2] * w; acc[7] += s1[3] * w;
            }
#pragma unroll
            for (int b = 0; b < 8; ++b) *(GAS f32x4*)(modp + (size_t)(kc * 8 + b) * 12288 + j0) = acc[b];
        }
    }
    {
        bf16* rwh = (bf16*)(ws + WS_RWP); bf16* rwl = rwh + NE * D;
        for (int o = gt; o < D * NE; o += NGT) { const int k = o & (D - 1), e = o >> 11; const float w = args.in[23][k * NE + e]; const unsigned hi = f2bf(w); rwh[o] = (bf16)hi; rwl[o] = (bf16)f2bf(w - bf2f((unsigned short)hi)); }
    }
    {
        bf16* wl = (bf16*)(ws + WS_WLORA);
        for (int o = gt; o < LORA_N * LORA_K; o += NGT) {
            const int n = o / LORA_K, k = o % LORA_K; float v = 0.f;
            if (n < 1024) { if (k < 64) v = args.in[9][k * 1024 + n]; }
            else if (n < 2048) { if (k >= 64 && k < 128) v = args.in[11][(k - 64) * 1024 + (n - 1024)]; }
            else { if (k >= 128 && k < 288) v = args.in[12][(k - 128) * 1024 + (n - 2048)]; }
            wl[o] = (bf16)f2bf(v);
        }
    }
    {
        GAS v4u* z = (GAS v4u*)(ws + WS_WIN + (size_t)RWKV_COLS * D * 2);
        for (int o = gt; o < (HG_BASE - RWKV_COLS) * D * 2 / 16; o += NGT) z[o] = (v4u){0u, 0u, 0u, 0u};
    }
    p0_convert(F, args, 0, P0_NITEMS, gw, NGW, 0);
    __syncthreads();
    if (P8_SPLITD > 0) p8_convert(F, args, 0, P8_SPLITD, gw, NGW, 768);
}

__device__ __forceinline__ void p1_norm1(Frame& F, const Args& args) {
    const float* modp = (const float*)(F.ws + WS_MODP); float* mod = (float*)(F.ws + WS_MOD); bf16* H = (bf16*)(F.ws + WS_H);
    LAS float* ml = (LAS float*)F.lds;
    for (int rg = F.vcu; rg < M / 64; rg += F.G) {
        const int b = rg / (SEQ / 64);
        __syncthreads();
        for (int j = F.tid; j < 2 * D; j += 512) { float s = args.in[3][j];
#pragma unroll
            for (int kc = 0; kc < 16; ++kc) s += modp[(size_t)(kc * 8 + b) * 12288 + j];
            ml[j] = s; }
        for (int idx = rg * 384 + F.tid; idx < (rg + 1) * 384 && F.tid < 384; idx += 512) { const int bb = idx / 12288, j = idx % 12288; float s = args.in[3][j];
#pragma unroll
            for (int kc = 0; kc < 16; ++kc) s += modp[(size_t)(kc * 8 + bb) * 12288 + j];
            mod[idx] = s; }
        __syncthreads();
        f32x4 g1q[8];
#pragma unroll
        for (int j = 0; j < 8; ++j) g1q[j] = *(const GAS f32x4*)(args.in[4] + 256 * j + 4 * F.lane);
        f32x4 vn[8];
        { const GAS f32x4* xr0 = (const GAS f32x4*)(args.in[0] + (size_t)(rg * 64 + F.wave * 8) * D) + F.lane;
#pragma unroll
          for (int j = 0; j < 8; ++j) vn[j] = xr0[64 * j]; }
        for (int i = 0; i < 8; ++i) {
            const int m = rg * 64 + F.wave * 8 + i;
            f32x4 v[8]; float ss = 0.f;
#pragma unroll
            for (int j = 0; j < 8; ++j) { v[j] = vn[j]; ss += (v[j].x * v[j].x + v[j].y * v[j].y) + (v[j].z * v[j].z + v[j].w * v[j].w); }
            if (i < 7) { const GAS f32x4* xr1 = (const GAS f32x4*)(args.in[0] + (size_t)(m + 1) * D) + F.lane;
#pragma unroll
                for (int j = 0; j < 8; ++j) vn[j] = xr1[64 * j]; }
            const float rstd = 1.0f / sqrtf(wave_sum(ss) * (1.0f / D) + NORM_EPS);
            GAS v2u* o8 = (GAS v2u*)(H + (size_t)m * D) + F.lane;
#pragma unroll
            for (int j = 0; j < 8; ++j) { const int c = 256 * j + 4 * F.lane;
                const f32x4 g = g1q[j], sh = *(const LAS f32x4*)(ml + c), scl = *(const LAS f32x4*)(ml + D + c);
                const f32x4 hv = v[j] * rstd * g * (scl + 1.0f) + sh;
                v2u w; w.x = pk2(hv.x, hv.y); w.y = pk2(hv.z, hv.w); o8[64 * j] = w; }
        }
    }
}

__device__ __forceinline__ void p3_lora_a(Frame& F, const Args& args) {
    const bf16* P = (const bf16*)(F.ws + WS_PROJ); bf16* A = (bf16*)(F.ws + WS_LORA_A);
    const int gw = F.vcu * NWAVES + F.wave, NGW = F.G * NWAVES;
    float muv[5];
#pragma unroll
    for (int jj = 0; jj < 5; ++jj) { const int c = F.lane + 64 * jj; muv[jj] = (c < 288) ? args.in[7][3072 + c] : 0.f; }
    for (int rg = gw; rg < M / 8; rg += NGW) {
        const int m0 = rg * 8; unsigned short raw[9][5];
#pragma unroll
        for (int r = 0; r < 9; ++r)
#pragma unroll
            for (int jj = 0; jj < 5; ++jj) { const int c = F.lane + 64 * jj; const bool first = (r == 0) && (m0 % SEQ) == 0; const int m = first ? m0 : m0 + r - 1;
                const unsigned short q = ((const GAS bf16*)P)[(size_t)m * NPROJ + 3072 + (c < 288 ? c : 287)]; raw[r][jj] = (c < 288 && !first) ? q : (unsigned short)0; }
#pragma unroll
        for (int r = 1; r < 9; ++r) { const int m = m0 + r - 1;
#pragma unroll
            for (int jj = 0; jj < 6; ++jj) { const int c = F.lane + 64 * jj; float o = 0.f;
                if (jj < 5 && c < 288) { const float p = bf2f(raw[r][jj < 5 ? jj : 0]), pp = bf2f(raw[r - 1][jj < 5 ? jj : 0]); const float s = p + (pp - p) * muv[jj < 5 ? jj : 0];
                    o = (c < 64) ? (2.0f * sigmoidf_(2.0f * s) - 1.0f) : ((c < 128) ? s : sigmoidf_(s)); }
                A[(size_t)m * LORA_K + c] = (bf16)f2bf(o); } }
    }
}

__device__ __forceinline__ float wave_sum_u(float v) {
    v += dpp_mov<0xB1>(v); v += dpp_mov<0x4E>(v); v += dpp_mov<0x141>(v); v += dpp_mov<0x140>(v);
    v += __builtin_bit_cast(float, __builtin_amdgcn_update_dpp(0, __builtin_bit_cast(int, v), 0x142, 0xa, 0xf, false));
    v += __builtin_bit_cast(float, __builtin_amdgcn_update_dpp(0, __builtin_bit_cast(int, v), 0x143, 0xc, 0xf, false));
    return __builtin_bit_cast(float, __builtin_amdgcn_readlane(__builtin_bit_cast(int, v), 63));
}
#define LO2(v) __builtin_shufflevector(v, v, 0, 1)
#define HI2(v) __builtin_shufflevector(v, v, 2, 3)
__device__ __forceinline__ float fma_s(float a, float b, float c) { float d; asm("v_fma_f32 %0, %1, %2, %3" : "=v"(d) : "v"(a), "v"(b), "v"(c)); return d; }
__device__ __forceinline__ float mul_s(float a, float b) { float d; asm("v_mul_f32 %0, %1, %2" : "=v"(d) : "v"(a), "v"(b)); return d; }
__device__ __forceinline__ float sub_s(float a, float b) { float d; asm("v_sub_f32 %0, %1, %2" : "=v"(d) : "v"(a), "v"(b)); return d; }
__device__ __forceinline__ float add_s(float a, float b) { float d; asm("v_add_f32 %0, %1, %2" : "=v"(d) : "v"(a), "v"(b)); return d; }
struct RStep { f32x4 kk0, kk1, w0, w1, nb0, nb1, k0, k1, r0, r1; float v; };
__device__ __forceinline__ void rwkv_scan(Frame& F, const Args& args, int bh) {
    constexpr int TT = 32, ARR = TT * 64, BUF = 8 * ARR + 64;
    const int b = bh >> 4, h = bh & 15, lane = F.lane, wave = F.wave;
    const bf16* P = (const bf16*)(F.ws + WS_PROJ); const bf16* LO = (const bf16*)(F.ws + WS_LORA_O); bf16* YA = (bf16*)(F.ws + WS_YA);
    LAS float* L = (LAS float*)F.lds;
    const int c = h * 64 + lane;
    const float mu_r = args.in[7][c], mu_k = args.in[7][1024 + c], mu_v = args.in[7][2048 + c], w0 = args.in[8][c], a0 = args.in[10][c], kkc = args.in[13][c], kac = args.in[14][c], rkc = args.in[15][c], gng = args.in[16][c], gnb = args.in[17][c];
    unsigned short rr[4], rk[4], rv[4], pr[4], pk[4], pv[4], rwl[4], ral[4], rg[4];
    auto load_raw = [&](int t0) {
#pragma unroll
        for (int i = 0; i < 4; ++i) { const int t = t0 + wave + 8 * i; const size_t m = (size_t)b * SEQ + t; const GAS bf16* pm = (const GAS bf16*)P + m * NPROJ + c;
            rr[i] = pm[0]; rk[i] = pm[1024]; rv[i] = pm[2048];
            if (t > 0) { pr[i] = pm[-NPROJ]; pk[i] = pm[1024 - NPROJ]; pv[i] = pm[2048 - NPROJ]; } else { pr[i] = 0; pk[i] = 0; pv[i] = 0; }
            const GAS bf16* lm = (const GAS bf16*)LO + m * LORA_N + c; rwl[i] = lm[0]; ral[i] = lm[1024]; rg[i] = lm[2048]; }
    };
    auto derive = [&](LAS float* B) {
#pragma unroll
        for (int i = 0; i < 4; ++i) { const int tl = wave + 8 * i;
            const float r0 = bf2f(rr[i]), k0 = bf2f(rk[i]), v0 = bf2f(rv[i]);
            const float r = r0 + (bf2f(pr[i]) - r0) * mu_r, k = k0 + (bf2f(pk[i]) - k0) * mu_k, v = v0 + (bf2f(pv[i]) - v0) * mu_v;
            const float decay = __expf(-0.6065306597126334f * sigmoidf_(w0 + bf2f(rwl[i])));
            const float a = sigmoidf_(a0 + bf2f(ral[i]));
            const float kkv = k * kkc; const float n2 = wave_sum_u(kkv * kkv); const float kk = kkv / fmaxf(sqrtf(n2), 1e-12f);
            const float k2 = k * (1.0f + (a - 1.0f) * kac);
            const float bon = wave_sum_u(r * k2 * rkc);
            B[0 * ARR + tl * 64 + lane] = kk; B[1 * ARR + tl * 64 + lane] = decay; B[2 * ARR + tl * 64 + lane] = -kk * a; B[3 * ARR + tl * 64 + lane] = k2;
            B[4 * ARR + tl * 64 + lane] = r; B[5 * ARR + tl * 64 + lane] = v; B[6 * ARR + tl * 64 + lane] = bf2f(rg[i]);
            if (lane == 0) B[8 * ARR + tl] = bon; }
    };
    const int rv8 = lane >> 3, kg = lane & 7, row = 8 * wave + rv8;
    float S[8];
#pragma unroll
    for (int i = 0; i < 8; ++i) S[i] = 0.f;
    auto ldstep = [&](const LAS float* B, int tl) -> RStep {
        const LAS f32x4* q = (const LAS f32x4*)(B + tl * 64 + 8 * kg); RStep s;
        s.kk0 = q[0]; s.kk1 = q[1]; s.w0 = q[ARR / 4]; s.w1 = q[ARR / 4 + 1]; s.nb0 = q[2 * ARR / 4]; s.nb1 = q[2 * ARR / 4 + 1];
        s.k0 = q[3 * ARR / 4]; s.k1 = q[3 * ARR / 4 + 1]; s.r0 = q[4 * ARR / 4]; s.r1 = q[4 * ARR / 4 + 1]; s.v = B[5 * ARR + tl * 64 + row]; return s;
    };
    float yacc = 0.f;
    auto step = [&](LAS float* B, const RStep& s, int tl) {
        float p0 = mul_s(S[0], s.kk0[0]), p1 = mul_s(S[1], s.kk0[1]);
        p0 = fma_s(S[2], s.kk0[2], p0); p1 = fma_s(S[3], s.kk0[3], p1); p0 = fma_s(S[4], s.kk1[0], p0); p1 = fma_s(S[5], s.kk1[1], p1); p0 = fma_s(S[6], s.kk1[2], p0); p1 = fma_s(S[7], s.kk1[3], p1);
        const float sa = red8(add_s(p0, p1));
#pragma unroll
        for (int i = 0; i < 4; ++i) { S[i] = fma_s(S[i], s.w0[i], fma_s(sa, s.nb0[i], mul_s(s.v, s.k0[i]))); S[4 + i] = fma_s(S[4 + i], s.w1[i], fma_s(sa, s.nb1[i], mul_s(s.v, s.k1[i]))); }
        float y0 = mul_s(S[0], s.r0[0]), y1 = mul_s(S[1], s.r0[1]);
        y0 = fma_s(S[2], s.r0[2], y0); y1 = fma_s(S[3], s.r0[3], y1); y0 = fma_s(S[4], s.r1[0], y0); y1 = fma_s(S[5], s.r1[1], y1); y0 = fma_s(S[6], s.r1[2], y0); y1 = fma_s(S[7], s.r1[3], y1);
        const float y = red8(add_s(y0, y1));
        yacc = ((tl & 7) == kg) ? y : yacc;
        if ((tl & 7) == 7) B[7 * ARR + ((tl & ~7) + kg) * 64 + row] = yacc;
    };
    __syncthreads();
    load_raw(0); derive(L);
    __syncthreads();
    for (int tile = 0; tile < SEQ / TT; ++tile) {
        LAS float* B = L + (tile & 1) * BUF; LAS float* Bn = L + ((tile + 1) & 1) * BUF;
        const bool more = (tile + 1) < SEQ / TT;
        if (more) load_raw((tile + 1) * TT);
        {
            RStep sa_ = ldstep(B, 0), sb_;
#pragma unroll
            for (int tl = 0; tl < TT; tl += 2) {
                sb_ = ldstep(B, tl + 1); __builtin_amdgcn_sched_barrier(0); step(B, sa_, tl); __builtin_amdgcn_sched_barrier(0);
                if (tl + 2 < TT) sa_ = ldstep(B, tl + 2);
                __builtin_amdgcn_sched_barrier(0); step(B, sb_, tl + 1); __builtin_amdgcn_sched_barrier(0);
            }
        }
        __syncthreads();
#pragma unroll
        for (int i = 0; i < 4; ++i) { const int tl = wave + 8 * i; const size_t m = (size_t)b * SEQ + tile * TT + tl;
            const float y = B[7 * ARR + tl * 64 + lane]; const float mean = wave_sum_u(y) * (1.0f / 64.0f); const float d = y - mean; const float var = wave_sum_u(d * d) * (1.0f / 64.0f);
            const float yn = d * (1.0f / sqrtf(var + GN_EPS)) * gng + gnb;
            const float o = (yn + B[8 * ARR + tl] * B[5 * ARR + tl * 64 + lane]) * B[6 * ARR + tl * 64 + lane];
            YA[m * RW + c] = (bf16)f2bf(o); }
        if (more) derive(Bn);
        __syncthreads();
    }
}

struct HStep { f32x4 f[4], q[4]; float v; };
__device__ __forceinline__ void hgrn_scan(Frame& F, const Args& args, int u) {
    constexpr int TT = 32, KP = 160, BUF = TT * (KP + KP + 64 + 64);
    const int half = u & 1, bh = u >> 1, b = bh >> 3, h = bh & 7, lane = F.lane, wave = F.wave, tid = F.tid;
    const bf16* P = (const bf16*)(F.ws + WS_PROJ); float* OH = (float*)(F.ws + WS_OHG);
    LAS float* L = (LAS float*)F.lds;
    const int j = tid & 127, ts = tid >> 7, jp = (j >> 4) * 20 + (j & 15);
    const float lb = 1.0f / (1.0f + __expf(args.in[18][1024 + h * 128 + j] - args.in[18][h * 128 + j]));
    unsigned short rq[8], rf[8], rvv[8];
    auto load_raw = [&](int t0) {
#pragma unroll
        for (int i = 0; i < 8; ++i) { const size_t m = (size_t)b * SEQ + t0 + ts + 4 * i; const GAS bf16* pm = (const GAS bf16*)P + m * NPROJ + HG_BASE + h * 128 + j;
            rq[i] = pm[0]; rf[i] = pm[1024]; rvv[i] = (j < 64) ? pm[2048 + half * 64] : (unsigned short)0; }
    };
    auto derive = [&](LAS float* B) {
#pragma unroll
        for (int i = 0; i < 8; ++i) { const int tl = ts + 4 * i; const float q = bf2f(rq[i]); const float f = lb + (1.0f - lb) * sigmoidf_(bf2f(rf[i]));
            B[tl * KP + jp] = f; B[TT * KP + tl * KP + jp] = q * sigmoidf_(q); if (j < 64) B[TT * 2 * KP + tl * 64 + j] = bf2f(rvv[i]); }
    };
    const int cv = lane >> 3, kg = lane & 7, col = 8 * wave + cv;
    float S[16];
#pragma unroll
    for (int i = 0; i < 16; ++i) S[i] = 0.f;
    auto ldstep = [&](const LAS float* B, int tl) -> HStep {
        const LAS f32x4* fp = (const LAS f32x4*)(B + tl * KP + 20 * kg); const LAS f32x4* qp = (const LAS f32x4*)(B + TT * KP + tl * KP + 20 * kg); HStep s; s.v = B[TT * 2 * KP + tl * 64 + col];
#pragma unroll
        for (int g4 = 0; g4 < 4; ++g4) { s.f[g4] = fp[g4]; s.q[g4] = qp[g4]; }
        return s;
    };
    float oacc = 0.f;
    auto step = [&](LAS float* B, const HStep& s, int tl) {
        float o0 = 0.f, o1 = 0.f;
#pragma unroll
        for (int g4 = 0; g4 < 4; ++g4) {
#pragma unroll
            for (int i = 0; i < 4; ++i) { S[4 * g4 + i] = fma_s(s.f[g4][i], sub_s(S[4 * g4 + i], s.v), s.v); }
            if (g4 == 0) { o0 = mul_s(s.q[0][0], S[0]); o1 = mul_s(s.q[0][1], S[1]); } else { o0 = fma_s(s.q[g4][0], S[4 * g4], o0); o1 = fma_s(s.q[g4][1], S[4 * g4 + 1], o1); }
            o0 = fma_s(s.q[g4][2], S[4 * g4 + 2], o0); o1 = fma_s(s.q[g4][3], S[4 * g4 + 3], o1); }
        const float o = red8(add_s(o0, o1));
        oacc = ((tl & 7) == kg) ? o : oacc;
        if ((tl & 7) == 7) B[TT * (2 * KP + 64) + ((tl & ~7) + kg) * 64 + col] = oacc;
    };
    __syncthreads();
    load_raw(0); derive(L);
    __syncthreads();
    for (int tile = 0; tile < SEQ / TT; ++tile) {
        LAS float* B = L + (tile & 1) * BUF; LAS float* Bn = L + ((tile + 1) & 1) * BUF;
        const bool more = (tile + 1) < SEQ / TT;
        if (more) load_raw((tile + 1) * TT);
        {
            HStep sa_ = ldstep(B, 0), sb_;
#pragma unroll
            for (int tl = 0; tl < TT; tl += 2) {
                sb_ = ldstep(B, tl + 1); __builtin_amdgcn_sched_barrier(0); step(B, sa_, tl); __builtin_amdgcn_sched_barrier(0);
                if (tl + 2 < TT) sa_ = ldstep(B, tl + 2);
                __builtin_amdgcn_sched_barrier(0); step(B, sb_, tl + 1); __builtin_amdgcn_sched_barrier(0);
            }
        }
        __syncthreads();
        {
            const int jj = tid & 63, t8 = tid >> 6;
#pragma unroll
            for (int i = 0; i < 4; ++i) { const int tl = t8 + 8 * i; const size_t m = (size_t)b * SEQ + tile * TT + tl; OH[m * 1024 + h * 128 + half * 64 + jj] = B[TT * (2 * KP + 64) + tl * 64 + jj]; }
        }
        if (more) derive(Bn);
        __syncthreads();
    }
}


typedef short bf16x8_t __attribute__((ext_vector_type(8)));
template <int KS> __device__ __forceinline__ f32x4 mm16(const LAS bf16* A, int lda, const LAS bf16* Bt, int ldb, f32x4 acc, int lane) {
    const LAS bf16* ap = A + (lane & 15) * lda + 8 * (lane >> 4); const LAS bf16* bp = Bt + (lane & 15) * ldb + 8 * (lane >> 4);
#pragma unroll
    for (int ks = 0; ks < KS; ++ks) { const bf16x8_t a = *(const LAS bf16x8_t*)(ap + 32 * ks), b = *(const LAS bf16x8_t*)(bp + 32 * ks); acc = __builtin_amdgcn_mfma_f32_16x16x32_bf16(a, b, acc, 0, 0, 0); }
    return acc;
}
__device__ __forceinline__ v2u pack4(f32x4 v) { v2u w; w.x = pk2(v[0], v[1]); w.y = pk2(v[2], v[3]); return w; }
__device__ __forceinline__ float row16_sum(float v) {
    v += dpp_mov<0xB1>(v); v += dpp_mov<0x4E>(v); v += dpp_mov<0x141>(v); v += dpp_mov<0x140>(v); return v;
}

__device__ __forceinline__ void hgrn_chunk_scan(Frame& F, const Args& args, int bh) {
    constexpr int CL = 32, PQ = 136, PS = 40, PO = 132;
    const int b = bh >> 3, h = bh & 7, lane_ = F.lane, wave = F.wave, tid_ = F.tid;
    const bf16* P = (const bf16*)(F.ws + WS_PROJ); bf16* YB = (bf16*)(F.ws + WS_YB);
    LAS bf16* QD = (LAS bf16*)F.lds;
    LAS bf16* KD = QD + 32 * PQ;
    LAS bf16* VT = KD + 32 * PQ;
    LAS bf16* KET = VT + 128 * PS;
    LAS bf16* ST = KET + 128 * PS;
    LAS bf16* AT = ST + 128 * PQ;
    LAS float* OB = (LAS float*)(AT + 32 * PS);
    LAS float* DEND = OB + 32 * PO;
    LAS float* TOT = DEND + 128;
    const float lb = 1.0f / (1.0f + __expf(args.in[18][1024 + h * 128 + (tid_ & 127)] - args.in[18][h * 128 + (tid_ & 127)]));
    unsigned short rq[8], rf[8], rvv[8];
    auto load_raw = [&](int t0) {
#pragma unroll
        for (int i = 0; i < 8; ++i) { const size_t m = (size_t)b * SEQ + t0 + 8 * (tid_ >> 7) + i; const GAS bf16* pm = (const GAS bf16*)P + m * NPROJ + HG_BASE + h * 128 + (tid_ & 127);
            rq[i] = pm[0]; rf[i] = pm[1024]; rvv[i] = pm[2048]; }
    };
    f32x4 Sacc[8];
#pragma unroll
    for (int vt = 0; vt < 8; ++vt) Sacc[vt] = (f32x4){0.f, 0.f, 0.f, 0.f};
    for (int i = tid_; i < 128 * PQ / 2; i += 512) ((LAS unsigned*)ST)[i] = 0u;
    const float gng0 = args.in[19][8 * (tid_ & 15)], gng1 = args.in[19][8 * (tid_ & 15) + 1], gng2 = args.in[19][8 * (tid_ & 15) + 2], gng3 = args.in[19][8 * (tid_ & 15) + 3],
                gng4 = args.in[19][8 * (tid_ & 15) + 4], gng5 = args.in[19][8 * (tid_ & 15) + 5], gng6 = args.in[19][8 * (tid_ & 15) + 6], gng7 = args.in[19][8 * (tid_ & 15) + 7];
    load_raw(0);
    const GAS bf16* ogp = (const GAS bf16*)P + ((size_t)b * SEQ + (tid_ >> 4)) * NPROJ + HG_BASE + 3072 + h * 128 + 8 * (tid_ & 15);
    v4u ogc = *(const GAS v4u*)ogp, ogn = ogc;
    __syncthreads();
    for (int ch = 0; ch < SEQ / CL; ++ch) {
        int lane = lane_, tid = tid_; asm volatile("" : "+v"(lane), "+v"(tid));
        const int j = tid & 127, tq = tid >> 7, q4 = lane >> 4, r16 = lane & 15;
        float fv[8], cs[8]; float run = 0.f;
#pragma unroll
        for (int i = 0; i < 8; ++i) { fv[i] = lb + (1.0f - lb) * sigmoidf_(bf2f(rf[i])); run += __logf(fv[i]); cs[i] = run; }
        TOT[tq * 128 + j] = run;
        {
            v4u w; w.x = (unsigned)rvv[0] | ((unsigned)rvv[1] << 16); w.y = (unsigned)rvv[2] | ((unsigned)rvv[3] << 16); w.z = (unsigned)rvv[4] | ((unsigned)rvv[5] << 16); w.w = (unsigned)rvv[6] | ((unsigned)rvv[7] << 16);
            *(LAS v4u*)(VT + j * PS + 8 * tq) = w; }
        __syncthreads();
        {
            const float t0 = TOT[j], t1 = TOT[128 + j], t2 = TOT[256 + j], t3 = TOT[384 + j];
            const float off = (tq > 0 ? t0 : 0.f) + (tq > 1 ? t1 : 0.f) + (tq > 2 ? t2 : 0.f); const float bl = ((t0 + t1) + t2) + t3; const float ebl = __expf(bl);
            if (tq == 0) DEND[j] = ebl;
            float ke[8];
#pragma unroll
            for (int i = 0; i < 8; ++i) { const float bb = off + cs[i]; const float eb = __expf(bb), enb = __builtin_amdgcn_rcpf(eb); const float qv = bf2f(rq[i]); const float kd = (1.0f - fv[i]) * enb;
                QD[(8 * tq + i) * PQ + j] = (bf16)f2bf(qv * sigmoidf_(qv) * eb); KD[(8 * tq + i) * PQ + j] = (bf16)f2bf(kd); ke[i] = kd * ebl; }
            v4u w; w.x = pk2(ke[0], ke[1]); w.y = pk2(ke[2], ke[3]); w.z = pk2(ke[4], ke[5]); w.w = pk2(ke[6], ke[7]);
            *(LAS v4u*)(KET + j * PS + 8 * tq) = w;
        }
        const bool more = (ch + 1) < SEQ / CL;
        if (more) { load_raw((ch + 1) * CL); ogn = *(const GAS v4u*)(ogp + (size_t)(ch + 1) * CL * NPROJ); }
        __syncthreads();
        if (wave < 4) { const int tt = wave >> 1, st = wave & 1;
            f32x4 a = mm16<4>(KD + 16 * st * PQ, PQ, QD + 16 * tt * PQ, PQ, (f32x4){0.f, 0.f, 0.f, 0.f}, lane);
            const int t = 16 * tt + r16, s0 = 16 * st + 4 * q4;
#pragma unroll
            for (int i = 0; i < 4; ++i) a[i] = (s0 + i <= t) ? a[i] : 0.f;
            *(LAS v2u*)(AT + t * PS + s0) = pack4(a); }
        const int ott = wave & 1, ovt0 = 2 * (wave >> 1);
        f32x4 o0 = mm16<4>(QD + 16 * ott * PQ, PQ, ST + 16 * ovt0 * PQ, PQ, (f32x4){0.f, 0.f, 0.f, 0.f}, lane);
        f32x4 o1 = mm16<4>(QD + 16 * ott * PQ, PQ, ST + 16 * (ovt0 + 1) * PQ, PQ, (f32x4){0.f, 0.f, 0.f, 0.f}, lane);
        __syncthreads();
        o0 = mm16<1>(AT + 16 * ott * PS, PS, VT + 16 * ovt0 * PS, PS, o0, lane);
        o1 = mm16<1>(AT + 16 * ott * PS, PS, VT + 16 * (ovt0 + 1) * PS, PS, o1, lane);
#pragma unroll
        for (int i = 0; i < 4; ++i) { OB[(16 * ott + 4 * q4 + i) * PO + 16 * ovt0 + r16] = o0[i]; OB[(16 * ott + 4 * q4 + i) * PO + 16 * (ovt0 + 1) + r16] = o1[i]; }
        {
            const f32x4 de = *(const LAS f32x4*)(DEND + 16 * wave + 4 * q4);
#pragma unroll
            for (int vt = 0; vt < 8; ++vt) { Sacc[vt] = Sacc[vt] * de; Sacc[vt] = mm16<1>(KET + 16 * wave * PS, PS, VT + 16 * vt * PS, PS, Sacc[vt], lane);
                *(LAS v2u*)(ST + (16 * vt + r16) * PQ + 16 * wave + 4 * q4) = pack4(Sacc[vt]); }
        }
        __syncthreads();
        {
            const int t = tid >> 4, vg = tid & 15; const size_t m = (size_t)b * SEQ + ch * CL + t;
            const f32x4 x0 = *(const LAS f32x4*)(OB + t * PO + 8 * vg), x1 = *(const LAS f32x4*)(OB + t * PO + 8 * vg + 4);
            float ss = (x0[0] * x0[0] + x0[1] * x0[1]) + (x0[2] * x0[2] + x0[3] * x0[3]) + ((x1[0] * x1[0] + x1[1] * x1[1]) + (x1[2] * x1[2] + x1[3] * x1[3]));
            ss = row16_sum(ss);
            const float rs = __builtin_amdgcn_rsqf(ss * (1.0f / 128.0f) + NORM_EPS);
            const v4u og = ogc; ogc = ogn;
            const float z0 = bflo(og.x), z1 = bfhi(og.x), z2 = bflo(og.y), z3 = bfhi(og.y), z4 = bflo(og.z), z5 = bfhi(og.z), z6 = bflo(og.w), z7 = bfhi(og.w);
            v4u w; w.x = pk2(x0[0] * rs * gng0 * (z0 * sigmoidf_(z0)), x0[1] * rs * gng1 * (z1 * sigmoidf_(z1))); w.y = pk2(x0[2] * rs * gng2 * (z2 * sigmoidf_(z2)), x0[3] * rs * gng3 * (z3 * sigmoidf_(z3)));
            w.z = pk2(x1[0] * rs * gng4 * (z4 * sigmoidf_(z4)), x1[1] * rs * gng5 * (z5 * sigmoidf_(z5))); w.w = pk2(x1[2] * rs * gng6 * (z6 * sigmoidf_(z6)), x1[3] * rs * gng7 * (z7 * sigmoidf_(z7)));
            *(GAS v4u*)(YB + m * 1024 + h * 128 + 8 * vg) = w;
        }
    }
}

__device__ __forceinline__ void rwkv_chunk_scan(Frame& F, const Args& args, int bh) {
    constexpr int CL = 32, P72 = 72, P40 = 40, PN = 36, PY = 68;
    const int b = bh >> 4, h = bh & 15, lane_ = F.lane, wave = F.wave, tid_ = F.tid;
    const bf16* P = (const bf16*)(F.ws + WS_PROJ); const bf16* LO = (const bf16*)(F.ws + WS_LORA_O); bf16* YA = (bf16*)(F.ws + WS_YA);
    LAS bf16* X1 = (LAS bf16*)F.lds;
    LAS bf16* X2 = X1 + 64 * P72;
    LAS bf16* BKT = X2 + 64 * P72;
    LAS bf16* VT = BKT + 64 * P72;
    LAS bf16* KKT = VT + 64 * P40;
    LAS bf16* MVT = KKT + 64 * P40;
    LAS bf16* UT = MVT + 64 * P40;
    LAS bf16* MAK = UT + 64 * P40;
    LAS bf16* TT = MAK + 32 * P40;
    LAS bf16* AR = TT + 32 * P40;
    LAS bf16* PM = AR + 32 * P72;
    LAS bf16* T11T = PM + 32 * P72;
    LAS bf16* WTm = T11T + 16 * P40;
    LAS bf16* N21B = WTm + 16 * P40;
    LAS bf16* T22B = N21B + 16 * P40;
    LAS bf16* ZT = T22B + 16 * P40;
    LAS float* NM = (LAS float*)(ZT + 2 * 64 * P72);
    LAS float* YBf = NM + 32 * PN;
    LAS float* WLv = YBf + 32 * PY;
    LAS float* CT = WLv + 64;
    LAS float* VGB = CT + 8 * 64;
    constexpr int VGB_SZ = 2 * 32 * 64 + 32;
    const int c = h * 64 + lane_;
    const float mu_r = args.in[7][c], mu_k = args.in[7][1024 + c], mu_v = args.in[7][2048 + c], w0 = args.in[8][c], a0 = args.in[10][c], kkc = args.in[13][c], kac = args.in[14][c], rkc = args.in[15][c], gng = args.in[16][c], gnb = args.in[17][c];
    unsigned short rr[5], rk[5], rv[5], rwl[4], ral[4], rg[4];
    auto load_raw = [&](int t0) {
#pragma unroll
        for (int i = 0; i < 5; ++i) { const int t = t0 + 4 * wave + i - 1;
            if (t >= 0) { const GAS bf16* pm = (const GAS bf16*)P + ((size_t)b * SEQ + t) * NPROJ + c; rr[i] = pm[0]; rk[i] = pm[1024]; rv[i] = pm[2048]; } else { rr[i] = 0; rk[i] = 0; rv[i] = 0; }
            if (i > 0) { const GAS bf16* lm = (const GAS bf16*)LO + ((size_t)b * SEQ + t) * LORA_N + c; rwl[i - 1] = lm[0]; ral[i - 1] = lm[1024]; rg[i - 1] = lm[2048]; } }
    };
    for (int i = tid_; i < (2 * 64 * P72) / 2; i += 512) ((LAS unsigned*)ZT)[i] = 0u;
    for (int i = tid_; i < (4 * 16 * P40) / 2; i += 512) ((LAS unsigned*)T11T)[i] = 0u;
    for (int i = tid_; i < (32 * P40) / 2; i += 512) ((LAS unsigned*)TT)[i] = 0u;
    f32x4 zacc[2] = {(f32x4){0.f, 0.f, 0.f, 0.f}, (f32x4){0.f, 0.f, 0.f, 0.f}};
    load_raw(0);
    __syncthreads();
    for (int ch = 0; ch < SEQ / CL; ++ch) {
        int lane = lane_; asm volatile("" : "+v"(lane));
        const int q4 = lane >> 4, r16 = lane & 15;
        LAS bf16* ZTc = ZT + (ch & 1) * 64 * P72; LAS bf16* ZTn = ZT + ((ch + 1) & 1) * 64 * P72;
        LAS float* VB = VGB + (ch & 1) * VGB_SZ; LAS float* GB = VB + 32 * 64; LAS float* BON = GB + 32 * 64;
        float er[4], ek2[4], ev[4], ekk[4], eb[4], elw[4], ecw[4]; float run = 0.f;
#pragma unroll
        for (int i = 0; i < 4; ++i) {
            const float r0 = bf2f(rr[i + 1]), k0 = bf2f(rk[i + 1]), v0 = bf2f(rv[i + 1]);
            const float r = r0 + (bf2f(rr[i]) - r0) * mu_r, k = k0 + (bf2f(rk[i]) - k0) * mu_k, v = v0 + (bf2f(rv[i]) - v0) * mu_v;
            const float lw = -0.6065306597126334f * sigmoidf_(w0 + bf2f(rwl[i]));
            const float a = sigmoidf_(a0 + bf2f(ral[i]));
            const float kkv = k * kkc; const float n2 = wave_sum_u(kkv * kkv); const float kk = kkv * __builtin_amdgcn_rsqf(fmaxf(n2, 1e-24f));
            const float k2 = k * (1.0f + (a - 1.0f) * kac);
            const float bon = wave_sum_u(r * k2 * rkc);
            run += lw; er[i] = r; ek2[i] = k2; ev[i] = v; ekk[i] = kk; eb[i] = kk * a; elw[i] = lw; ecw[i] = run;
            const int t = 4 * wave + i;
            VB[t * 64 + lane] = v; GB[t * 64 + lane] = bf2f(rg[i]); if (lane == 0) BON[t] = bon;
        }
        CT[wave * 64 + lane] = run;
        __syncthreads();
        {
            float off = 0.f, tot = 0.f;
#pragma unroll
            for (int w = 0; w < 8; ++w) { const float cv = CT[w * 64 + lane]; off += (w < wave) ? cv : 0.f; tot += cv; }
            const float etot = __expf(tot);
            if (wave == 0) WLv[lane] = etot;
            float fb[4], fk[4], fkk[4];
#pragma unroll
            for (int i = 0; i < 4; ++i) { const int t = 4 * wave + i; const float cw = off + ecw[i]; const float e1 = __expf(cw), e2 = __expf(cw - elw[i]), e3 = __builtin_amdgcn_rcpf(e1), e4 = etot * e3;
                fkk[i] = ekk[i] * e2; fb[i] = eb[i] * e4; fk[i] = ek2[i] * e4;
                X1[t * P72 + lane] = (bf16)f2bf(fkk[i]); X1[(32 + t) * P72 + lane] = (bf16)f2bf(er[i] * e1);
                X2[t * P72 + lane] = (bf16)f2bf(eb[i] * e3); X2[(32 + t) * P72 + lane] = (bf16)f2bf(ek2[i] * e3); }
            v2u w; w.x = pk2(fb[0], fb[1]); w.y = pk2(fb[2], fb[3]); *(LAS v2u*)(BKT + lane * P72 + 4 * wave) = w;
            w.x = pk2(fk[0], fk[1]); w.y = pk2(fk[2], fk[3]); *(LAS v2u*)(BKT + lane * P72 + 32 + 4 * wave) = w;
            w.x = pk2(fkk[0], fkk[1]); w.y = pk2(fkk[2], fkk[3]); *(LAS v2u*)(KKT + lane * P40 + 4 * wave) = w;
            w.x = pk2(ev[0], ev[1]); w.y = pk2(ev[2], ev[3]); *(LAS v2u*)(VT + lane * P40 + 4 * wave) = w;
        }
        const bool more = (ch + 1) < SEQ / CL;
        if (more) load_raw((ch + 1) * CL);
        __syncthreads();
#pragma unroll
        for (int u = 0; u < 2; ++u) { const int idx = 2 * wave + u, rt = idx >> 2, ct = idx & 3;
            if (rt == 0 && ct == 1) continue;
            f32x4 m = mm16<2>(X2 + 16 * ct * P72, P72, X1 + 16 * rt * P72, P72, (f32x4){0.f, 0.f, 0.f, 0.f}, lane);
            const int t = 16 * (rt & 1) + r16, s0 = 16 * (ct & 1) + 4 * q4;
            if (rt < 2) {
#pragma unroll
                for (int i = 0; i < 4; ++i) m[i] = (s0 + i < t) ? m[i] : 0.f;
                if (ct < 2) { *(LAS f32x4*)(NM + t * PN + s0) = m; if (rt == 1 && ct == 0) *(LAS v2u*)(N21B + r16 * P40 + 4 * q4) = pack4(m); }
                else *(LAS v2u*)(MAK + t * P40 + s0) = pack4(m);
            } else {
#pragma unroll
                for (int i = 0; i < 4; ++i) m[i] = (s0 + i <= t) ? m[i] : 0.f;
                *(LAS v2u*)(AR + t * P72 + (ct >= 2 ? 32 : 0) + s0) = pack4(m);
            }
        }
        __syncthreads();
        if (wave == 0) {
            const int blk = q4 & 1, jc = r16; float Tc[16];
            const LAS float* nrow = NM + (16 * blk) * PN + 16 * blk;
#pragma unroll
            for (int t = 0; t < 16; ++t) { float acc = (t == jc) ? 1.0f : 0.0f;
                if (t > 0) {
                    f32x4 nv[4];
#pragma unroll
                    for (int g = 0; g < 4; ++g) if (4 * g < t) nv[g] = *(const LAS f32x4*)(nrow + t * PN + 4 * g);
#pragma unroll
                    for (int s = 0; s < t; ++s) acc -= nv[s >> 2][s & 3] * Tc[s];
                }
                Tc[t] = acc; }
            if (lane < 32) {
#pragma unroll
                for (int s = 0; s < 16; ++s) TT[(16 * blk + s) * P40 + 16 * blk + jc] = (bf16)f2bf(Tc[s]);
                if (blk == 0) { v4u w0v, w1v; w0v.x = pk2(Tc[0], Tc[1]); w0v.y = pk2(Tc[2], Tc[3]); w0v.z = pk2(Tc[4], Tc[5]); w0v.w = pk2(Tc[6], Tc[7]); w1v.x = pk2(Tc[8], Tc[9]); w1v.y = pk2(Tc[10], Tc[11]); w1v.z = pk2(Tc[12], Tc[13]); w1v.w = pk2(Tc[14], Tc[15]);
                    *(LAS v4u*)(T11T + jc * P40) = w0v; *(LAS v4u*)(T11T + jc * P40 + 8) = w1v; }
                else {
#pragma unroll
                    for (int s = 0; s < 16; ++s) T22B[s * P40 + jc] = (bf16)f2bf(Tc[s]); }
            }
            LDS_WAIT();
            f32x4 wv = mm16<1>(N21B, P40, T11T, P40, (f32x4){0.f, 0.f, 0.f, 0.f}, lane);
            *(LAS v2u*)(WTm + r16 * P40 + 4 * q4) = pack4(wv);
            LDS_WAIT();
            f32x4 t21 = mm16<1>(WTm, P40, T22B, P40, (f32x4){0.f, 0.f, 0.f, 0.f}, lane);
            *(LAS v2u*)(TT + (16 + r16) * P40 + 4 * q4) = pack4(-t21);
        } else {
#pragma unroll
            for (int u = 0; u < 2; ++u) { const int tile = (wave - 1) + 7 * u; if (tile < 8) { const int tt = tile & 1, vt = tile >> 1;
                f32x4 mv = mm16<1>(MAK + 16 * tt * P40, P40, VT + 16 * vt * P40, P40, (f32x4){0.f, 0.f, 0.f, 0.f}, lane);
                *(LAS v2u*)(MVT + (16 * vt + r16) * P40 + 16 * tt + 4 * q4) = pack4(mv); } }
        }
        __syncthreads();
        const int ptt = wave & 1, pct = wave >> 1;
        {
            f32x4 pv = mm16<1>(KKT + 16 * pct * P40, P40, TT + 16 * ptt * P40, P40, (f32x4){0.f, 0.f, 0.f, 0.f}, lane);
            *(LAS v2u*)(PM + (16 * ptt + r16) * P72 + 16 * pct + 4 * q4) = pack4(-pv);
        }
        f32x4 uacc = -mm16<1>(TT + 16 * ptt * P40, P40, MVT + 16 * pct * P40, P40, (f32x4){0.f, 0.f, 0.f, 0.f}, lane);
        __syncthreads();
        uacc = mm16<2>(PM + 16 * ptt * P72, P72, ZTc + 16 * pct * P72, P72, uacc, lane);
        *(LAS v2u*)(UT + (16 * pct + r16) * P40 + 16 * ptt + 4 * q4) = pack4(uacc);
        __syncthreads();
        {
            f32x4 y = mm16<2>(X1 + (32 + 16 * ptt) * P72, P72, ZTc + 16 * pct * P72, P72, (f32x4){0.f, 0.f, 0.f, 0.f}, lane);
            y = mm16<1>(AR + 16 * ptt * P72, P72, UT + 16 * pct * P40, P40, y, lane);
            y = mm16<1>(AR + 16 * ptt * P72 + 32, P72, VT + 16 * pct * P40, P40, y, lane);
#pragma unroll
            for (int i = 0; i < 4; ++i) YBf[(16 * ptt + 4 * q4 + i) * PY + 16 * pct + r16] = y[i];
            const int kt = wave >> 1; const f32x4 wl = *(const LAS f32x4*)(WLv + 16 * kt + 4 * q4);
#pragma unroll
            for (int jv = 0; jv < 2; ++jv) { const int vt = 2 * (wave & 1) + jv;
                zacc[jv] = zacc[jv] * wl;
                zacc[jv] = mm16<1>(BKT + 16 * kt * P72, P72, UT + 16 * vt * P40, P40, zacc[jv], lane);
                zacc[jv] = mm16<1>(BKT + 16 * kt * P72 + 32, P72, VT + 16 * vt * P40, P40, zacc[jv], lane);
                *(LAS v2u*)(ZTn + (16 * vt + r16) * P72 + 16 * kt + 4 * q4) = pack4(zacc[jv]); }
        }
        __syncthreads();
#pragma unroll
        for (int i = 0; i < 4; ++i) { const int tl = wave + 8 * i; const size_t m = (size_t)b * SEQ + ch * CL + tl;
            const float y = YBf[tl * PY + lane]; const float mean = wave_sum_u(y) * (1.0f / 64.0f); const float d = y - mean; const float var = wave_sum_u(d * d) * (1.0f / 64.0f);
            const float yn = d * __builtin_amdgcn_rsqf(var + GN_EPS) * gng + gnb;
            const float o = (yn + BON[tl] * VB[tl * 64 + lane]) * GB[tl * 64 + lane];
            YA[m * RW + c] = (bf16)f2bf(o); }
    }
}

__device__ __forceinline__ void p6_hgrn_post(Frame& F, const Args& args) {
    const bf16* P = (const bf16*)(F.ws + WS_PROJ); const float* OH = (const float*)(F.ws + WS_OHG); bf16* YB = (bf16*)(F.ws + WS_YB);
    const int gw = F.vcu * NWAVES + F.wave, NGW = F.G * NWAVES;
    const float g0 = args.in[19][F.lane], g1 = args.in[19][64 + F.lane];
    for (int p = gw; p < M * HNH; p += NGW) { const int m = p >> 3, h = p & 7;
        const float o0 = OH[(size_t)m * 1024 + h * 128 + F.lane], o1 = OH[(size_t)m * 1024 + h * 128 + 64 + F.lane];
        const float rs = 1.0f / sqrtf(wave_sum(o0 * o0 + o1 * o1) * (1.0f / 128.0f) + NORM_EPS);
        const bf16* og = P + (size_t)m * NPROJ + HG_BASE + 3072 + h * 128 + F.lane; const float z0 = bf2f(og[0]), z1 = bf2f(og[64]);
        YB[(size_t)m * 1024 + h * 128 + F.lane] = (bf16)f2bf(o0 * rs * g0 * (z0 * sigmoidf_(z0)));
        YB[(size_t)m * 1024 + h * 128 + 64 + F.lane] = (bf16)f2bf(o1 * rs * g1 * (z1 * sigmoidf_(z1))); }
}

typedef float f32x4_ __attribute__((ext_vector_type(4)));
__device__ __forceinline__ void p9_norm2_router(Frame& F, const Args& args) {
    const bf16* X1 = (const bf16*)(F.ws + WS_X1); const float* mod = (const float*)(F.ws + WS_MOD); unsigned char* H8 = F.ws + WS_XG; const bf16* rwh = (const bf16*)(F.ws + WS_RWP); const bf16* rwl = rwh + NE * D;
    int* tk_e = (int*)(F.ws + WS_ROUTE + RT_E); int* tk_rank = (int*)(F.ws + WS_ROUTE + RT_RANK); float* tk_gate = (float*)(F.ws + WS_ROUTE + RT_GATE);
    constexpr int CP = 264;
    LAS bf16* hsh = (LAS bf16*)F.lds;
    LAS bf16* hsl = hsh + 64 * CP;
    LAS bf16* bsh = hsl + 64 * CP;
    LAS bf16* bsl = bsh + 32 * CP;
    LAS float* rstd_l = (LAS float*)(bsl + 32 * CP);
    LAS float* lg = rstd_l + 64;
    LAS int* lcnt = (LAS int*)(lg + 64 * 32);
    LAS int* lbase = lcnt + 32;
    LAS int* res_e = lbase + 32;
    LAS int* res_r = res_e + 256;
    LAS float* res_g = (LAS float*)(res_r + 256);
    const int lane = F.lane, wave = F.wave, tid = F.tid;
    for (int rg = F.vcu; rg < M / 64; rg += F.G) {
        const int b = rg / (SEQ / 64), m0 = rg * 64;
        const float* sh2 = mod + (size_t)b * 12288 + 3 * D; const float* sc2 = mod + (size_t)b * 12288 + 4 * D;
        __syncthreads();
        if (tid < 32) lcnt[tid] = 0;
        { float pq[8];
#pragma unroll
          for (int i = 0; i < 8; ++i) pq[i] = (lane < 32) ? ((const GAS float*)(F.ws + WS_MODP))[(size_t)(m0 + wave * 8 + i) * 32 + lane] : 0.f;
#pragma unroll
          for (int i = 0; i < 8; ++i) { const float rs = 1.0f / sqrtf(wave_sum(pq[i]) * (1.0f / D) + NORM_EPS); if (lane == 0) rstd_l[wave * 8 + i] = rs; } }
        __syncthreads();
        const int rt = wave >> 1, nt = wave & 1;
        f32x4 acc = (f32x4){0.f, 0.f, 0.f, 0.f};
        v2u xq[8];
#pragma unroll
        for (int p = 0; p < 8; ++p) xq[p] = *(const GAS v2u*)(X1 + (size_t)(m0 + p * 8 + (tid >> 6)) * D + 4 * (tid & 63));
        f32x4 gq = *(const GAS f32x4*)(args.in[5] + 4 * (tid & 63)), shq = *(const GAS f32x4*)(sh2 + 4 * (tid & 63)), scq = *(const GAS f32x4*)(sc2 + 4 * (tid & 63));
        v4u bq[4];
#pragma unroll
        for (int i = 0; i < 4; ++i) { const int idx = tid + 512 * i, e = (idx & 1023) >> 5, k16 = idx & 31; bq[i] = *(const GAS v4u*)(((idx >> 10) ? rwl : rwh) + (size_t)e * D + 8 * k16); }
        for (int ch = 0; ch < 8; ++ch) {
#pragma unroll
            for (int i = 0; i < 4; ++i) { const int idx = tid + 512 * i, e = (idx & 1023) >> 5, k16 = idx & 31; *(LAS v4u*)(((idx >> 10) ? bsl : bsh) + e * CP + 8 * k16) = bq[i]; }
#pragma unroll
            for (int p = 0; p < 8; ++p) { const int rl = p * 8 + (tid >> 6), c = ch * 256 + 4 * (tid & 63);
                const v2u xv = xq[p]; const f32x4 v = (f32x4){bflo(xv.x), bfhi(xv.x), bflo(xv.y), bfhi(xv.y)};
                const f32x4 hv = v * rstd_l[rl] * gq * (scq + 1.0f) + shq;
                { v2u wh, wl; wh.x = pk2(hv.x, hv.y); wh.y = pk2(hv.z, hv.w);
                  wl.x = pk2(hv.x - bflo(wh.x), hv.y - bfhi(wh.x)); wl.y = pk2(hv.z - bflo(wh.y), hv.w - bfhi(wh.y));
                  *(LAS v2u*)(hsh + rl * CP + 4 * (tid & 63)) = wh; *(LAS v2u*)(hsl + rl * CP + 4 * (tid & 63)) = wl; }
                int q8 = 0; q8 = __builtin_amdgcn_cvt_pk_fp8_f32(fminf(fmaxf(hv.x * H8_SCALE, -448.f), 448.f), fminf(fmaxf(hv.y * H8_SCALE, -448.f), 448.f), q8, false);
                q8 = __builtin_amdgcn_cvt_pk_fp8_f32(fminf(fmaxf(hv.z * H8_SCALE, -448.f), 448.f), fminf(fmaxf(hv.w * H8_SCALE, -448.f), 448.f), q8, true);
                *(GAS int*)(H8 + (size_t)(m0 + rl) * D + c) = q8; }
            if (ch < 7) { const int cn = (ch + 1) * 256 + 4 * (tid & 63);
#pragma unroll
                for (int p = 0; p < 8; ++p) xq[p] = *(const GAS v2u*)(X1 + (size_t)(m0 + p * 8 + (tid >> 6)) * D + cn);
                gq = *(const GAS f32x4*)(args.in[5] + cn); shq = *(const GAS f32x4*)(sh2 + cn); scq = *(const GAS f32x4*)(sc2 + cn);
#pragma unroll
                for (int i = 0; i < 4; ++i) { const int idx = tid + 512 * i, e = (idx & 1023) >> 5, k16 = idx & 31; bq[i] = *(const GAS v4u*)(((idx >> 10) ? rwl : rwh) + (size_t)e * D + (ch + 1) * 256 + 8 * k16); } }
            __syncthreads();
#pragma unroll
            for (int ks = 0; ks < 8; ++ks) {
                const int ao = (16 * rt + (lane & 15)) * CP + 32 * ks + 8 * (lane >> 4);
                const int bo = (16 * nt + (lane & 15)) * CP + 32 * ks + 8 * (lane >> 4);
                const bf16x8_t ah = *(const LAS bf16x8_t*)(hsh + ao), al = *(const LAS bf16x8_t*)(hsl + ao), bh = *(const LAS bf16x8_t*)(bsh + bo), bl = *(const LAS bf16x8_t*)(bsl + bo);
                acc = __builtin_amdgcn_mfma_f32_16x16x32_bf16(ah, bh, acc, 0, 0, 0); acc = __builtin_amdgcn_mfma_f32_16x16x32_bf16(ah, bl, acc, 0, 0, 0); acc = __builtin_amdgcn_mfma_f32_16x16x32_bf16(al, bh, acc, 0, 0, 0);
            }
            __syncthreads();
        }
#pragma unroll
        for (int i = 0; i < 4; ++i) lg[(16 * rt + 4 * (lane >> 4) + i) * 32 + 16 * nt + (lane & 15)] = acc[i] + args.in[24][16 * nt + (lane & 15)];
        __syncthreads();
        if (tid < 64) {
            float v[32];
#pragma unroll
            for (int e = 0; e < 32; ++e) v[e] = lg[tid * 32 + e];
            float tv[4]; int ti[4];
#pragma unroll
            for (int k = 0; k < 4; ++k) { float best = -3.0e38f; int bi = 0;
#pragma unroll
                for (int e = 0; e < 32; ++e) { const bool gt = v[e] > best; best = gt ? v[e] : best; bi = gt ? e : bi; }
                tv[k] = best; ti[k] = bi;
#pragma unroll
                for (int e = 0; e < 32; ++e) v[e] = (e == bi) ? -3.0e38f : v[e]; }
            const float e1 = __expf(tv[1] - tv[0]), e2 = __expf(tv[2] - tv[0]), e3 = __expf(tv[3] - tv[0]); const float inv = 1.0f / (1.0f + e1 + e2 + e3);
            const float gt4[4] = {inv, e1 * inv, e2 * inv, e3 * inv};
#pragma unroll
            for (int k = 0; k < 4; ++k) { res_e[tid * 4 + k] = ti[k]; res_g[tid * 4 + k] = gt4[k]; res_r[tid * 4 + k] = atomicAdd((int*)&lcnt[ti[k]], 1); }
        }
        __syncthreads();
        if (tid < 32) lbase[tid] = (int)__hip_atomic_fetch_add((unsigned*)(F.ctl + CW_CNT) + tid, (unsigned)lcnt[tid], RLX_AGENT);
        __syncthreads();
        if (tid < 256) { const int e = res_e[tid]; const size_t p = (size_t)m0 * 4 + tid; tk_e[p] = e; tk_rank[p] = lbase[e] + res_r[tid]; tk_gate[p] = res_g[tid]; }
    }
}

__device__ __forceinline__ void p10_dispatch(Frame& F, const Args& args) {
    const int* tk_e = (const int*)(F.ws + WS_ROUTE + RT_E); const int* tk_rank = (const int*)(F.ws + WS_ROUTE + RT_RANK); const float* tk_gate = (const float*)(F.ws + WS_ROUTE + RT_GATE);
    int* tok_slot = (int*)(F.ws + WS_ROUTE + RT_TOKSLOT); float* slot_w = (float*)(F.ws + WS_ROUTE + RT_SLOTW); int* tile_e = (int*)(F.ws + WS_ROUTE + RT_TILEE); int* slot_tok = (int*)(F.ws + WS_ROUTE + RT_SLOTTOK);
    LAS int* tstart = (LAS int*)F.lds;
    __syncthreads();
    if (F.tid < NE) tstart[40 + F.tid] = (int)__hip_atomic_load((unsigned*)(F.ctl + CW_CNT) + F.tid, RLX_AGENT);
    __syncthreads();
    if (F.tid == 0) { int s = 0; for (int e = 0; e < NE; ++e) { tstart[e] = s; s += (tstart[40 + e] + 255) >> 8; } tstart[NE] = s; }
    __syncthreads();
    if (blockIdx.x == 0) { const int nt = tstart[NE]; for (int t = F.tid; t <= MAXTILES; t += 512) { int e = -1; if (t < nt) { e = 0; while (tstart[e + 1] <= t) ++e; } if (t < MAXTILES) tile_e[t] = (e < 0) ? 0 : e; else tile_e[MAXTILES] = nt; } }
    for (int e = F.vcu; e < NE; e += F.G) { const int cn = tstart[40 + e], base = 256 * tstart[e], pe = ((cn + 255) >> 8) << 8; for (int s = cn + F.tid; s < pe; s += 512) slot_tok[base + s] = 0; }
    const int gt = F.vcu * 512 + F.tid, NGT = F.G * 512;
    for (int p = gt; p < NASSIGN; p += NGT) { const int e = tk_e[p], slot = 256 * tstart[e] + tk_rank[p]; tok_slot[p] = slot; slot_w[slot] = tk_gate[p]; slot_tok[slot] = p >> 2; }
}

__device__ __forceinline__ void p13_final(Frame& F, const Args& args) {
    const bf16* X1 = (const bf16*)(F.ws + WS_X1); const float* mod = (const float*)(F.ws + WS_MOD); const unsigned char* YE = F.ws + WS_YE; const int* tok_slot = (const int*)(F.ws + WS_ROUTE + RT_TOKSLOT);
    const int gw = F.vcu * NWAVES + F.wave, NGW = F.G * NWAVES;
    typedef int i32x4 __attribute__((ext_vector_type(4)));
    f32x4 fg[8];
#pragma unroll
    for (int j = 0; j < 4; ++j)
#pragma unroll
        for (int hh = 0; hh < 2; ++hh) fg[2 * j + hh] = *(const GAS f32x4*)(args.in[29] + 512 * j + 8 * F.lane + 4 * hh);
    i32x4 sl = *(const GAS i32x4*)(tok_slot + 4 * (gw < M ? gw : 0));
    for (int m = gw; m < M; m += NGW) {
        const int b = m / SEQ; const float* g2 = mod + (size_t)b * 12288 + 5 * D;
        const int s0 = sl.x, s1 = sl.y, s2 = sl.z, s3 = sl.w;
        { const int mn = (m + NGW < M) ? m + NGW : m; sl = *(const GAS i32x4*)(tok_slot + 4 * mn); }
        const GAS v4u* xr = (const GAS v4u*)(X1 + (size_t)m * D) + F.lane;
        f32x4 v[8]; float ss = 0.f;
#pragma unroll
        for (int j = 0; j < 4; ++j) { const int c = 512 * j + 8 * F.lane;
            const v2u y0 = *(const GAS v2u*)(YE + (size_t)s0 * D + c), y1 = *(const GAS v2u*)(YE + (size_t)s1 * D + c), y2 = *(const GAS v2u*)(YE + (size_t)s2 * D + c), y3 = *(const GAS v2u*)(YE + (size_t)s3 * D + c);
            const v4u xv = xr[64 * j];
            const unsigned q0[2] = {y0.x, y0.y}, q1[2] = {y1.x, y1.y}, q2[2] = {y2.x, y2.y}, q3[2] = {y3.x, y3.y}; const unsigned xw[4] = {xv.x, xv.y, xv.z, xv.w};
#pragma unroll
            for (int hh = 0; hh < 2; ++hh) {
                const f32x2 a0 = __builtin_amdgcn_cvt_pk_f32_fp8((int)q0[hh], false), a1 = __builtin_amdgcn_cvt_pk_f32_fp8((int)q0[hh], true), b0 = __builtin_amdgcn_cvt_pk_f32_fp8((int)q1[hh], false), b1 = __builtin_amdgcn_cvt_pk_f32_fp8((int)q1[hh], true);
                const f32x2 c0 = __builtin_amdgcn_cvt_pk_f32_fp8((int)q2[hh], false), c1 = __builtin_amdgcn_cvt_pk_f32_fp8((int)q2[hh], true), d0 = __builtin_amdgcn_cvt_pk_f32_fp8((int)q3[hh], false), d1 = __builtin_amdgcn_cvt_pk_f32_fp8((int)q3[hh], true);
                const f32x2 lo = ((a0 + b0) + c0) + d0, hi = ((a1 + b1) + c1) + d1;
                const f32x4 f = (f32x4){lo.x, lo.y, hi.x, hi.y} * (1.0f / Y8_SCALE);
                const f32x4 x4 = (f32x4){bflo(xw[2 * hh]), bfhi(xw[2 * hh]), bflo(xw[2 * hh + 1]), bfhi(xw[2 * hh + 1])};
                v[2 * j + hh] = x4 + *(const GAS f32x4*)(g2 + c + 4 * hh) * f;
                ss += (v[2 * j + hh].x * v[2 * j + hh].x + v[2 * j + hh].y * v[2 * j + hh].y) + (v[2 * j + hh].z * v[2 * j + hh].z + v[2 * j + hh].w * v[2 * j + hh].w); } }
        const float rstd = 1.0f / sqrtf(wave_sum(ss) * (1.0f / D) + NORM_EPS);
        float* orow = args.out + (size_t)m * D;
#pragma unroll
        for (int j = 0; j < 4; ++j)
#pragma unroll
            for (int hh = 0; hh < 2; ++hh) { const int c = 512 * j + 8 * F.lane + 4 * hh; *(GAS f32x4*)(orow + c) = v[2 * j + hh] * rstd * fg[2 * j + hh]; }
    }
}

__global__ void __launch_bounds__(NWAVES * 64, 2) mk_fwd(Args args) {
    extern __shared__ __attribute__((aligned(16))) unsigned char lds[];
    Frame F;
    F.lds = (LAS unsigned char*)lds;
    F.MISC = (volatile LAS unsigned*)(F.lds + MISC_OFF);
    F.tid = threadIdx.x; F.lane = F.tid & 63; F.wave = __builtin_amdgcn_readfirstlane(F.tid >> 6);
    F.G = gridDim.x; { const int bx = blockIdx.x; F.vcu = (F.G % 8 == 0) ? (bx % 8) * (F.G / 8) + bx / 8 : bx; }
    F.ws = args.ws; F.ctl = (gu32*)(args.ws + WS_CTL);
    for (int u = F.tid; u < 64; u += NWAVES * 64) ((LAS unsigned*)(F.lds + MISC_OFF))[u] = 0u;
    __syncthreads();
    XcdBarrier bar; bar.bar = (unsigned*)(F.ctl + CW_BAR); bar.x = 0; bar.st = nullptr;
    if (N_LAUNCHES == 1) bar = xcd_barrier_post((unsigned*)(F.ctl + CW_BAR), F.MISC + 8);
#define GRID_BAR() do { if (N_LAUNCHES == 1) { xcd_barrier(bar); } } while (0)
    const int lo = args.ph_lo, hi = args.ph_hi;
#ifndef PROBE_REPEAT
#define PROBE_REPEAT 0
#endif
#define REP(k) for (int rep_ = 0; rep_ < (((PROBE_REPEAT) >> (k)) & 1) + 1; ++rep_)
#define IN(k) (lo <= (k) && (k) < hi)
#define BOTH(k) (IN(k) && IN((k) + 1))
    unsigned char* ws = args.ws;
    pg8::bf16_t* const Hb = (pg8::bf16_t*)(ws + WS_H); pg8::bf16_t* const PROJ = (pg8::bf16_t*)(ws + WS_PROJ);

    if (IN(0)) REP(0) { p0_prologue(F, args); if (BOTH(0)) GRID_BAR(); }
    if (IN(1)) REP(1) { p1_norm1(F, args); if (BOTH(1)) GRID_BAR(); }
    if (IN(2)) REP(2) {
        const int bx = (int)blockIdx.x; const bool ded = (F.G == 256) && bx >= P2_GEMM_WGS;
        pg8::Gemm g{Hb, (const pg8::bf16_t*)(ws + WS_WIN), M, NPROJ, D, 0}; pg8::StaticOrder S; S.init(M, NPROJ, (F.G == 256) ? P2_GEMM_WGS : F.G, bx);
        pg8::EpiBf16<0> E{PROJ, NPROJ, nullptr, 0, 0, 1.f};
        if (!ded) pg8::gemm_phase<pg8::EpiBf16<0>, pg8::StaticOrder, PG8_ALIGN, PG8_SP2>(F.lds, g, S, E);
        if (F.G == 256) {
            if (ded) p8_convert(F, args, P8_SPLITD, P8_SPLITR, (bx - P2_GEMM_WGS) * NWAVES + F.wave, (256 - P2_GEMM_WGS) * NWAVES, 0);
            else if (bx >= P2_NFULL) p8_convert(F, args, P8_SPLITA, P8_SPLIT, (bx - P2_NFULL) * NWAVES + F.wave, (P2_GEMM_WGS - P2_NFULL) * NWAVES, 0); }
        else { p8_convert(F, args, P8_SPLITD, P8_SPLITR, F.vcu * NWAVES + F.wave, F.G * NWAVES, 0); p8_convert(F, args, P8_SPLITA, P8_SPLIT, F.vcu * NWAVES + F.wave, F.G * NWAVES, 0); }
        if (BOTH(2)) GRID_BAR();
    }
    if (IN(3)) REP(3) { p3_lora_a(F, args); if (BOTH(3)) GRID_BAR(); }
    if (IN(4)) REP(4) {
        pg8::Gemm g{(const pg8::bf16_t*)(ws + WS_LORA_A), (const pg8::bf16_t*)(ws + WS_WLORA), M, LORA_N, LORA_K, 0}; pg8::StaticOrder S; S.init(M, LORA_N, F.G, (int)blockIdx.x);
        pg8::EpiBf16<0> E{(pg8::bf16_t*)(ws + WS_LORA_O), LORA_N, nullptr, 0, 0, 1.f};
        pg8::gemm_phase<pg8::EpiBf16<0>, pg8::StaticOrder, PG8_ALIGN, PG8_SP2>(F.lds, g, S, E);
        if (BOTH(4)) GRID_BAR();
    }
    if (IN(5)) REP(5) {
        if (F.G == 256) { const int bx = (int)blockIdx.x;
            if (bx < 128) { rwkv_chunk_scan(F, args, bx); __syncthreads(); p8_convert(F, args, P8_SPLITR, P8_SPLITH, bx * NWAVES + F.wave, 128 * NWAVES, 0); } else if (bx < 192) { hgrn_chunk_scan(F, args, bx - 128); __syncthreads(); p8_convert(F, args, P8_SPLITH, P8_SPLITA, (bx - 128) * NWAVES + F.wave, 64 * NWAVES, 0); } else p8_convert(F, args, P8_SPLIT, P8_N, (bx - 192) * NWAVES + F.wave, 64 * NWAVES, 0); }
        else { for (int u = F.vcu; u < 192; u += F.G) { if (u < 128) rwkv_chunk_scan(F, args, u); else hgrn_chunk_scan(F, args, u - 128); } __syncthreads(); p8_convert(F, args, P8_SPLITR, P8_SPLITA, F.vcu * NWAVES + F.wave, F.G * NWAVES, 0); p8_convert(F, args, P8_SPLIT, P8_N, F.vcu * NWAVES + F.wave, F.G * NWAVES, 0); }
        if (BOTH(5)) GRID_BAR();
        if ((PROBE_REPEAT >> 14) & 1) { for (int u = F.vcu; u < 192; u += F.G) { if (u < 128) rwkv_chunk_scan(F, args, u); } GRID_BAR(); }
        if ((PROBE_REPEAT >> 15) & 1) { for (int u = F.vcu; u < 192; u += F.G) { if (u >= 128) hgrn_chunk_scan(F, args, u - 128); } GRID_BAR(); }
    }
    if (IN(6)) {   }
    if (IN(7)) REP(7) {
        pg8::Gemm g{(const pg8::bf16_t*)(ws + WS_YA), (const pg8::bf16_t*)(ws + WS_WPA), M, D, RW, 0, nullptr, (const pg8::bf16_t*)(ws + WS_YB), (const pg8::bf16_t*)(ws + WS_WPB)}; pg8::PairOrder S; S.init(M, D, F.G, (int)blockIdx.x);
        pg8::EpiMerge E{PROJ + GATE_BASE, NPROJ, D, (pg8::bf16_t*)(ws + WS_MERGED), D};
        pg8::gemm_phase<pg8::EpiMerge, pg8::PairOrder, PG8_ALIGN, PG8_SP2>(F.lds, g, S, E);
        if (BOTH(7)) GRID_BAR();
    }
    if (IN(8)) REP(8) {
        pg8::Gemm g{(const pg8::bf16_t*)(ws + WS_MERGED), (const pg8::bf16_t*)(ws + WS_WOUT), M, D, D, 0}; pg8::StaticOrder S; S.init(M, D, F.G, (int)blockIdx.x);
        pg8::EpiRes E{args.in[0], (pg8::bf16_t*)(ws + WS_X1), D, (const float*)(ws + WS_MOD) + 2 * D, 12288, SEQ, (float*)(ws + WS_MODP)};
        pg8::gemm_phase<pg8::EpiRes, pg8::StaticOrder, PG8_ALIGN, PG8_SP2>(F.lds, g, S, E);
        if (BOTH(8)) GRID_BAR();
    }
    if ((PROBE_REPEAT >> 16) & 1) { if (IN(8)) {
        pg8::Gemm g{(const pg8::bf16_t*)(ws + WS_MERGED), (const pg8::bf16_t*)(ws + WS_WOUT), M, D, D, 0}; pg8::StaticOrder S; S.init(M, D, F.G, (int)blockIdx.x);
        pg8::EpiNull E{(float*)(ws + WS_T1)};
        pg8::gemm_phase<pg8::EpiNull, pg8::StaticOrder, PG8_ALIGN, PG8_SP2>(F.lds, g, S, E);
        GRID_BAR();
        if ((PROBE_REPEAT >> 17) & 1) { pg8::gemm_phase<pg8::EpiNull, pg8::StaticOrder, PG8_ALIGN, PG8_SP2>(F.lds, g, S, E); GRID_BAR(); } } }
    if (IN(9)) REP(9) { p9_norm2_router(F, args); if (BOTH(9)) GRID_BAR(); }
    if (IN(10)) REP(10) { p10_dispatch(F, args); if (BOTH(10)) GRID_BAR(); }
    if (IN(11)) REP(11) {
        const int* tile_e = (const int*)(ws + WS_ROUTE + RT_TILEE); const int nt = tile_e[MAXTILES];
        pg8::Gemm g{(const pg8::bf16_t*)(ws + WS_XG), (const pg8::bf16_t*)(ws + WS_WGU), nt * 256, 2 * DE, D / 2, (size_t)2 * DE * D, (const int*)(ws + WS_ROUTE + RT_SLOTTOK)};     pg8::GroupedOrder S; S.init(nt * 256, 2 * DE, F.G, (int)blockIdx.x); S.tile_e = tile_e;
        pg8::EpiSwigluF8 E{ws + WS_ACT, DE, args.in[26], DE, 1.0f / (W8_SCALE * H8_SCALE), A8_SCALE};
        pg8::gemm_phase<pg8::EpiSwigluF8, pg8::GroupedOrder, PG8_ALIGN, PG8_SP2, true, true>(F.lds, g, S, E);
        {
            const int nwg = nt * ((2 * DE) / 256), R = (nwg + F.G - 1) / F.G, nfull = nwg - F.G * (R - 1), s = F.G - nfull, bx = (int)blockIdx.x;
            const int capA = (P11_TAIL_ITEMS * s < P8_Q) ? P11_TAIL_ITEMS * s : P8_Q;
            if (s > 0 && bx >= nfull) p8_convert(F, args, P8_N, P8_N + capA, (bx - nfull) * NWAVES + F.wave, s * NWAVES, 0);
            if (capA < P8_Q) p8_convert(F, args, P8_N + capA, P8_N + P8_Q, F.vcu * NWAVES + F.wave, F.G * NWAVES, 0);
        }
        if (BOTH(11)) GRID_BAR();
    }
    if (IN(12)) REP(12) {
        const int* tile_e = (const int*)(ws + WS_ROUTE + RT_TILEE); const int nt = tile_e[MAXTILES];
        pg8::Gemm g{(const pg8::bf16_t*)(ws + WS_ACT), (const pg8::bf16_t*)(ws + WS_WDN), nt * 256, D, DE / 2, (size_t)D * DE, nullptr}; pg8::GroupedOrder S; S.init(nt * 256, D, F.G, (int)blockIdx.x); S.tile_e = tile_e;
        pg8::EpiDown E{ws + WS_YE, D, args.in[28], (const float*)(ws + WS_ROUTE + RT_SLOTW), 1.0f / (W8_SCALE * A8_SCALE), Y8_SCALE};
        pg8::gemm_phase<pg8::EpiDown, pg8::GroupedOrder, PG8_ALIGN, PG8_SP2, false, true>(F.lds, g, S, E);
        if (BOTH(12)) GRID_BAR();
    }
    if (IN(13)) REP(13) { p13_final(F, args); }
#undef IN
#undef BOTH
}

extern "C" void kernel_launch(void* const* d_in, const int* in_sizes, int n_in, void* d_out, int out_size, void* d_ws, size_t ws_size, hipStream_t stream) {
    static int grid = 0;
    if (grid == 0) {
        if (n_in != 30 || out_size != M * D || ws_size < WS_END) { fprintf(stderr, "kernel_launch: unexpected shapes (n_in %d, out %d, ws %zu)\n", n_in, out_size, ws_size); grid = -1; return; }
        int dev = 0, cus = 0, per_cu = 0;
        if (hipGetDevice(&dev) != hipSuccess || hipDeviceGetAttribute(&cus, hipDeviceAttributeMultiprocessorCount, dev) != hipSuccess) { grid = -1; return; }
        if (hipFuncSetAttribute((const void*)mk_fwd, hipFuncAttributeMaxDynamicSharedMemorySize, LDS_BYTES) != hipSuccess) { fprintf(stderr, "kernel_launch: hipFuncSetAttribute failed\n"); grid = -1; return; }
        if (hipOccupancyMaxActiveBlocksPerMultiprocessor(&per_cu, (const void*)mk_fwd, NWAVES * 64, LDS_BYTES) != hipSuccess || per_cu < 1) fprintf(stderr, "kernel_launch: occupancy query reports %d\n", per_cu);
        (void)hipGetLastError();
        grid = cus;
    }
    if (grid < 0) return;
    (void)in_sizes;
    if (hipMemsetAsync((char*)d_ws + WS_CTL, 0, CTL_ZERO_BYTES, stream) != hipSuccess) return;
    Args a{};
    for (int i = 0; i < 30; ++i) a.in[i] = (const float*)d_in[i];
    a.out = (float*)d_out; a.ws = (unsigned char*)d_ws;
    for (int li = 0; li < N_LAUNCHES; ++li) {
        a.ph_lo = (N_LAUNCHES == 1) ? 0 : li; a.ph_hi = (N_LAUNCHES == 1) ? N_PHASES : li + 1; a.li = li; a.pad = 0;
        hipLaunchKernelGGL(mk_fwd, dim3(grid), dim3(NWAVES * 64), LDS_BYTES, stream, a);
        const hipError_t le = hipPeekAtLastError();
        if (le != hipSuccess) { fprintf(stderr, "kernel_launch: launch %d failed: %s\n", li, hipGetErrorName(le)); break; }
    }
}
```
